# Optimizing an MI355X kernel written in HIP

```python
import math
import jax, jax.numpy as jnp
from jax import lax
import numpy as np

D_MODEL = 2048
BATCH = 4
SEQ = 4096
DEPTH = 2

N_MIXERS = 2
N_HGRN_LAYERS = (DEPTH + N_MIXERS - 1) // N_MIXERS
N_NSA_LAYERS = DEPTH // N_MIXERS
RMS_EPS = 1e-6

HGRN_HEAD_DIM = 128
HGRN_HEADS = D_MODEL // HGRN_HEAD_DIM
HGRN_WIDTH = HGRN_HEADS * HGRN_HEAD_DIM
HGRN_CHUNK = 64

NSA_HEAD_DIM = 128
NSA_HEADS = D_MODEL // NSA_HEAD_DIM
NSA_KV_GROUPS = 4
NSA_HPG = NSA_HEADS // NSA_KV_GROUPS
NSA_WIDTH = NSA_HEADS * NSA_HEAD_DIM
NSA_KV_WIDTH = NSA_KV_GROUPS * NSA_HEAD_DIM
N_BRANCH = 3
CMP_BLOCK = 32
CMP_STRIDE = 16
SEL_BLOCK = 64
N_SELECT = 16
WINDOW = 512
PHI_HIDDEN = 128
Q_BLOCK = 32
NSA_PROJ_SIZES = (NSA_WIDTH,) + (NSA_KV_WIDTH,) * 6 + (NSA_HEADS * N_BRANCH, NSA_WIDTH)
NSA_PROJ = sum(NSA_PROJ_SIZES)

NUM_BUCKETS = 32
MAX_DISTANCE = 128

NEG_INF = -1e30
FORCE_SCORE = 1e9

kernel_name = "hybrid_hgrn2_nsa_interleaved"


def rms_norm(x, g):
    xf = x.astype(jnp.float32)
    y = xf * lax.rsqrt(jnp.mean(xf * xf, axis=-1, keepdims=True) + RMS_EPS) * g.astype(jnp.float32)
    return y.astype(x.dtype)


def t5_bucket(dist):
    n = jnp.maximum(dist, 0)
    max_exact = NUM_BUCKETS // 2
    large = max_exact + (jnp.log(jnp.maximum(n, 1).astype(jnp.float32) / max_exact)
                         / math.log(MAX_DISTANCE / max_exact) * (NUM_BUCKETS - max_exact)).astype(jnp.int32)
    large = jnp.minimum(large, NUM_BUCKETS - 1)
    return jnp.where(n < max_exact, n, large)


def masked_softmax(logits, mask):
    p = jax.nn.softmax(jnp.where(mask, logits.astype(jnp.float32), NEG_INF), axis=-1)
    return jnp.where(mask, p, 0.0)


def chunk_gated_recurrence(q, k, v, log_f):
    B, S, H, dk = q.shape
    dv = v.shape[-1]
    C = HGRN_CHUNK
    n_chunks = S // C

    def to_chunks(a):
        return a.reshape(B, n_chunks, C, H, a.shape[-1]).transpose(1, 0, 3, 2, 4)

    causal = jnp.tril(jnp.ones((C, C), dtype=bool))[:, :, None]

    def step(state, inp):
        qc, kc, vc, gc = inp
        b = jnp.cumsum(gc, axis=2)
        o_inter = jnp.einsum('bhtk,bhkv->bhtv', qc * jnp.exp(b), state)
        diff = b[:, :, :, None, :] - b[:, :, None, :, :]
        decay = jnp.where(causal, jnp.exp(jnp.where(causal, diff, 0.0)), 0.0)
        scores = jnp.einsum('bhtk,bhtsk,bhsk->bhts', qc, decay, kc)
        o_intra = jnp.einsum('bhts,bhsv->bhtv', scores, vc)
        b_last = b[:, :, -1:, :]
        state = (jnp.exp(b_last[:, :, 0, :, None]) * state
                 + jnp.einsum('bhsk,bhsv->bhkv', kc * jnp.exp(b_last - b), vc))
        return state, o_inter + o_intra

    state0 = jnp.zeros((B, H, dk, dv), jnp.float32)
    _, o = lax.scan(step, state0, (to_chunks(q), to_chunks(k), to_chunks(v), to_chunks(log_f)))
    return o.transpose(1, 0, 3, 2, 4).reshape(B, S, H, dv)


def hgrn2_mixer(h, w_in, lb, head_gain, w_out):
    B, S, _ = h.shape
    proj = (h @ w_in).astype(jnp.float32).reshape(B, S, 4, HGRN_HEADS, HGRN_HEAD_DIM)
    q, f_pre, v, z = proj[:, :, 0], proj[:, :, 1], proj[:, :, 2], proj[:, :, 3]
    lb = lb.reshape(HGRN_HEADS, HGRN_HEAD_DIM)
    log_f = jnp.log(lb + (1.0 - lb) * jax.nn.sigmoid(f_pre))
    k = (1.0 - lb) * jax.nn.sigmoid(-f_pre)
    o = chunk_gated_recurrence(q * HGRN_HEAD_DIM ** -0.5, k, v, log_f)
    o = rms_norm(o, head_gain) * jax.nn.silu(z)
    return o.reshape(B, S, HGRN_WIDTH).astype(h.dtype) @ w_out


def compress_kv(kv, pe, w1, b1, w2):
    B, S, G, dk = kv.shape
    n_cmp = (S - CMP_BLOCK) // CMP_STRIDE + 1
    chunks = kv.reshape(B, S // CMP_STRIDE, CMP_STRIDE, G, dk)
    ratio = CMP_BLOCK // CMP_STRIDE
    blocks = jnp.concatenate([chunks[:, m:m + n_cmp] for m in range(ratio)], axis=2)
    blocks = blocks + pe[None, None, :, None, :].astype(blocks.dtype)
    flat = blocks.transpose(0, 3, 1, 2, 4).reshape(B, G, n_cmp, CMP_BLOCK * dk)
    return jax.nn.gelu(flat @ w1.astype(jnp.float32) + b1.astype(jnp.float32)) @ w2.astype(jnp.float32)


def nsa_mixer(h, w_in, pe_k, pe_v, phi_k_w1, phi_k_b1, phi_k_w2, phi_v_w1, phi_v_b1, phi_v_w2,
              rel_bias, w_out):
    B, S, _ = h.shape
    G, hpg, dk = NSA_KV_GROUPS, NSA_HPG, NSA_HEAD_DIM
    proj = (h @ w_in).astype(jnp.float32)
    split_at = [int(s) for s in np.cumsum(NSA_PROJ_SIZES)[:-1]]
    q, k_c, v_c, k_s, v_s, k_w, v_w, gate_logits, z = jnp.split(proj, split_at, axis=-1)
    q = q.reshape(B, S, G, hpg, dk) * dk ** -0.5

    def kv4(a):
        return a.reshape(B, S, G, dk)

    K_cmp = compress_kv(kv4(k_c), pe_k, phi_k_w1, phi_k_b1, phi_k_w2)
    V_cmp = compress_kv(kv4(v_c), pe_v, phi_v_w1, phi_v_b1, phi_v_w2)
    n_cmp = K_cmp.shape[2]
    n_sel = S // SEL_BLOCK
    n_top = min(N_SELECT, n_sel)

    def sel_blocks(a):
        return a.reshape(B, n_sel, SEL_BLOCK, G, dk).transpose(0, 3, 1, 2, 4)

    def win_pad(a):
        return jnp.pad(kv4(a).transpose(0, 2, 1, 3), ((0, 0), (0, 0), (WINDOW, 0), (0, 0)))

    K_sel, V_sel = sel_blocks(k_s), sel_blocks(v_s)
    K_win, V_win = win_pad(k_w), win_pad(v_w)

    tab = rel_bias.astype(jnp.float32).reshape(NUM_BUCKETS, G, hpg).transpose(1, 0, 2)
    cmp_end = CMP_STRIDE * jnp.arange(n_cmp) + CMP_BLOCK - 1
    ci = jnp.arange(n_cmp)[:, None]
    sj = jnp.arange(n_sel)[None, :]
    overlap = ((CMP_STRIDE * ci < SEL_BLOCK * (sj + 1))
               & (CMP_STRIDE * ci + CMP_BLOCK > SEL_BLOCK * sj)).astype(jnp.float32)
    bidx = jnp.arange(B)[:, None, None, None]
    gidx = jnp.arange(G)[None, :, None, None]
    n_qblk = S // Q_BLOCK
    q_blocks = q.reshape(B, n_qblk, Q_BLOCK, G, hpg, dk).transpose(1, 0, 3, 2, 4, 5)

    def bias_shared(dist):
        return tab[:, t5_bucket(dist)].transpose(0, 1, 3, 2)

    def block_fn(args):
        blk, qb = args
        start = blk * Q_BLOCK
        t = start + jnp.arange(Q_BLOCK)
        dist_c = t[:, None] - cmp_end[None, :]
        logit_c = jnp.einsum('bgqhd,bgkd->bgqhk', qb, K_cmp) + bias_shared(dist_c)
        p_c = masked_softmax(logit_c, (dist_c >= 0)[:, None, :])
        o_c = jnp.einsum('bgqhk,bgkd->bgqhd', p_c, V_cmp)
        importance = jnp.einsum('bgqhk,kn->bgqn', p_c, overlap)
        j = jnp.arange(n_sel)[None, :]
        cur = (t // SEL_BLOCK)[:, None]
        forced = (j == 0) | (j == cur) | (j == cur - 1)
        visible = j * SEL_BLOCK <= t[:, None]
        score = jnp.where(forced, FORCE_SCORE, jnp.where(visible, importance, NEG_INF))
        _, idx = lax.top_k(score, n_top)
        k_g = K_sel[bidx, gidx, idx].reshape(B, G, Q_BLOCK, n_top * SEL_BLOCK, dk)
        v_g = V_sel[bidx, gidx, idx].reshape(B, G, Q_BLOCK, n_top * SEL_BLOCK, dk)
        pos_s = (idx[..., None] * SEL_BLOCK + jnp.arange(SEL_BLOCK)).reshape(B, G, Q_BLOCK, n_top * SEL_BLOCK)
        dist_s = t[:, None] - pos_s
        bias_s = jnp.moveaxis(tab[gidx, t5_bucket(dist_s)], -1, -2)
        logit_s = jnp.einsum('bgqhd,bgqkd->bgqhk', qb, k_g) + bias_s
        p_s = masked_softmax(logit_s, (dist_s >= 0)[..., None, :])
        o_s = jnp.einsum('bgqhk,bgqkd->bgqhd', p_s, v_g)
        k_wb = lax.dynamic_slice_in_dim(K_win, start, WINDOW + Q_BLOCK, axis=2)
        v_wb = lax.dynamic_slice_in_dim(V_win, start, WINDOW + Q_BLOCK, axis=2)
        pos_w = start - WINDOW + jnp.arange(WINDOW + Q_BLOCK)
        dist_w = t[:, None] - pos_w[None, :]
        mask_w = (dist_w >= 0) & (dist_w < WINDOW) & (pos_w[None, :] >= 0)
        logit_w = jnp.einsum('bgqhd,bgkd->bgqhk', qb, k_wb) + bias_shared(dist_w)
        p_w = masked_softmax(logit_w, mask_w[:, None, :])
        o_w = jnp.einsum('bgqhk,bgkd->bgqhd', p_w, v_wb)
        return jnp.stack([o_c, o_s, o_w], axis=-2)

    out = lax.map(block_fn, (jnp.arange(n_qblk), q_blocks))
    out = out.transpose(1, 0, 3, 2, 4, 5, 6).reshape(B, S, NSA_HEADS, N_BRANCH, dk)
    gates = jax.nn.sigmoid(gate_logits.reshape(B, S, NSA_HEADS, N_BRANCH))
    o = jnp.einsum('bshc,bshcd->bshd', gates, out).reshape(B, S, NSA_WIDTH) * jax.nn.silu(z)
    return o.astype(h.dtype) @ w_out


def setup_inputs(seed: int = 0) -> dict:
    key = jax.random.key(seed)
    ks = jax.random.split(key, 20)
    f32 = jnp.float32

    def nrm(k, shape, scale):
        return jax.random.normal(k, shape, f32) * scale

    nb = N_NSA_LAYERS
    return {
        "x": nrm(ks[0], (BATCH, SEQ, D_MODEL), 1.0),
        "norm_gains": 1.0 + nrm(ks[1], (DEPTH, D_MODEL), 0.02),
        "final_gain": 1.0 + nrm(ks[2], (D_MODEL,), 0.02),
        "rel_bias": nrm(ks[3], (NUM_BUCKETS, NSA_HEADS), 0.5),
        "hgrn_lb": nrm(ks[4], (DEPTH + 1, HGRN_WIDTH), 0.5),
        "hgrn_w_in": nrm(ks[5], (N_HGRN_LAYERS, D_MODEL, 4 * HGRN_WIDTH), D_MODEL ** -0.5),
        "hgrn_head_gain": 1.0 + nrm(ks[6], (N_HGRN_LAYERS, HGRN_HEAD_DIM), 0.02),
        "hgrn_w_out": nrm(ks[7], (N_HGRN_LAYERS, HGRN_WIDTH, D_MODEL), HGRN_WIDTH ** -0.5),
        "nsa_w_in": nrm(ks[8], (nb, D_MODEL, NSA_PROJ), D_MODEL ** -0.5),
        "nsa_pe_k": nrm(ks[9], (nb, CMP_BLOCK, NSA_HEAD_DIM), 0.1),
        "nsa_pe_v": nrm(ks[10], (nb, CMP_BLOCK, NSA_HEAD_DIM), 0.1),
        "nsa_phi_k_w1": nrm(ks[11], (nb, CMP_BLOCK * NSA_HEAD_DIM, PHI_HIDDEN), (CMP_BLOCK * NSA_HEAD_DIM) ** -0.5),
        "nsa_phi_k_b1": nrm(ks[12], (nb, PHI_HIDDEN), 0.01),
        "nsa_phi_k_w2": nrm(ks[13], (nb, PHI_HIDDEN, NSA_HEAD_DIM), PHI_HIDDEN ** -0.5),
        "nsa_phi_v_w1": nrm(ks[14], (nb, CMP_BLOCK * NSA_HEAD_DIM, PHI_HIDDEN), (CMP_BLOCK * NSA_HEAD_DIM) ** -0.5),
        "nsa_phi_v_b1": nrm(ks[15], (nb, PHI_HIDDEN), 0.01),
        "nsa_phi_v_w2": nrm(ks[16], (nb, PHI_HIDDEN, NSA_HEAD_DIM), PHI_HIDDEN ** -0.5),
        "nsa_w_out": nrm(ks[17], (nb, NSA_WIDTH, D_MODEL), NSA_WIDTH ** -0.5),
    }


def reference(x, norm_gains, final_gain, rel_bias, hgrn_lb, hgrn_w_in, hgrn_head_gain, hgrn_w_out,
              nsa_w_in, nsa_pe_k, nsa_pe_v, nsa_phi_k_w1, nsa_phi_k_b1, nsa_phi_k_w2,
              nsa_phi_v_w1, nsa_phi_v_b1, nsa_phi_v_w2, nsa_w_out):
    lower_bounds = jnp.cumsum(jax.nn.softmax(hgrn_lb.astype(jnp.float32), axis=0), axis=0)
    for i in range(DEPTH):
        h = rms_norm(x, norm_gains[i])
        a = i // N_MIXERS
        if i % N_MIXERS == 0:
            y = hgrn2_mixer(h, hgrn_w_in[a], lower_bounds[i], hgrn_head_gain[a], hgrn_w_out[a])
        else:
            y = nsa_mixer(h, nsa_w_in[a], nsa_pe_k[a], nsa_pe_v[a],
                          nsa_phi_k_w1[a], nsa_phi_k_b1[a], nsa_phi_k_w2[a],
                          nsa_phi_v_w1[a], nsa_phi_v_b1[a], nsa_phi_v_w2[a],
                          rel_bias, nsa_w_out[a])
        x = x + y.astype(x.dtype)
    return rms_norm(x, final_gain)
```

```cpp
#include <hip/hip_runtime.h>
#include <hip/hip_cooperative_groups.h>
#include <cstdio>
#include <cstdint>
namespace cg = cooperative_groups;

#ifndef MK_SKEL
#define MK_SKEL 0
#endif
#ifndef HGRN_NAIVE
#define HGRN_NAIVE 0
#endif
#ifndef NSA_NAIVE
#define NSA_NAIVE 0
#endif
#ifndef NSA_DIFF
#define NSA_DIFF 0
#endif
#define NSA_AMP 64.f
#ifndef PROBE_REP
#define PROBE_REP -1
#endif
#ifndef MK_MULTI
constexpr bool LOGF_L2 = true;
#define MK_MULTI 0
#endif

#define LAS __attribute__((address_space(3)))
typedef unsigned short bf16_t;
typedef short bf16x8 __attribute__((ext_vector_type(8)));
typedef float f32x4 __attribute__((ext_vector_type(4)));
typedef float f32x2 __attribute__((ext_vector_type(2)));
typedef unsigned u32x4 __attribute__((ext_vector_type(4)));
typedef unsigned u32x2 __attribute__((ext_vector_type(2)));
typedef _Float16 f16x8 __attribute__((ext_vector_type(8)));
typedef _Float16 f16x4 __attribute__((ext_vector_type(4)));

constexpr int NB = 4, SEQ = 4096, T = NB * SEQ, DM = 2048;
constexpr int NH = 16, HD = 128, NG = 4;
constexpr int N0IN = 8192;
constexpr int N1IN = 7216, N1PAD = 7424;
constexpr int NCMP = 255, NCMPP = 256;
constexpr float RMS_EPS = 1e-6f;
constexpr float QSCALE = 0.08838834764831845f;

constexpr size_t MiB = 1u << 20;
constexpr size_t WS_A = 0;
constexpr size_t WS_B = 64 * MiB;
constexpr size_t WS_D = 192 * MiB;
constexpr size_t WS_E = 256 * MiB;
constexpr size_t WS_G = 352 * MiB;
constexpr size_t WS_SSQ = 160 * MiB;
constexpr size_t WS_W0IN = 416 * MiB;
constexpr size_t WS_W0OUT = 448 * MiB;
constexpr size_t WS_W1IN = 456 * MiB;
constexpr size_t WS_W1OUT = 486 * MiB;
constexpr size_t WS_GATES = 128 * MiB;
constexpr size_t WS_KCMP = 497 * MiB;
constexpr size_t WS_VCMP = 498 * MiB;
constexpr size_t WS_MISC = 499 * MiB;
constexpr size_t WS_W1K = 500 * MiB;
constexpr size_t WS_W1V = 501 * MiB;
constexpr size_t WS_W2K = 502 * MiB;
constexpr size_t WS_W2V = 502 * MiB + 65536;
constexpr size_t WS_BAR = 503 * MiB;
constexpr size_t BAR_BYTES = 16384;
constexpr size_t WS_END = 504 * MiB;
constexpr size_t MISC_LB = 0, MISC_BIASP = 8192, MISC_CVP = 16384;

constexpr int LDS_BYTES = 160 * 1024;

struct Params {
    const float* x; const float* norm_gains; const float* final_gain; const float* rel_bias; const float* hgrn_lb;
    const float* hgrn_w_in; const float* hgrn_head_gain; const float* hgrn_w_out; const float* nsa_w_in;
    const float* pe_k; const float* pe_v; const float* pk_w1; const float* pk_b1; const float* pk_w2;
    const float* pv_w1; const float* pv_b1; const float* pv_w2; const float* nsa_w_out;
    float* out; unsigned char* ws;
    int ph_lo, ph_hi;
};

__device__ __forceinline__ float bf2f(bf16_t b) { return __uint_as_float(((unsigned)b) << 16); }
__device__ __forceinline__ unsigned f2bf(float f) { unsigned u = __float_as_uint(f); return (u + 0x7fffu + ((u >> 16) & 1u)) >> 16; }
__device__ __forceinline__ unsigned pk2(float lo, float hi) { return f2bf(lo) | (f2bf(hi) << 16); }
__device__ __forceinline__ float wave_sum(float v) {
#pragma unroll
    for (int o = 1; o < 64; o <<= 1) v += __shfl_xor(v, o);
    return v;
}
__device__ __forceinline__ float wave_max(float v) {
#pragma unroll
    for (int o = 1; o < 64; o <<= 1) v = fmaxf(v, __shfl_xor(v, o));
    return v;
}
__device__ __forceinline__ float sigmoidf_(float x) { return __builtin_amdgcn_rcpf(1.f + __expf(-x)); }
__device__ __forceinline__ float gate_of(const float* g) { return sigmoidf_((g[0] + g[(size_t)T * 48]) + (g[(size_t)2 * T * 48] + g[(size_t)3 * T * 48])); }
#define LDS_WAIT() asm volatile("s_waitcnt lgkmcnt(0)" ::: "memory")
#define LDS_BARRIER() do { asm volatile("s_waitcnt lgkmcnt(0)" ::: "memory"); __builtin_amdgcn_s_barrier(); asm volatile("" ::: "memory"); } while (0)

template <int CTRL> __device__ __forceinline__ float quad_x(float v) { return __uint_as_float((unsigned)__builtin_amdgcn_update_dpp(0, (int)__float_as_uint(v), CTRL, 0xF, 0xF, true)); }
__device__ __forceinline__ float lane_x16(float v, int sel) { auto r = __builtin_amdgcn_permlane16_swap(__float_as_uint(v), __float_as_uint(v), false, false); return __uint_as_float((sel & 1) ? r[0] : r[1]); }
__device__ __forceinline__ float lane_x32(float v, int sel) { auto r = __builtin_amdgcn_permlane32_swap(__float_as_uint(v), __float_as_uint(v), false, false); return __uint_as_float((sel & 2) ? r[0] : r[1]); }
namespace pg8 {
#define PG8_LAS __attribute__((address_space(3)))
constexpr int BM = 256, BK = 64, HALF = 128, HTB = HALF * BK * 2, STAGE_BYTES = 8 * HTB, NXCD = 8, WGM = 8;
__host__ __device__ __forceinline__ int lds_byte(int r, int c) { const int st = (r >> 4) * 2 + (c >> 5), rr = r & 15, cc = c & 31, ob = rr * 64 + cc * 2; return st * 1024 + (ob ^ (((ob >> 9) & 1) << 5)); }
__host__ __device__ __forceinline__ void stage_rc(int b, int& R, int& C) { const int st = b / 1024, sb = b % 1024, swz = sb ^ (((sb >> 9) & 1) << 5); R = (st >> 1) * 16 + swz / 64; C = (st & 1) * 32 + (swz % 64) / 2; }
__host__ __device__ __forceinline__ int perm32(int rho) { const int n = rho >> 4, i = rho & 15; return 8 * (i >> 2) + 4 * n + (i & 3); }
struct Unit { int pm, pn, ks; };
struct Gemm { const bf16_t* A; const bf16_t* Bt; int M, N, K; };
struct StaticOrder {
    int nM, nN, nwg, G, c;
    __host__ __device__ void init(int M, int N, int G_, int c_) { nM = M / BM; nN = N / BM; nwg = nM * nN; G = G_; c = c_; }
    __host__ __device__ bool next(int i, Unit& u) const {
        const long L = (long)i * G + c; if (L >= nwg) return false;
        int wgid = (int)L; { const int q = nwg / NXCD, r = nwg % NXCD, xcd = wgid % NXCD, off = wgid / NXCD; wgid = (xcd < r ? xcd * (q + 1) : r * (q + 1) + (xcd - r) * q) + off; }
        const int nig = WGM * nN, gid = wgid / nig, fm = gid * WGM, gsz = (nM - fm) < WGM ? (nM - fm) : WGM;
        u.pm = fm + ((wgid % nig) % gsz); u.pn = (wgid % nig) / gsz; u.ks = 0; return true;
    }
    __device__ __forceinline__ int nt(const Unit&, int ntf) const { return ntf; }
    __device__ __forceinline__ size_t kbytes(const Unit&, int) const { return 0; }
    __device__ __forceinline__ void a_ready(const Unit&) const {}
    __device__ __forceinline__ void done(const Unit&) const {}
};
struct SplitTailOrder {
    StaticOrder so;
    __host__ __device__ void init(int M, int Nfull, int G_, int c_) { so.init(M, Nfull, G_, c_); }
    __host__ __device__ bool next(int i, Unit& u) const {
        const long L = (long)i * so.G + so.c;
        if (L < so.nwg) return so.next(i, u);
        const int idx = (int)(L - so.nwg); if (idx >= so.nM * 4) return false;
        u.pm = idx >> 2; u.pn = so.nN; u.ks = idx & 3; return true;
    }
    __device__ __forceinline__ int nt(const Unit& u, int ntf) const { return u.pn == so.nN ? (ntf >> 2) : ntf; }
    __device__ __forceinline__ size_t kbytes(const Unit& u, int K) const { return u.pn == so.nN ? (size_t)u.ks * (size_t)(K >> 2) * 2 : 0; }
    __device__ __forceinline__ void a_ready(const Unit&) const {}
    __device__ __forceinline__ void done(const Unit&) const {}
};
__device__ __forceinline__ unsigned cvt_pk_bf16(float lo, float hi) { unsigned r; asm volatile("v_cvt_pk_bf16_f32 %0, %1, %2" : "=v"(r) : "v"(lo), "v"(hi)); return r; }


struct EpiHgrnIn {
    static constexpr bool PERM = true, AFTER_DRAIN = false, INIT = false, ROWSCALE = false;
    unsigned char* ws; float* LOGF; const float* lb;
    __device__ __forceinline__ void operator()(const f32x4 (&acc)[2][2][4][2], const Unit& u, int wr, int wc, int fr, int fq) const {
        const int row0 = u.pm * BM + wr * 64 + fr, sect = u.pn >> 3, col0 = (u.pn & 7) * BM + wc * 32 + 8 * fq;
        if (sect == 1) {
            f32x4 lbv[2][2];
#pragma unroll
            for (int bj = 0; bj < 2; ++bj)
#pragma unroll
                for (int n = 0; n < 2; ++n) lbv[bj][n] = *(const f32x4*)(lb + col0 + bj * HALF + 4 * n);
#pragma unroll
            for (int ai = 0; ai < 2; ++ai)
#pragma unroll
                for (int m = 0; m < 4; ++m) { _Float16* rowp = (_Float16*)LOGF + (size_t)(row0 + ai * HALF + m * 16) * DM + col0;
#pragma unroll
                    for (int bj = 0; bj < 2; ++bj) { f16x8 o;
#pragma unroll
                        for (int n = 0; n < 2; ++n) { const f32x4 x = acc[ai][bj][m][n], l = lbv[bj][n];
#pragma unroll
                            for (int e = 0; e < 4; ++e) { const float sg = sigmoidf_(x[e]); o[4 * n + e] = (_Float16)(LOGF_L2 ? __log2f(l[e] + (1.f - l[e]) * sg) : __logf(l[e] + (1.f - l[e]) * sg)); } }
                        *(f16x8*)(rowp + bj * HALF) = o; } }
        } else {
            const size_t boff = sect == 0 ? WS_B : (sect == 2 ? WS_B + 64 * MiB : WS_D);
            bf16_t* base = (bf16_t*)(ws + boff);
#pragma unroll
            for (int ai = 0; ai < 2; ++ai)
#pragma unroll
                for (int m = 0; m < 4; ++m) { bf16_t* rowp = base + (size_t)(row0 + ai * HALF + m * 16) * DM + col0;
#pragma unroll
                    for (int bj = 0; bj < 2; ++bj) { f32x4 v0 = acc[ai][bj][m][0], v1 = acc[ai][bj][m][1];
                        if (sect == 0) { v0 = v0 * QSCALE; v1 = v1 * QSCALE; }
                        u32x4 w; w.x = cvt_pk_bf16(v0[0], v0[1]); w.y = cvt_pk_bf16(v0[2], v0[3]); w.z = cvt_pk_bf16(v1[0], v1[1]); w.w = cvt_pk_bf16(v1[2], v1[3]);
                        *(u32x4*)(rowp + bj * HALF) = w; } }
        }
    }
};
template <bool RF32>
struct EpiResidT {
    static constexpr bool PERM = true, AFTER_DRAIN = false, INIT = false, ROWSCALE = false;
    const void* R; bf16_t* O;
    __device__ __forceinline__ void operator()(const f32x4 (&acc)[2][2][4][2], const Unit& u, int wr, int wc, int fr, int fq) const {
        const int row0 = u.pm * BM + wr * 64 + fr, col0 = u.pn * BM + wc * 32 + 8 * fq;
#pragma unroll
        for (int ai = 0; ai < 2; ++ai) { f32x4 rv[4][2][RF32 ? 2 : 1];
#pragma unroll
            for (int m = 0; m < 4; ++m) { const size_t off = (size_t)(row0 + ai * HALF + m * 16) * DM + col0;
#pragma unroll
                for (int bj = 0; bj < 2; ++bj) {
                    if constexpr (RF32) { rv[m][bj][0] = *(const f32x4*)((const float*)R + off + bj * HALF); rv[m][bj][1] = *(const f32x4*)((const float*)R + off + bj * HALF + 4); }
                    else rv[m][bj][0] = *(const f32x4*)((const bf16_t*)R + off + bj * HALF); } }
            __builtin_amdgcn_sched_barrier(0);
#pragma unroll
            for (int m = 0; m < 4; ++m) { const size_t off = (size_t)(row0 + ai * HALF + m * 16) * DM + col0;
#pragma unroll
                for (int bj = 0; bj < 2; ++bj) { f32x4 r0, r1;
                    if constexpr (RF32) { r0 = rv[m][bj][0]; r1 = rv[m][bj][1]; }
                    else { const f32x4 q = rv[m][bj][0]; const unsigned a = __float_as_uint(q.x), b = __float_as_uint(q.y), c = __float_as_uint(q.z), d = __float_as_uint(q.w);
                        r0 = (f32x4){__uint_as_float(a << 16), __uint_as_float(a & 0xffff0000u), __uint_as_float(b << 16), __uint_as_float(b & 0xffff0000u)};
                        r1 = (f32x4){__uint_as_float(c << 16), __uint_as_float(c & 0xffff0000u), __uint_as_float(d << 16), __uint_as_float(d & 0xffff0000u)}; }
                    const f32x4 v0 = r0 + acc[ai][bj][m][0], v1 = r1 + acc[ai][bj][m][1];
                    u32x4 w; w.x = cvt_pk_bf16(v0[0], v0[1]); w.y = cvt_pk_bf16(v0[2], v0[3]); w.z = cvt_pk_bf16(v1[0], v1[1]); w.w = cvt_pk_bf16(v1[2], v1[3]);
                    *(u32x4*)(O + off + bj * HALF) = w; } }
            __builtin_amdgcn_sched_barrier(0); }
    }
};
template <bool RF32, bool SSQ = false>
struct EpiResidInit {
    static constexpr bool PERM = true, AFTER_DRAIN = false, INIT = true, ROWSCALE = false;
    const void* R; bf16_t* O; float* SS = nullptr;
    __device__ __forceinline__ void init(f32x4 (&acc)[2][2][4][2], const Unit& u, int wr, int wc, int fr, int fq) const {
        const int row0 = u.pm * BM + wr * 64 + fr, col0 = u.pn * BM + wc * 32 + 8 * fq;
#pragma unroll
        for (int ai = 0; ai < 2; ++ai)
#pragma unroll
            for (int m = 0; m < 4; ++m) { const size_t off = (size_t)(row0 + ai * HALF + m * 16) * DM + col0;
#pragma unroll
                for (int bj = 0; bj < 2; ++bj) {
                    if constexpr (RF32) { acc[ai][bj][m][0] = *(const f32x4*)((const float*)R + off + bj * HALF); acc[ai][bj][m][1] = *(const f32x4*)((const float*)R + off + bj * HALF + 4); }
                    else { const f32x4 q = *(const f32x4*)((const bf16_t*)R + off + bj * HALF); const unsigned a = __float_as_uint(q.x), b = __float_as_uint(q.y), c = __float_as_uint(q.z), d = __float_as_uint(q.w);
                        acc[ai][bj][m][0] = (f32x4){__uint_as_float(a << 16), __uint_as_float(a & 0xffff0000u), __uint_as_float(b << 16), __uint_as_float(b & 0xffff0000u)};
                        acc[ai][bj][m][1] = (f32x4){__uint_as_float(c << 16), __uint_as_float(c & 0xffff0000u), __uint_as_float(d << 16), __uint_as_float(d & 0xffff0000u)}; } } }
    }
    __device__ __forceinline__ void operator()(const f32x4 (&acc)[2][2][4][2], const Unit& u, int wr, int wc, int fr, int fq) const {
        const int row0 = u.pm * BM + wr * 64 + fr, col0 = u.pn * BM + wc * 32 + 8 * fq;
#pragma unroll
        for (int ai = 0; ai < 2; ++ai)
#pragma unroll
            for (int m = 0; m < 4; ++m) { const size_t off = (size_t)(row0 + ai * HALF + m * 16) * DM + col0; float ss = 0.f;
#pragma unroll
                for (int bj = 0; bj < 2; ++bj) { const f32x4 v0 = acc[ai][bj][m][0], v1 = acc[ai][bj][m][1];
                    if constexpr (SSQ) ss += ((v0[0] * v0[0] + v0[1] * v0[1]) + (v0[2] * v0[2] + v0[3] * v0[3])) + ((v1[0] * v1[0] + v1[1] * v1[1]) + (v1[2] * v1[2] + v1[3] * v1[3]));
                    u32x4 w; w.x = cvt_pk_bf16(v0[0], v0[1]); w.y = cvt_pk_bf16(v0[2], v0[3]); w.z = cvt_pk_bf16(v1[0], v1[1]); w.w = cvt_pk_bf16(v1[2], v1[3]);
                    *(u32x4*)(O + off + bj * HALF) = w; }
                if constexpr (SSQ) { ss += lane_x16(ss, fq); ss += lane_x32(ss, fq);
                    if (fq == 0) SS[(size_t)(row0 + ai * HALF + m * 16) * 32 + u.pn * 4 + wc] = ss; } }
    }
};
struct EpiNsaIn {
    static constexpr bool PERM = true, AFTER_DRAIN = false, INIT = false, ROWSCALE = true;
    unsigned char* ws; float* GT; PG8_LAS unsigned char* ldsb; const float* SS;
    static constexpr int RS_OFF = STAGE_BYTES;
    __device__ __forceinline__ void load_rowscale(int pm, int tid) const {
        asm volatile("s_waitcnt lgkmcnt(0)" ::: "memory"); __builtin_amdgcn_s_barrier();
        if (tid < BM) { const f32x4* pp = (const f32x4*)(SS + (size_t)(pm * BM + tid) * 32); f32x4 a = pp[0];
#pragma unroll
            for (int i = 1; i < 8; ++i) a += pp[i];
            ((PG8_LAS float*)(ldsb + RS_OFF))[tid] = rsqrtf(((a.x + a.y) + (a.z + a.w)) * (1.f / DM) + RMS_EPS); }
        asm volatile("s_waitcnt lgkmcnt(0)" ::: "memory"); __builtin_amdgcn_s_barrier();
    }
    __device__ __forceinline__ void operator()(const f32x4 (&acc)[2][2][4][2], const Unit& u, int wr, int wc, int fr, int fq) const {
        const int row0 = u.pm * BM + wr * 64 + fr, pn = u.pn, cl = wc * 32 + 8 * fq;
        if (pn == 28) {
#pragma unroll
            for (int ai = 0; ai < 2; ++ai)
#pragma unroll
                for (int m = 0; m < 4; ++m) { float* rowp = GT + ((size_t)u.ks * T + (size_t)(row0 + ai * HALF + m * 16)) * 48;
                    const float r_ = ((const PG8_LAS float*)(ldsb + RS_OFF))[wr * 64 + fr + ai * HALF + m * 16];
                    if (cl < 48) {
#pragma unroll
                        for (int n = 0; n < 2; ++n) *(f32x4*)(rowp + cl + 4 * n) = acc[ai][0][m][n] * r_; } }
            return;
        }
        size_t boff; int ld, colb; int mode = 0;
        if (pn < 8) { boff = WS_D; ld = DM; colb = pn * BM; mode = 1; }
        else if (pn < 20) { const int idx = pn - 8; boff = WS_E + (size_t)(idx >> 1) * ((size_t)T * 512 * 2); ld = 512; colb = (idx & 1) * BM; }
        else { boff = WS_G; ld = DM; colb = (pn - 20) * BM; mode = 2; }
        bf16_t* base = (bf16_t*)(ws + boff);
#pragma unroll
        for (int ai = 0; ai < 2; ++ai)
#pragma unroll
            for (int m = 0; m < 4; ++m) { bf16_t* rowp = base + (size_t)(row0 + ai * HALF + m * 16) * ld + colb + cl;
                const float r0_ = ((const PG8_LAS float*)(ldsb + RS_OFF))[wr * 64 + fr + ai * HALF + m * 16], r_ = mode == 1 ? r0_ * QSCALE : r0_;
#pragma unroll
                for (int bj = 0; bj < 2; ++bj) { f32x4 v0 = acc[ai][bj][m][0] * r_, v1 = acc[ai][bj][m][1] * r_;
                    if (mode == 2) {
#pragma unroll
                        for (int e = 0; e < 4; ++e) { v0[e] = v0[e] * sigmoidf_(v0[e]); v1[e] = v1[e] * sigmoidf_(v1[e]); } }
                    u32x4 w; w.x = cvt_pk_bf16(v0[0], v0[1]); w.y = cvt_pk_bf16(v0[2], v0[3]); w.z = cvt_pk_bf16(v1[0], v1[1]); w.w = cvt_pk_bf16(v1[2], v1[3]);
                    *(u32x4*)(rowp + bj * HALF) = w; } }
    }
};

template <class Epi, class Sched, bool ALIGN_EPI = false, bool SP2 = false>
__device__ __forceinline__ void gemm_phase(PG8_LAS unsigned char* lds, const Gemm g, const Sched& S, const Epi& E, const int tidv) {
    const int tid = tidv, wid = __builtin_amdgcn_readfirstlane(tid >> 6), lane = tid & 63, wr = wid >> 2, wc = wid & 3, fr = lane & 15, fq = lane >> 4;
    const int K = g.K, nt = K / BK;
    unsigned voffA[2], voffB[2];
#pragma unroll
    for (int i = 0; i < 2; ++i) { int R, C; stage_rc(tid * 16 + i * 8192, R, C); const int Rb = Epi::PERM ? ((R & ~31) + perm32(R & 31)) : R;
        voffA[i] = (unsigned)(R * K + C) * 2u; voffB[i] = (unsigned)(Rb * K + C) * 2u; }
    const size_t kstep = (size_t)(BK * 2);
    const size_t hstep = (size_t)HALF * K * 2;
    const size_t tstep = 2 * hstep;
    const unsigned ldsw = (unsigned)wid * 1024u;
    const int aoff = lds_byte(wr * 64 + fr, fq * 8), boff = lds_byte(wc * 32 + fr, fq * 8);
#define PG8_SA(b, h) (((b) * 2 + (h)) * HTB)
#define PG8_SB(b, h) ((4 + (b) * 2 + (h)) * HTB)
#define PG8_STAGE(bufoff, gbase, voff) do { _Pragma("unroll") for (int _i = 0; _i < 2; ++_i) \
        __builtin_amdgcn_global_load_lds((const unsigned*)((const char*)(gbase) + (voff)[_i]), (PG8_LAS unsigned*)(lds + (bufoff) + ldsw + _i * 8192), 16, 0, 0); } while (0)
#define PG8_LDA(dst, b, h) do { _Pragma("unroll") for (int m = 0; m < 4; ++m) _Pragma("unroll") for (int k = 0; k < 2; ++k) dst[m][k] = *(const PG8_LAS bf16x8*)(lds + PG8_SA(b, h) + aoff + m * 2048 + k * 1024); } while (0)
#define PG8_LDB(dst, b, h) do { _Pragma("unroll") for (int n = 0; n < 2; ++n) _Pragma("unroll") for (int k = 0; k < 2; ++k) dst[n][k] = *(const PG8_LAS bf16x8*)(lds + PG8_SB(b, h) + boff + n * 2048 + k * 1024); } while (0)
#define PG8_MMA(ai, bj, At, Bt) do { __builtin_amdgcn_s_setprio(1); _Pragma("unroll") for (int m = 0; m < 4; ++m) _Pragma("unroll") for (int n = 0; n < 2; ++n) _Pragma("unroll") for (int k = 0; k < 2; ++k) \
        acc[ai][bj][m][n] = __builtin_amdgcn_mfma_f32_16x16x32_bf16(Bt[n][k], At[m][k], acc[ai][bj][m][n], 0, 0, 0); __builtin_amdgcn_s_setprio(0); } while (0)
#define PG8_WAIT_V(n) asm volatile("s_waitcnt vmcnt(" #n ")" ::: "memory")
#define PG8_WAIT_L(n) asm volatile("s_waitcnt lgkmcnt(" #n ")" ::: "memory")
#define PG8_BAR __builtin_amdgcn_s_barrier()
#define PG8_SCHED __builtin_amdgcn_sched_barrier(0)
    Unit cur, nxt; int ui = 0;
    if (!S.next(0, cur)) return;
    f32x4 acc[2][2][4][2];
    if constexpr (Epi::ROWSCALE) E.load_rowscale(cur.pm, tid);
    if constexpr (Epi::INIT) E.init(acc, cur, wr, wc, fr, fq);
    else {
#pragma unroll
    for (int a = 0; a < 2; ++a)
#pragma unroll
        for (int b = 0; b < 2; ++b)
#pragma unroll
            for (int m = 0; m < 4; ++m)
#pragma unroll
                for (int n = 0; n < 2; ++n) acc[a][b][m][n] = (f32x4){0.f, 0.f, 0.f, 0.f};
    }
    bf16x8 At[4][2], B0[2][2], B1[2][2];
    const char* cA = (const char*)g.A + (size_t)cur.pm * tstep + S.kbytes(cur, K); const char* cB = (const char*)g.Bt + (size_t)cur.pn * tstep + S.kbytes(cur, K);
    S.a_ready(cur);
    if constexpr (SP2) {
        PG8_STAGE(PG8_SB(0, 0), cB, voffB); PG8_STAGE(PG8_SB(0, 1), cB + hstep, voffB); PG8_STAGE(PG8_SA(0, 0), cA, voffA); PG8_STAGE(PG8_SA(0, 1), cA + hstep, voffA);
        if (wr == 1) PG8_BAR;
        PG8_WAIT_V(2); PG8_BAR;
        PG8_STAGE(PG8_SB(1, 0), cB + kstep, voffB); PG8_STAGE(PG8_SA(1, 0), cA + kstep, voffA); PG8_STAGE(PG8_SB(1, 1), cB + hstep + kstep, voffB);
        PG8_WAIT_V(6); PG8_BAR;
    } else {
        PG8_STAGE(PG8_SB(0, 0), cB, voffB); PG8_STAGE(PG8_SA(0, 0), cA, voffA); PG8_STAGE(PG8_SB(0, 1), cB + hstep, voffB); PG8_STAGE(PG8_SA(0, 1), cA + hstep, voffA);
        if (wr == 1) PG8_BAR;
        PG8_WAIT_V(4); PG8_BAR;
        PG8_STAGE(PG8_SB(1, 0), cB + kstep, voffB); PG8_STAGE(PG8_SA(1, 0), cA + kstep, voffA); PG8_STAGE(PG8_SB(1, 1), cB + hstep + kstep, voffB);
        PG8_WAIT_V(6); PG8_BAR;
    }
    for (;;) {
        const bool has_next = S.next(ui + 1, nxt);
        const char* nA = has_next ? (const char*)g.A + (size_t)nxt.pm * tstep + S.kbytes(nxt, K) : cA; const char* nB = has_next ? (const char*)g.Bt + (size_t)nxt.pn * tstep + S.kbytes(nxt, K) : cB;
        const int ntc = S.nt(cur, nt);
        for (int t = 0; t < ntc; t += 2) {
            const bool last = (t == ntc - 2);
            const char* a1 = cA + (size_t)(t + 1) * kstep;
            const char* a2 = last ? nA : cA + (size_t)(t + 2) * kstep; const char* b2 = last ? nB : cB + (size_t)(t + 2) * kstep;
            const char* a3 = a2 + kstep; const char* b3 = b2 + kstep;
            if (last && has_next) S.a_ready(nxt);
            if constexpr (SP2) {
            PG8_LDB(B0, 0, 0); PG8_LDB(B1, 0, 1); PG8_SCHED; PG8_LDA(At, 0, 0); PG8_STAGE(PG8_SA(1, 1), a1 + hstep, voffA);
            PG8_WAIT_V(8); PG8_WAIT_L(0); PG8_BAR; PG8_MMA(0, 0, At, B0); PG8_MMA(0, 1, At, B1); PG8_BAR; PG8_SCHED;
            PG8_LDA(At, 0, 1); PG8_STAGE(PG8_SB(0, 0), b2, voffB); PG8_STAGE(PG8_SB(0, 1), b2 + hstep, voffB); PG8_STAGE(PG8_SA(0, 0), a2, voffA);
            PG8_WAIT_V(8); PG8_WAIT_L(0); PG8_BAR; PG8_MMA(1, 0, At, B0); PG8_MMA(1, 1, At, B1); PG8_BAR; PG8_SCHED;
            PG8_LDB(B0, 1, 0); PG8_LDB(B1, 1, 1); PG8_SCHED; PG8_LDA(At, 1, 0); PG8_STAGE(PG8_SA(0, 1), a2 + hstep, voffA);
            PG8_WAIT_V(8); PG8_WAIT_L(0); PG8_BAR; PG8_MMA(0, 0, At, B0); PG8_MMA(0, 1, At, B1); PG8_BAR; PG8_SCHED;
            PG8_LDA(At, 1, 1); PG8_STAGE(PG8_SB(1, 0), b3, voffB); PG8_STAGE(PG8_SB(1, 1), b3 + hstep, voffB); PG8_STAGE(PG8_SA(1, 0), a3, voffA);
            PG8_WAIT_V(8); PG8_WAIT_L(0); PG8_BAR; PG8_MMA(1, 0, At, B0); PG8_MMA(1, 1, At, B1); PG8_BAR; PG8_SCHED;
            } else {
            PG8_LDB(B0, 0, 0); PG8_SCHED; PG8_LDA(At, 0, 0); PG8_STAGE(PG8_SA(1, 1), a1 + hstep, voffA);
            PG8_WAIT_L(8); PG8_BAR; PG8_WAIT_L(0); PG8_MMA(0, 0, At, B0); PG8_BAR; PG8_SCHED;
            PG8_LDB(B1, 0, 1); PG8_STAGE(PG8_SB(0, 0), b2, voffB);
            PG8_BAR; PG8_WAIT_L(0); PG8_MMA(0, 1, At, B1); PG8_BAR;
            PG8_LDA(At, 0, 1); PG8_STAGE(PG8_SA(0, 0), a2, voffA);
            PG8_BAR; PG8_WAIT_L(0); PG8_MMA(1, 0, At, B0); PG8_BAR; PG8_SCHED;
            PG8_STAGE(PG8_SB(0, 1), b2 + hstep, voffB);
            PG8_WAIT_V(6); PG8_BAR; PG8_MMA(1, 1, At, B1); PG8_BAR;
            PG8_LDB(B0, 1, 0); PG8_SCHED; PG8_LDA(At, 1, 0); PG8_STAGE(PG8_SA(0, 1), a2 + hstep, voffA);
            PG8_WAIT_L(8); PG8_BAR; PG8_WAIT_L(0); PG8_MMA(0, 0, At, B0); PG8_BAR; PG8_SCHED;
            PG8_LDB(B1, 1, 1); PG8_STAGE(PG8_SB(1, 0), b3, voffB);
            PG8_BAR; PG8_WAIT_L(0); PG8_MMA(0, 1, At, B1); PG8_BAR;
            PG8_LDA(At, 1, 1); PG8_STAGE(PG8_SA(1, 0), a3, voffA);
            PG8_BAR; PG8_WAIT_L(0); PG8_MMA(1, 0, At, B0); PG8_BAR; PG8_SCHED;
            PG8_STAGE(PG8_SB(1, 1), b3 + hstep, voffB);
            PG8_WAIT_V(6); PG8_BAR; PG8_MMA(1, 1, At, B1); PG8_BAR;
            }
        }
        if constexpr (ALIGN_EPI) { if (wr == 0) PG8_BAR; }
        if constexpr (!Epi::AFTER_DRAIN) { E(acc, cur, wr, wc, fr, fq); S.done(cur); }
        if (!has_next) break;
        if constexpr (Epi::ROWSCALE) { if (nxt.pm != cur.pm) E.load_rowscale(nxt.pm, tid); }
        if constexpr (Epi::INIT) E.init(acc, nxt, wr, wc, fr, fq);
        else {
#pragma unroll
        for (int a = 0; a < 2; ++a)
#pragma unroll
            for (int b = 0; b < 2; ++b)
#pragma unroll
                for (int m = 0; m < 4; ++m)
#pragma unroll
                    for (int n = 0; n < 2; ++n) acc[a][b][m][n] = (f32x4){0.f, 0.f, 0.f, 0.f};
        }
        cur = nxt; cA = nA; cB = nB; ++ui;
        if constexpr (ALIGN_EPI) { if (wr == 1) PG8_BAR; }
    }
    PG8_WAIT_V(0);
    if constexpr (!ALIGN_EPI) { if (wr == 0) PG8_BAR; }
    PG8_BAR;
#undef PG8_SA
#undef PG8_SB
#undef PG8_STAGE
#undef PG8_LDA
#undef PG8_LDB
#undef PG8_MMA
#undef PG8_WAIT_V
#undef PG8_WAIT_L
#undef PG8_BAR
#undef PG8_SCHED
}
}

__device__ __forceinline__ int t5_bucket(int n) {
    if (n < 16) return n;
    const int large = 16 + (int)(logf((float)n / 16.f) / 2.0794415416798357f * 16.f);
    return large < 31 ? large : 31;
}
template <class ColMap>
__device__ __forceinline__ void transpose_item(const float* W, int Nsrc, int K, bf16_t* WT, LAS float* scr, int kb, int nb, int lane, ColMap cm, const float* kgain = nullptr, int kmask = -1) {
    const int k0 = 64 * kb, n0 = 32 * nb;
    const int kq = lane >> 3, n4 = 4 * (lane & 7);
    const int nsrc = cm(n0 + n4);
    f32x4 wv[8];
#pragma unroll
    for (int i = 0; i < 8; ++i) wv[i] = nsrc >= 0 ? *(const f32x4*)(W + (size_t)(k0 + 8 * i + kq) * Nsrc + nsrc) : (f32x4){0.f, 0.f, 0.f, 0.f};
    if (kgain != nullptr) {
#pragma unroll
        for (int i = 0; i < 8; ++i) wv[i] = wv[i] * kgain[(k0 + 8 * i + kq) & kmask]; }
#pragma unroll
    for (int i = 0; i < 8; ++i) { LAS float* d = scr + (8 * i + kq) * 33 + n4; d[0] = wv[i].x; d[1] = wv[i].y; d[2] = wv[i].z; d[3] = wv[i].w; }
    LDS_WAIT(); asm volatile("" ::: "memory");
    const int c = lane & 7;
#pragma unroll
    for (int j = 0; j < 4; ++j) { const int n = (lane >> 3) + 8 * j; const LAS float* s = scr + (8 * c) * 33 + n;
        u32x4 o; o.x = pk2(s[0 * 33], s[1 * 33]); o.y = pk2(s[2 * 33], s[3 * 33]); o.z = pk2(s[4 * 33], s[5 * 33]); o.w = pk2(s[6 * 33], s[7 * 33]);
        *(u32x4*)(WT + (size_t)(n0 + n) * K + k0 + 8 * c) = o; }
    LDS_WAIT(); asm volatile("" ::: "memory");
}
struct CmIdent { __device__ __forceinline__ int operator()(int n) const { return n; } };
struct CmNsaIn { __device__ __forceinline__ int operator()(int n) const { return n < 5120 ? n : (n < 7168 ? n + 48 : (n < N1IN ? n - 2048 : -1)); } };

__device__ __forceinline__ void rms_row_bf16(const float* xrow, const float* gain, bf16_t* orow, int lane) {
    const f32x4* xr = (const f32x4*)xrow + lane; const f32x4* gr = (const f32x4*)gain + lane;
    f32x4 v[8]; float s = 0.f;
#pragma unroll
    for (int j = 0; j < 8; ++j) { v[j] = xr[64 * j]; s += (v[j].x * v[j].x + v[j].y * v[j].y) + (v[j].z * v[j].z + v[j].w * v[j].w); }
    const float r = rsqrtf(wave_sum(s) * (1.f / DM) + RMS_EPS);
    u32x2* o8 = (u32x2*)orow + lane;
#pragma unroll
    for (int j = 0; j < 8; ++j) { const f32x4 g = gr[64 * j]; u32x2 w; w.x = pk2(v[j].x * r * g.x, v[j].y * r * g.y); w.y = pk2(v[j].z * r * g.z, v[j].w * r * g.w); o8[64 * j] = w; }
}
__device__ __forceinline__ void rms_row_f32(const float* xrow, const float* gain, float* orow, int lane) {
    const f32x4* xr = (const f32x4*)xrow + lane; const f32x4* gr = (const f32x4*)gain + lane;
    f32x4 v[8]; float s = 0.f;
#pragma unroll
    for (int j = 0; j < 8; ++j) { v[j] = xr[64 * j]; s += (v[j].x * v[j].x + v[j].y * v[j].y) + (v[j].z * v[j].z + v[j].w * v[j].w); }
    const float r = rsqrtf(wave_sum(s) * (1.f / DM) + RMS_EPS);
    f32x4* o = (f32x4*)orow + lane;
#pragma unroll
    for (int j = 0; j < 8; ++j) { const f32x4 g = gr[64 * j]; o[64 * j] = v[j] * r * g; }
}

__device__ __forceinline__ void p0_prep(const Params& p, unsigned char* lds_g) {
    const int tid = threadIdx.x, lane = tid & 63, wave = tid >> 6, G = gridDim.x, bx = blockIdx.x;
    const int gw = bx * 8 + wave, NGW = G * 8;
    float* misc = (float*)(p.ws + WS_MISC);
    if (bx == 0) {
        for (int c = tid; c < DM; c += 512) { const float a = p.hgrn_lb[c], b = p.hgrn_lb[DM + c], d = p.hgrn_lb[2 * DM + c]; const float m = fmaxf(a, fmaxf(b, d));
            const float ea = expf(a - m), eb = expf(b - m), ed = expf(d - m); misc[MISC_LB / 4 + c] = ea / (ea + eb + ed); }
    }
    if (bx == 1 % G) {
        for (int e = tid; e < NH * 128; e += 512) { const int head = e >> 7, dist = e & 127; misc[MISC_BIASP / 4 + e] = p.rel_bias[t5_bucket(dist) * NH + head] - p.rel_bias[31 * NH + head]; }
    }
    if (bx >= 2 && bx < 18 && G >= 18) {
        const int which = (bx - 2) >> 3, slice = (bx - 2) & 7;
        const float* pe = which ? p.pe_v : p.pe_k; const float* w1 = which ? p.pv_w1 : p.pk_w1;
        float* red = (float*)lds_g;
        const int n = tid & 127, part = tid >> 7; float s = 0.f;
        const int r0 = slice * 512 + part * 128;
#pragma unroll 16
        for (int r = r0; r < r0 + 128; ++r) s += pe[r] * w1[(size_t)r * 128 + n];
        __syncthreads(); red[part * 128 + n] = s; __syncthreads();
        if (tid < 128) misc[MISC_CVP / 4 + (which * 8 + slice) * 128 + tid] = (red[tid] + red[128 + tid]) + (red[256 + tid] + red[384 + tid]);
        __syncthreads();
    }
    LAS float* scr = (LAS float*)((LAS unsigned char*)lds_g + 4096 + wave * 8704);
    constexpr int I0IN = 32 * (N0IN / 32), IOUT = 32 * (DM / 32), I1IN = 32 * (N1PAD / 32);
    constexpr int IW1 = (4096 / 64) * (128 / 32), IW2 = (128 / 64) * (128 / 32);
    constexpr int NITEMS = I0IN + IOUT + I1IN + IOUT + 2 * IW1 + 2 * IW2;
    for (int it = gw; it < NITEMS; it += NGW) {
        int r = it;
        if (r < I0IN) { transpose_item(p.hgrn_w_in, N0IN, DM, (bf16_t*)(p.ws + WS_W0IN), scr, r / (N0IN / 32), r % (N0IN / 32), lane, CmIdent()); continue; } r -= I0IN;
        if (r < IOUT) { transpose_item(p.hgrn_w_out, DM, DM, (bf16_t*)(p.ws + WS_W0OUT), scr, r / (DM / 32), r % (DM / 32), lane, CmIdent(), p.hgrn_head_gain, HD - 1); continue; } r -= IOUT;
        if (r < I1IN) { transpose_item(p.nsa_w_in, N1IN, DM, (bf16_t*)(p.ws + WS_W1IN), scr, r / (N1PAD / 32), r % (N1PAD / 32), lane, CmNsaIn(), p.norm_gains + DM); continue; } r -= I1IN;
        if (r < IOUT) { transpose_item(p.nsa_w_out, DM, DM, (bf16_t*)(p.ws + WS_W1OUT), scr, r / (DM / 32), r % (DM / 32), lane, CmIdent()); continue; } r -= IOUT;
        if (r < IW1) { transpose_item(p.pk_w1, 128, 4096, (bf16_t*)(p.ws + WS_W1K), scr, r / 4, r % 4, lane, CmIdent()); continue; } r -= IW1;
        if (r < IW1) { transpose_item(p.pv_w1, 128, 4096, (bf16_t*)(p.ws + WS_W1V), scr, r / 4, r % 4, lane, CmIdent()); continue; } r -= IW1;
        if (r < IW2) { transpose_item(p.pk_w2, 128, 128, (bf16_t*)(p.ws + WS_W2K), scr, r / 4, r % 4, lane, CmIdent()); continue; } r -= IW2;
        transpose_item(p.pv_w2, 128, 128, (bf16_t*)(p.ws + WS_W2V), scr, r / 4, r % 4, lane, CmIdent());
    }
}

__device__ __forceinline__ void hgrn_naive(const Params& p, unsigned char* lds_g) {
    const int tid = threadIdx.x;
    const bf16_t* Q0 = (const bf16_t*)(p.ws + WS_B); const bf16_t* V0 = (const bf16_t*)(p.ws + WS_B + 64 * MiB);
    const float* LOGF = p.out; bf16_t* O0 = (bf16_t*)(p.ws + WS_E);
    float* qs = (float*)lds_g; float* fs = qs + 16 * 128; float* part = fs + 16 * 128;
    const int v = tid & 127, kq = tid >> 7;
    for (int unit = blockIdx.x; unit < NB * NH; unit += gridDim.x) {
        const int b = unit / NH, h = unit % NH;
        float S[32];
#pragma unroll
        for (int i = 0; i < 32; ++i) S[i] = 0.f;
        for (int t0 = 0; t0 < SEQ; t0 += 16) {
            __syncthreads();
            for (int e = tid; e < 2048; e += 512) { const int tt = e >> 7, k = e & 127; const size_t idx = (size_t)(b * SEQ + t0 + tt) * DM + h * HD + k;
                qs[e] = bf2f(Q0[idx]); fs[e] = __expf(LOGF[idx]); }
            __syncthreads();
            for (int tt = 0; tt < 16; ++tt) {
                const float vv = bf2f(V0[(size_t)(b * SEQ + t0 + tt) * DM + h * HD + v]);
                float o = 0.f;
#pragma unroll
                for (int kk = 0; kk < 32; ++kk) { const float f = fs[tt * 128 + kq * 32 + kk]; S[kk] = f * S[kk] + (1.f - f) * vv; o += S[kk] * qs[tt * 128 + kq * 32 + kk]; }
                part[(tt * 4 + kq) * 128 + v] = o;
            }
            __syncthreads();
            for (int e = tid; e < 2048; e += 512) { const int tt = e >> 7, vx = e & 127;
                const float o = (part[(tt * 4 + 0) * 128 + vx] + part[(tt * 4 + 1) * 128 + vx]) + (part[(tt * 4 + 2) * 128 + vx] + part[(tt * 4 + 3) * 128 + vx]);
                O0[(size_t)(b * SEQ + t0 + tt) * DM + h * HD + vx] = (bf16_t)f2bf(o); }
        }
    }
}
typedef float f32x16 __attribute__((ext_vector_type(16)));
__device__ __forceinline__ int crow(int r, int hi) { return (r & 3) + 8 * (r >> 2) + 4 * hi; }
namespace hg {
constexpr int RS = 272, RS2 = 144;
constexpr int QS = 0, QD = 17408, KS = 34816, KST = 52224, VT = 70656, PP = 75264, SOP0 = 84480, SOP1 = 93184, SEGT = 101888, VEC = 105984;
}
__device__ __forceinline__ u32x2 pack4bf(float a, float b, float c, float d) { u32x2 w; w.x = pg8::cvt_pk_bf16(a, b); w.y = pg8::cvt_pk_bf16(c, d); return w; }
__device__ __forceinline__ void hgrn_chunk(const Params& p, unsigned char* lds_g) {
    using namespace hg;
    LAS unsigned char* L = (LAS unsigned char*)lds_g;
    const int tid = threadIdx.x, lane = tid & 63, wave = __builtin_amdgcn_readfirstlane(tid >> 6), r32 = lane & 31, hi = lane >> 5;
    const bf16_t* Q0 = (const bf16_t*)(p.ws + WS_B); const bf16_t* V0 = (const bf16_t*)(p.ws + WS_B + 64 * MiB);
    const float* LOGF = p.out; bf16_t* O0 = (bf16_t*)(p.ws + WS_E);
    const int vs = tid >> 3, vv4 = (tid & 7) * 4;
    for (int unit = blockIdx.x; unit < 256; unit += gridDim.x) {
        const int bh = unit & 63, c4 = unit >> 6, b = bh >> 4, h = bh & 15;
        const size_t rowb = (size_t)b * SEQ; const int colb = h * HD;
        f32x16 S;
#pragma unroll
        for (int i = 0; i < 16; ++i) S[i] = 0.f;
        __syncthreads();
        for (int e = tid; e < (SOP1 - SOP0) / 4; e += 512) ((LAS unsigned*)(L + SOP0))[e] = 0u;
        int cur = 0;
        f32x2 lf[8]; unsigned qv[8]; u32x2 vraw;
#pragma unroll
        for (int i = 0; i < 8; ++i) { const size_t idx = (rowb + 8 * wave + i) * DM + colb + 2 * lane; lf[i] = *(const f32x2*)(LOGF + idx); qv[i] = *(const unsigned*)(Q0 + idx); }
        vraw = *(const u32x2*)(V0 + (rowb + vs) * DM + colb + c4 * 32 + vv4);
        for (int c = 0; c < 64; ++c) {
            float c0[8], c1[8]; float s0 = 0.f, s1 = 0.f;
#pragma unroll
            for (int i = 0; i < 8; ++i) { s0 += lf[i].x; c0[i] = s0; s1 += lf[i].y; c1[i] = s1; }
            *(LAS f32x2*)(L + SEGT + (wave * 128 + 2 * lane) * 4) = (f32x2){s0, s1};
            LDS_BARRIER();
            float pre0 = 0.f, pre1 = 0.f, br0 = 0.f, br1 = 0.f, bl0 = 0.f, bl1 = 0.f;
#pragma unroll
            for (int w = 0; w < 8; ++w) { const f32x2 v = *(const LAS f32x2*)(L + SEGT + (w * 128 + 2 * lane) * 4);
                if (w < wave) { pre0 += v.x; pre1 += v.y; } if (w < 4) { br0 += v.x; br1 += v.y; } bl0 += v.x; bl1 += v.y; }
            const float er0 = __expf(br0), er1 = __expf(br1);
            if (wave == 0) { *(LAS f32x2*)(L + VEC + (2 * lane) * 4) = (f32x2){__expf(bl0 - br0), __expf(bl1 - br1)}; *(LAS f32x2*)(L + VEC + 512 + (2 * lane) * 4) = (f32x2){__expf(bl0), __expf(bl1)}; }
            float kt0[8], kt1[8];
#pragma unroll
            for (int i = 0; i < 8; ++i) { const int t = 8 * wave + i;
                const float q0 = __uint_as_float(qv[i] << 16), q1 = __uint_as_float(qv[i] & 0xffff0000u);
                const float d0 = fminf(fmaxf(pre0 + c0[i] - br0, -80.f), 80.f), d1 = fminf(fmaxf(pre1 + c1[i] - br1, -80.f), 80.f);
                const float k0 = 1.f - __expf(lf[i].x), k1 = 1.f - __expf(lf[i].y);
                const float qs0 = q0 * __expf(d0), qs1 = q1 * __expf(d1), ks0 = k0 * __expf(-d0), ks1 = k1 * __expf(-d1);
                *(LAS unsigned*)(L + QS + t * RS + 4 * lane) = pg8::cvt_pk_bf16(qs0, qs1);
                *(LAS unsigned*)(L + QD + t * RS + 4 * lane) = pg8::cvt_pk_bf16(qs0 * er0, qs1 * er1);
                *(LAS unsigned*)(L + KS + t * RS + 4 * lane) = pg8::cvt_pk_bf16(ks0, ks1);
                kt0[i] = ks0; kt1[i] = ks1; }
            { u32x4 w0, w1;
              w0.x = pg8::cvt_pk_bf16(kt0[0], kt0[1]); w0.y = pg8::cvt_pk_bf16(kt0[2], kt0[3]); w0.z = pg8::cvt_pk_bf16(kt0[4], kt0[5]); w0.w = pg8::cvt_pk_bf16(kt0[6], kt0[7]);
              w1.x = pg8::cvt_pk_bf16(kt1[0], kt1[1]); w1.y = pg8::cvt_pk_bf16(kt1[2], kt1[3]); w1.z = pg8::cvt_pk_bf16(kt1[4], kt1[5]); w1.w = pg8::cvt_pk_bf16(kt1[6], kt1[7]);
              *(LAS u32x4*)(L + KST + (2 * lane) * RS2 + 16 * wave) = w0; *(LAS u32x4*)(L + KST + (2 * lane + 1) * RS2 + 16 * wave) = w1; }
            { LAS bf16_t* vt = (LAS bf16_t*)(L + VT);
              vt[(vv4 + 0) * (RS2 / 2) + vs] = (bf16_t)(vraw.x & 0xffff); vt[(vv4 + 1) * (RS2 / 2) + vs] = (bf16_t)(vraw.x >> 16);
              vt[(vv4 + 2) * (RS2 / 2) + vs] = (bf16_t)(vraw.y & 0xffff); vt[(vv4 + 3) * (RS2 / 2) + vs] = (bf16_t)(vraw.y >> 16); }
            if (c + 1 < 64) {
#pragma unroll
                for (int i = 0; i < 8; ++i) { const size_t idx = (rowb + 64 * (c + 1) + 8 * wave + i) * DM + colb + 2 * lane; lf[i] = *(const f32x2*)(LOGF + idx); qv[i] = *(const unsigned*)(Q0 + idx); }
                vraw = *(const u32x2*)(V0 + (rowb + 64 * (c + 1) + vs) * DM + colb + c4 * 32 + vv4);
            }
            LDS_BARRIER();
            const int sopc = cur ? SOP1 : SOP0, sopn = cur ? SOP0 : SOP1;
            if (wave < 3) {
                const int si = wave >> 1, ti = (wave + 1) >> 1;
                f32x16 acc;
#pragma unroll
                for (int i = 0; i < 16; ++i) acc[i] = 0.f;
#pragma unroll
                for (int ks = 0; ks < 8; ++ks) { const bf16x8 a = *(const LAS bf16x8*)(L + KS + (32 * si + r32) * RS + 32 * ks + 16 * hi);
                    const bf16x8 bq = *(const LAS bf16x8*)(L + QS + (32 * ti + r32) * RS + 32 * ks + 16 * hi);
                    acc = __builtin_amdgcn_mfma_f32_32x32x16_bf16(a, bq, acc, 0, 0, 0); }
                const int t = 32 * ti + r32;
#pragma unroll
                for (int q = 0; q < 16; ++q) { const int sidx = 32 * si + crow(q, hi); if (sidx > t) acc[q] = 0.f; }
#pragma unroll
                for (int g = 0; g < 4; ++g) *(LAS u32x2*)(L + PP + t * RS2 + (32 * si + 8 * g + 4 * hi) * 2) = pack4bf(acc[4 * g], acc[4 * g + 1], acc[4 * g + 2], acc[4 * g + 3]);
            } else if (wave >= 4) {
                const int kt = wave - 4;
                f32x16 U;
#pragma unroll
                for (int i = 0; i < 16; ++i) U[i] = 0.f;
#pragma unroll
                for (int ss = 0; ss < 4; ++ss) { const bf16x8 a = *(const LAS bf16x8*)(L + KST + (32 * kt + r32) * RS2 + 32 * ss + 16 * hi);
                    const bf16x8 bv = *(const LAS bf16x8*)(L + VT + r32 * RS2 + 32 * ss + 16 * hi);
                    U = __builtin_amdgcn_mfma_f32_32x32x16_bf16(a, bv, U, 0, 0, 0); }
#pragma unroll
                for (int g = 0; g < 4; ++g) { const int k0 = 32 * kt + 8 * g + 4 * hi;
                    const f32x4 el = *(const LAS f32x4*)(L + VEC + k0 * 4), dl = *(const LAS f32x4*)(L + VEC + 512 + k0 * 4);
#pragma unroll
                    for (int e = 0; e < 4; ++e) S[4 * g + e] = dl[e] * S[4 * g + e] + el[e] * U[4 * g + e];
                    *(LAS u32x2*)(L + sopn + r32 * RS + k0 * 2) = pack4bf(S[4 * g], S[4 * g + 1], S[4 * g + 2], S[4 * g + 3]); }
            }
            LDS_BARRIER();
            if (wave < 2) {
                const int ti = wave;
                f32x16 o;
#pragma unroll
                for (int i = 0; i < 16; ++i) o[i] = 0.f;
#pragma unroll
                for (int ks = 0; ks < 8; ++ks) { const bf16x8 a = *(const LAS bf16x8*)(L + QD + (32 * ti + r32) * RS + 32 * ks + 16 * hi);
                    const bf16x8 bs = *(const LAS bf16x8*)(L + sopc + r32 * RS + 32 * ks + 16 * hi);
                    o = __builtin_amdgcn_mfma_f32_32x32x16_bf16(a, bs, o, 0, 0, 0); }
#pragma unroll
                for (int ss = 0; ss < 4; ++ss) { if (ss < 2 || ti == 1) {
                    const bf16x8 a = *(const LAS bf16x8*)(L + PP + (32 * ti + r32) * RS2 + 32 * ss + 16 * hi);
                    const bf16x8 bv = *(const LAS bf16x8*)(L + VT + r32 * RS2 + 32 * ss + 16 * hi);
                    o = __builtin_amdgcn_mfma_f32_32x32x16_bf16(a, bv, o, 0, 0, 0); } }
                bf16_t* orow = O0 + (rowb + 64 * c + 32 * ti) * DM + colb + c4 * 32 + r32;
#pragma unroll
                for (int q = 0; q < 16; ++q) orow[(size_t)crow(q, hi) * DM] = (bf16_t)f2bf(o[q]);
            }
            cur ^= 1;
        }
    }
}
namespace hg2 {
constexpr int RS = 272, RS2 = 144;
constexpr int QS = 0, KS = 17408, KST = 34816, VT = 53248, VEC = 57856, SETSZ = 59392;
constexpr int PP = 2 * SETSZ, SOP0 = PP + 9216, SOP1 = SOP0 + 8704, SEGT = SOP1 + 8704;
}
__device__ __forceinline__ void hgrn_chunk2(const Params& p, unsigned char* lds_g) {
    using namespace hg2;
    LAS unsigned char* L = (LAS unsigned char*)lds_g;
    const int tid = threadIdx.x, lane = tid & 63, wave = __builtin_amdgcn_readfirstlane(tid >> 6), r32 = lane & 31, hi = lane >> 5;
    const bf16_t* Q0 = (const bf16_t*)(p.ws + WS_B); const bf16_t* V0 = (const bf16_t*)(p.ws + WS_B + 64 * MiB);
    const float* LOGF = p.out; bf16_t* O0 = (bf16_t*)(p.ws + WS_E);
    const bool isP = wave < 4;
    const int vs = (tid & 255) >> 2, v8 = (tid & 3) * 8;
    for (int unit = blockIdx.x; unit < 256; unit += gridDim.x) {
        const int bh = unit & 63, c4 = unit >> 6, b = bh >> 4, h = bh & 15;
        const size_t rowb = (size_t)b * SEQ; const int colb = h * HD;
        __syncthreads();
        f32x16 S;
#pragma unroll
        for (int i = 0; i < 16; ++i) S[i] = 0.f;
        f32x2 lf[16], lfn[16]; unsigned qv[16], qvn[16]; u32x4 vraw, vrawn;
#define HG_LOAD_RAW(cn_, lf, qv, vraw) do { _Pragma("unroll") for (int i = 0; i < 16; ++i) { const size_t ro_ = (rowb + 64 * (cn_) + 16 * wave + i) * DM + colb;     \
            lf[i] = *(const f32x2*)((LOGF + ro_) + 2 * lane); qv[i] = *(const unsigned*)((Q0 + ro_) + 2 * lane); } \
            vraw = *(const u32x4*)((V0 + (rowb + 64 * (cn_)) * DM + colb + c4 * 32) + vs * DM + v8); } while (0)
        if (isP) HG_LOAD_RAW(0, lf, qv, vraw);
        for (int it = -1; it < 64; ++it) {
            const int cn = it + 1;
            LAS unsigned char* Sc = L + (it & 1) * SETSZ;
            LAS unsigned char* Sn = L + (cn & 1) * SETSZ;
            const int sopc = (it & 1) ? SOP1 : SOP0, sopn = (it & 1) ? SOP0 : SOP1;
            if (isP) {
                if (cn < 64) {
                    float s0 = 0.f, s1 = 0.f;
#pragma unroll
                    for (int i = 0; i < 16; ++i) { s0 += lf[i].x; s1 += lf[i].y; }
                    *(LAS f32x2*)(L + SEGT + (wave * 128 + 2 * lane) * 4) = (f32x2){s0, s1};
                }
            } else {
                const int mw = wave - 4;
                if (it < 0) { for (int e = lane + 64 * mw; e < 8704 / 4; e += 256) ((LAS unsigned*)(L + SOP0))[e] = 0u; }
                else {
                    f32x16 U;
#pragma unroll
                    for (int i = 0; i < 16; ++i) U[i] = 0.f;
#pragma unroll
                    for (int ss = 0; ss < 4; ++ss) { const bf16x8 a = *(const LAS bf16x8*)(Sc + KST + (32 * mw + r32) * RS2 + 32 * ss + 16 * hi);
                        const bf16x8 bv = *(const LAS bf16x8*)(Sc + VT + r32 * RS2 + 32 * ss + 16 * hi);
                        U = __builtin_amdgcn_mfma_f32_32x32x16_bf16(a, bv, U, 0, 0, 0); }
#pragma unroll
                    for (int g = 0; g < 4; ++g) { const int k0 = 32 * mw + 8 * g + 4 * hi;
                        const f32x4 el = *(const LAS f32x4*)(Sc + VEC + k0 * 4), dl = *(const LAS f32x4*)(Sc + VEC + 512 + k0 * 4);
#pragma unroll
                        for (int e = 0; e < 4; ++e) S[4 * g + e] = dl[e] * S[4 * g + e] + el[e] * U[4 * g + e]; }
                    if (mw < 3) {
                        const int si = mw >> 1, ti = (mw + 1) >> 1;
                        f32x16 acc;
#pragma unroll
                        for (int i = 0; i < 16; ++i) acc[i] = 0.f;
#pragma unroll
                        for (int ks = 0; ks < 8; ++ks) { const bf16x8 a = *(const LAS bf16x8*)(Sc + KS + (32 * si + r32) * RS + 32 * ks + 16 * hi);
                            const bf16x8 bq = *(const LAS bf16x8*)(Sc + QS + (32 * ti + r32) * RS + 32 * ks + 16 * hi);
                            acc = __builtin_amdgcn_mfma_f32_32x32x16_bf16(a, bq, acc, 0, 0, 0); }
                        const int t = 32 * ti + r32;
#pragma unroll
                        for (int q = 0; q < 16; ++q) { const int sidx = 32 * si + crow(q, hi); if (sidx > t) acc[q] = 0.f; }
#pragma unroll
                        for (int g = 0; g < 4; ++g) *(LAS u32x2*)(L + PP + t * RS2 + (32 * si + 8 * g + 4 * hi) * 2) = pack4bf(acc[4 * g], acc[4 * g + 1], acc[4 * g + 2], acc[4 * g + 3]);
                    }
                }
            }
            LDS_BARRIER();
            if (isP) {
                if (cn < 64) {
                    if (cn + 1 < 64) HG_LOAD_RAW(cn + 1, lfn, qvn, vrawn);
                    float pre0 = 0.f, pre1 = 0.f, br0 = 0.f, br1 = 0.f, bl0 = 0.f, bl1 = 0.f;
#pragma unroll
                    for (int w = 0; w < 4; ++w) { const f32x2 v = *(const LAS f32x2*)(L + SEGT + (w * 128 + 2 * lane) * 4);
                        if (w < wave) { pre0 += v.x; pre1 += v.y; } if (w < 2) { br0 += v.x; br1 += v.y; } bl0 += v.x; bl1 += v.y; }
                    if (wave == 0) { *(LAS f32x2*)(Sn + VEC + (2 * lane) * 4) = (f32x2){__expf(bl0 - br0), __expf(bl1 - br1)}; *(LAS f32x2*)(Sn + VEC + 512 + (2 * lane) * 4) = (f32x2){__expf(bl0), __expf(bl1)}; }
                    unsigned kt0[8], kt1[8]; float kp0 = 0.f, kp1 = 0.f;
                    float b0 = pre0 - br0, b1 = pre1 - br1;
#pragma unroll
                    for (int i = 0; i < 16; ++i) { const int t = 16 * wave + i;
                        const float q0 = __uint_as_float(qv[i] << 16), q1 = __uint_as_float(qv[i] & 0xffff0000u);
                        b0 += lf[i].x; b1 += lf[i].y;
                        const float d0 = fminf(fmaxf(b0, -80.f), 80.f), d1 = fminf(fmaxf(b1, -80.f), 80.f);
                        const float ks0 = (1.f - __expf(lf[i].x)) * __expf(-d0), ks1 = (1.f - __expf(lf[i].y)) * __expf(-d1);
                        *(LAS unsigned*)(Sn + QS + t * RS + 4 * lane) = pg8::cvt_pk_bf16(q0 * __expf(d0), q1 * __expf(d1));
                        *(LAS unsigned*)(Sn + KS + t * RS + 4 * lane) = pg8::cvt_pk_bf16(ks0, ks1);
                        if (i & 1) { kt0[i >> 1] = pg8::cvt_pk_bf16(kp0, ks0); kt1[i >> 1] = pg8::cvt_pk_bf16(kp1, ks1); }
                        else { kp0 = ks0; kp1 = ks1; } }
                    *(LAS u32x4*)(Sn + KST + (2 * lane) * RS2 + 32 * wave) = (u32x4){kt0[0], kt0[1], kt0[2], kt0[3]}; *(LAS u32x4*)(Sn + KST + (2 * lane) * RS2 + 32 * wave + 16) = (u32x4){kt0[4], kt0[5], kt0[6], kt0[7]};
                    *(LAS u32x4*)(Sn + KST + (2 * lane + 1) * RS2 + 32 * wave) = (u32x4){kt1[0], kt1[1], kt1[2], kt1[3]}; *(LAS u32x4*)(Sn + KST + (2 * lane + 1) * RS2 + 32 * wave + 16) = (u32x4){kt1[4], kt1[5], kt1[6], kt1[7]};
                    { LAS bf16_t* vt = (LAS bf16_t*)(Sn + VT);
                      vt[(v8 + 0) * (RS2 / 2) + vs] = (bf16_t)(vraw.x & 0xffff); vt[(v8 + 1) * (RS2 / 2) + vs] = (bf16_t)(vraw.x >> 16);
                      vt[(v8 + 2) * (RS2 / 2) + vs] = (bf16_t)(vraw.y & 0xffff); vt[(v8 + 3) * (RS2 / 2) + vs] = (bf16_t)(vraw.y >> 16);
                      vt[(v8 + 4) * (RS2 / 2) + vs] = (bf16_t)(vraw.z & 0xffff); vt[(v8 + 5) * (RS2 / 2) + vs] = (bf16_t)(vraw.z >> 16);
                      vt[(v8 + 6) * (RS2 / 2) + vs] = (bf16_t)(vraw.w & 0xffff); vt[(v8 + 7) * (RS2 / 2) + vs] = (bf16_t)(vraw.w >> 16); }
#pragma unroll
                    for (int i = 0; i < 16; ++i) { lf[i] = lfn[i]; qv[i] = qvn[i]; }
                    vraw = vrawn;
                }
            } else if (it >= 0) {
                const int mw = wave - 4;
                if (cn < 64) {
#pragma unroll
                    for (int g = 0; g < 4; ++g) { const int k0 = 32 * mw + 8 * g + 4 * hi;
                        const f32x4 s0 = *(const LAS f32x4*)(L + SEGT + k0 * 4), s1 = *(const LAS f32x4*)(L + SEGT + (128 + k0) * 4);
                        *(LAS u32x2*)(L + sopn + r32 * RS + k0 * 2) = pack4bf(S[4 * g] * __expf(s0[0] + s1[0]), S[4 * g + 1] * __expf(s0[1] + s1[1]), S[4 * g + 2] * __expf(s0[2] + s1[2]), S[4 * g + 3] * __expf(s0[3] + s1[3])); }
                }
                if (mw < 2) {
                    const int ti = mw;
                    f32x16 o;
#pragma unroll
                    for (int i = 0; i < 16; ++i) o[i] = 0.f;
#pragma unroll
                    for (int ks = 0; ks < 8; ++ks) { const bf16x8 a = *(const LAS bf16x8*)(Sc + QS + (32 * ti + r32) * RS + 32 * ks + 16 * hi);
                        const bf16x8 bs = *(const LAS bf16x8*)(L + sopc + r32 * RS + 32 * ks + 16 * hi);
                        o = __builtin_amdgcn_mfma_f32_32x32x16_bf16(a, bs, o, 0, 0, 0); }
#pragma unroll
                    for (int ss = 0; ss < 4; ++ss) { if (ss < 2 || ti == 1) {
                        const bf16x8 a = *(const LAS bf16x8*)(L + PP + (32 * ti + r32) * RS2 + 32 * ss + 16 * hi);
                        const bf16x8 bv = *(const LAS bf16x8*)(Sc + VT + r32 * RS2 + 32 * ss + 16 * hi);
                        o = __builtin_amdgcn_mfma_f32_32x32x16_bf16(a, bv, o, 0, 0, 0); } }
                    bf16_t* orow = O0 + (rowb + 64 * it + 32 * ti) * DM + colb + c4 * 32 + r32;
#pragma unroll
                    for (int q = 0; q < 16; ++q) orow[(size_t)crow(q, hi) * DM] = (bf16_t)f2bf(o[q]);
                }
            }
            LDS_BARRIER();
        }
#undef HG_LOAD_RAW
    }
}
namespace hg3 {
constexpr int RS = 272, RS2 = 144;
constexpr int QS = 0, KS = 17408, VT = 33792, VEC = 37888, SETSZ = 38912;
constexpr int PP = 2 * SETSZ, SOP0 = PP + 9216, SOP1 = SOP0 + 8704, SEGT = SOP1 + 8704;
struct Raw { f16x4 lf[8]; u32x2 q[8]; u32x4 v; };
typedef short v4i16_t __attribute__((ext_vector_type(4)));
__device__ __forceinline__ int offb(int row, int ch) { return 256 * row + 16 * (ch ^ (((row & 3) << 2) | ((row >> 2) & 3))); }
__device__ __forceinline__ v4i16_t trrd(const LAS unsigned char* p) { return __builtin_amdgcn_ds_read_tr16_b64_v4i16((LAS v4i16_t*)p); }
__device__ __forceinline__ bf16x8 tr_frag_ks(const LAS unsigned char* Kb, int lane, int c, int ks) {
    const int h = lane >> 5, blk = (lane >> 4) & 1, q = (lane & 15) >> 2, pp = lane & 3, r0 = 16 * ks + 8 * h + q, ch = 4 * c + 2 * blk + (pp >> 1);
    const v4i16_t lo = trrd(Kb + offb(r0, ch) + 8 * (pp & 1)), hi4 = trrd(Kb + offb(r0 + 4, ch) + 8 * (pp & 1));
    return (bf16x8){lo[0], lo[1], lo[2], lo[3], hi4[0], hi4[1], hi4[2], hi4[3]};
}
__device__ __forceinline__ bf16x8 tr_frag_v(const LAS unsigned char* Vb, int lane, int ks) {
    const int h = lane >> 5, blk = (lane >> 4) & 1, q = (lane & 15) >> 2, pp = lane & 3;
    const LAS unsigned char* a = Vb + (16 * ks + 8 * h + q) * 64 + (2 * blk + (pp >> 1)) * 16 + 8 * (pp & 1);
    const v4i16_t lo = trrd(a), hi4 = trrd(a + 4 * 64);
    return (bf16x8){lo[0], lo[1], lo[2], lo[3], hi4[0], hi4[1], hi4[2], hi4[3]};
}
}
__device__ __forceinline__ void hg3_a1(LAS unsigned char* L, const hg3::Raw& R, int sg, int k4, int sb, int segt = hg3::SEGT) {
    f32x4 s = __builtin_convertvector(R.lf[0], f32x4);
#pragma unroll
    for (int i = 1; i < 8; ++i) s += __builtin_convertvector(R.lf[i], f32x4);
    *(LAS f32x4*)(L + segt + sb * 4096 + (sg * 128 + k4) * 4) = s;
}
struct HgA2 { f32x4 bb; };
template <int HALF>
__device__ __forceinline__ void hg3_a2h(LAS unsigned char* L, LAS unsigned char* Sn, const hg3::Raw& R, int sg, int k4, int sb, int vs, int v8, HgA2& st, int segt = hg3::SEGT, bool wr_br = false) {
    using namespace hg3;
    if (HALF == 0) {
        f32x4 pre = {0.f, 0.f, 0.f, 0.f}, br = pre, bl = pre;
#pragma unroll
        for (int w = 0; w < 8; ++w) { const f32x4 v = *(const LAS f32x4*)(L + segt + sb * 4096 + (w * 128 + k4) * 4); if (w < sg) pre += v; if (w < 4) br += v; bl += v; }
        if (sg == 0) { f32x4 el, dl;
#pragma unroll
            for (int e = 0; e < 4; ++e) { el[e] = __expf(bl[e] - br[e]); dl[e] = __expf(bl[e]); }
            *(LAS f32x4*)(Sn + VEC + k4 * 4) = el; *(LAS f32x4*)(Sn + VEC + 512 + k4 * 4) = dl; if (wr_br) *(LAS f32x4*)(Sn + VEC + 1024 + k4 * 4) = br; }
        st.bb = pre - br;
    }
#pragma unroll
    for (int i = 4 * HALF; i < 4 * HALF + 4; ++i) { const int t = 8 * sg + i;
        float q[4]; q[0] = __uint_as_float(R.q[i].x << 16); q[1] = __uint_as_float(R.q[i].x & 0xffff0000u); q[2] = __uint_as_float(R.q[i].y << 16); q[3] = __uint_as_float(R.q[i].y & 0xffff0000u);
        const f32x4 lfi = __builtin_convertvector(R.lf[i], f32x4);
        st.bb += lfi;
        float qs[4], ks[4];
#pragma unroll
        for (int e = 0; e < 4; ++e) { const float d = fminf(fmaxf(st.bb[e], -80.f), 80.f); qs[e] = q[e] * __expf(d); ks[e] = (1.f - __expf(lfi[e])) * __expf(-d); }
        *(LAS u32x2*)(Sn + QS + t * RS + k4 * 2) = pack4bf(qs[0], qs[1], qs[2], qs[3]);
        *(LAS u32x2*)(Sn + KS + offb(t, k4 >> 3) + (k4 & 4) * 2) = pack4bf(ks[0], ks[1], ks[2], ks[3]); }
    if (HALF == 1) *(LAS u32x4*)(Sn + VT + vs * 64 + v8 * 2) = R.v;
}
struct HgA2p { f32x4 tt; };
template <int HALF>
__device__ __forceinline__ void hg3_a2p(LAS unsigned char* L, LAS unsigned char* Sn, const hg3::Raw& R, int sg, int k4, int sb, int vs, int v8, HgA2p& st, int segt) {
    using namespace hg3;
    if (HALF == 0) {
        f32x4 pre = {0.f, 0.f, 0.f, 0.f}, br = pre, bl = pre;
#pragma unroll
        for (int w = 0; w < 8; ++w) { const f32x4 v = *(const LAS f32x4*)(L + segt + sb * 4096 + (w * 128 + k4) * 4); if (w < sg) pre += v; if (w < 4) br += v; bl += v; }
        if (sg == 0) { f32x4 el, dl;
#pragma unroll
            for (int e = 0; e < 4; ++e) { el[e] = __builtin_amdgcn_exp2f(bl[e] - br[e]); dl[e] = __builtin_amdgcn_exp2f(bl[e]); }
            *(LAS f32x4*)(Sn + VEC + k4 * 4) = el; *(LAS f32x4*)(Sn + VEC + 512 + k4 * 4) = dl; *(LAS f32x4*)(Sn + VEC + 1024 + k4 * 4) = br; }
#pragma unroll
        for (int e = 0; e < 4; ++e) st.tt[e] = __builtin_amdgcn_exp2f(fminf(fmaxf(pre[e] - br[e], -115.f), 115.f));
    }
#pragma unroll
    for (int i = 4 * HALF; i < 4 * HALF + 4; ++i) { const int t = 8 * sg + i;
        float q[4]; q[0] = __uint_as_float(R.q[i].x << 16); q[1] = __uint_as_float(R.q[i].x & 0xffff0000u); q[2] = __uint_as_float(R.q[i].y << 16); q[3] = __uint_as_float(R.q[i].y & 0xffff0000u);
        const f32x4 lfi = __builtin_convertvector(R.lf[i], f32x4);
        float qs[4], ks[4];
#pragma unroll
        for (int e = 0; e < 4; ++e) { const float f = __builtin_amdgcn_exp2f(lfi[e]); const float tn = fminf(fmaxf(st.tt[e] * f, 1.8e-35f), 5.5e34f); st.tt[e] = tn;
            qs[e] = q[e] * tn; ks[e] = (1.f - f) * __builtin_amdgcn_rcpf(tn); }
        *(LAS u32x2*)(Sn + QS + t * RS + k4 * 2) = pack4bf(qs[0], qs[1], qs[2], qs[3]);
        *(LAS u32x2*)(Sn + KS + offb(t, k4 >> 3) + (k4 & 4) * 2) = pack4bf(ks[0], ks[1], ks[2], ks[3]); }
    if (HALF == 1) *(LAS u32x4*)(Sn + VT + vs * 64 + v8 * 2) = R.v;
}
__device__ __forceinline__ void hg3_m1(LAS unsigned char* L, LAS unsigned char* Sc, int it, int mw, int r32, int hi, f32x16& S, int pp = hg3::PP, int sop0 = hg3::SOP0) {
    using namespace hg3;
    const int lane = hi * 32 + r32;
    if (it < 0) { for (int e = lane + 64 * mw; e < 8704 / 4; e += 256) ((LAS unsigned*)(L + sop0))[e] = 0u; return; }
    bf16x8 ua[4], ub[4];
#pragma unroll
    for (int ss = 0; ss < 4; ++ss) { ua[ss] = tr_frag_ks(Sc + KS, lane, mw, ss); ub[ss] = tr_frag_v(Sc + VT, lane, ss); }
    f32x4 el[4], dl[4];
#pragma unroll
    for (int g = 0; g < 4; ++g) { const int k0 = 32 * mw + 8 * g + 4 * hi; el[g] = *(const LAS f32x4*)(Sc + VEC + k0 * 4); dl[g] = *(const LAS f32x4*)(Sc + VEC + 512 + k0 * 4); }
    const int si = mw >> 1, ti = (mw + 1) >> 1;
    bf16x8 sa[8], sq[8];
    if (mw < 3) {
#pragma unroll
        for (int ks = 0; ks < 8; ++ks) { sa[ks] = *(const LAS bf16x8*)(Sc + KS + offb(32 * si + r32, 2 * ks + hi)); sq[ks] = *(const LAS bf16x8*)(Sc + QS + (32 * ti + r32) * RS + 32 * ks + 16 * hi); }
    }
    __builtin_amdgcn_sched_barrier(0);
    f32x16 U;
#pragma unroll
    for (int i = 0; i < 16; ++i) U[i] = 0.f;
#pragma unroll
    for (int ss = 0; ss < 4; ++ss) U = __builtin_amdgcn_mfma_f32_32x32x16_bf16(ua[ss], ub[ss], U, 0, 0, 0);
    if (mw < 3) {
        f32x16 acc;
#pragma unroll
        for (int i = 0; i < 16; ++i) acc[i] = 0.f;
#pragma unroll
        for (int ks = 0; ks < 8; ++ks) acc = __builtin_amdgcn_mfma_f32_32x32x16_bf16(sa[ks], sq[ks], acc, 0, 0, 0);
        const int t = 32 * ti + r32;
#pragma unroll
        for (int q = 0; q < 16; ++q) { const int sidx = 32 * si + crow(q, hi); if (sidx > t) acc[q] = 0.f; }
#pragma unroll
        for (int g = 0; g < 4; ++g) *(LAS u32x2*)(L + pp + t * RS2 + (32 * si + 8 * g + 4 * hi) * 2) = pack4bf(acc[4 * g], acc[4 * g + 1], acc[4 * g + 2], acc[4 * g + 3]);
    }
#pragma unroll
    for (int g = 0; g < 4; ++g)
#pragma unroll
        for (int e = 0; e < 4; ++e) S[4 * g + e] = dl[g][e] * S[4 * g + e] + el[g][e] * U[4 * g + e];
}
__device__ __forceinline__ void hg4_m1(LAS unsigned char* L, LAS unsigned char* Sc, int it, int mw, int r32, int hi, f32x16& S, int pp, int sop0) {
    using namespace hg3;
    const int lane = hi * 32 + r32;
    if (it < 0) { for (int e = lane + 64 * mw; e < 8704 / 4; e += 256) ((LAS unsigned*)(L + sop0))[e] = 0u; return; }
    bf16x8 ua[4], ub[4];
#pragma unroll
    for (int ss = 0; ss < 4; ++ss) { ua[ss] = tr_frag_ks(Sc + KS, lane, mw, ss); ub[ss] = tr_frag_v(Sc + VT, lane, ss); }
    f32x4 el[4], dl[4];
#pragma unroll
    for (int g = 0; g < 4; ++g) { const int k0 = 32 * mw + 8 * g + 4 * hi; el[g] = *(const LAS f32x4*)(Sc + VEC + k0 * 4); dl[g] = *(const LAS f32x4*)(Sc + VEC + 512 + k0 * 4); }
    const int si = mw, ti0 = mw;
    bf16x8 sa[8], sq[8];
    if (mw < 2) {
#pragma unroll
        for (int ks = 0; ks < 8; ++ks) { sa[ks] = *(const LAS bf16x8*)(Sc + KS + offb(32 * si + r32, 2 * ks + hi)); sq[ks] = *(const LAS bf16x8*)(Sc + QS + (32 * ti0 + r32) * RS + 32 * ks + 16 * hi); }
    }
    __builtin_amdgcn_sched_barrier(0);
    f32x16 U;
#pragma unroll
    for (int i = 0; i < 16; ++i) U[i] = 0.f;
#pragma unroll
    for (int ss = 0; ss < 4; ++ss) U = __builtin_amdgcn_mfma_f32_32x32x16_bf16(ua[ss], ub[ss], U, 0, 0, 0);
    if (mw < 2) {
        f32x16 acc;
#pragma unroll
        for (int i = 0; i < 16; ++i) acc[i] = 0.f;
#pragma unroll
        for (int ks = 0; ks < 8; ++ks) acc = __builtin_amdgcn_mfma_f32_32x32x16_bf16(sa[ks], sq[ks], acc, 0, 0, 0);
        if (mw == 0) {
#pragma unroll
            for (int ks = 0; ks < 8; ++ks) sq[ks] = *(const LAS bf16x8*)(Sc + QS + (32 + r32) * RS + 32 * ks + 16 * hi);
        }
        { const int t = 32 * ti0 + r32;
#pragma unroll
          for (int q = 0; q < 16; ++q) { const int sidx = 32 * si + crow(q, hi); if (sidx > t) acc[q] = 0.f; }
#pragma unroll
          for (int g = 0; g < 4; ++g) *(LAS u32x2*)(L + pp + t * RS2 + (32 * si + 8 * g + 4 * hi) * 2) = pack4bf(acc[4 * g], acc[4 * g + 1], acc[4 * g + 2], acc[4 * g + 3]); }
        if (mw == 0) {
            __builtin_amdgcn_sched_barrier(0);
            f32x16 ac2;
#pragma unroll
            for (int i = 0; i < 16; ++i) ac2[i] = 0.f;
#pragma unroll
            for (int ks = 0; ks < 8; ++ks) ac2 = __builtin_amdgcn_mfma_f32_32x32x16_bf16(sa[ks], sq[ks], ac2, 0, 0, 0);
            const int t = 32 + r32;
#pragma unroll
            for (int g = 0; g < 4; ++g) *(LAS u32x2*)(L + pp + t * RS2 + (8 * g + 4 * hi) * 2) = pack4bf(ac2[4 * g], ac2[4 * g + 1], ac2[4 * g + 2], ac2[4 * g + 3]);
        }
    }
#pragma unroll
    for (int g = 0; g < 4; ++g)
#pragma unroll
        for (int e = 0; e < 4; ++e) S[4 * g + e] = dl[g][e] * S[4 * g + e] + el[g][e] * U[4 * g + e];
}
__device__ __forceinline__ void hg3_m2(LAS unsigned char* L, LAS unsigned char* Sc, int sopc, int sopn, int it, int mw, int r32, int hi, const f32x16& S, bf16_t* Ob, int pp = hg3::PP, const LAS unsigned char* brp = nullptr, bool out_hi = false, bool wide = false, bool do_keep = false, u32x4* keep = nullptr) {
    using namespace hg3;
    const int lane = hi * 32 + r32;
    const int sbn = ((it + 1) & 1) * 4096;
    const int ti = out_hi ? mw - 2 : mw;
    const bool outw = out_hi ? (mw >= 2) : (mw < 2);
    bf16x8 oa[8], ob[8], pa[4], pv[4];
    if (outw) {
#pragma unroll
        for (int ks = 0; ks < 8; ++ks) { oa[ks] = *(const LAS bf16x8*)(Sc + QS + (32 * ti + r32) * RS + 32 * ks + 16 * hi); ob[ks] = *(const LAS bf16x8*)(L + sopc + r32 * RS + 32 * ks + 16 * hi); }
#pragma unroll
        for (int ss = 0; ss < 4; ++ss) { pa[ss] = *(const LAS bf16x8*)(L + pp + (32 * ti + r32) * RS2 + 32 * ss + 16 * hi); pv[ss] = tr_frag_v(Sc + VT, lane, ss); }
    }
    f32x4 sb[4];
    if (it + 1 < 64) {
#pragma unroll
        for (int g = 0; g < 4; ++g) { const int k0 = 32 * mw + 8 * g + 4 * hi;
            if (brp != nullptr) sb[g] = *(const LAS f32x4*)(brp + k0 * 4);
            else sb[g] = (*(const LAS f32x4*)(L + SEGT + sbn + k0 * 4) + *(const LAS f32x4*)(L + SEGT + sbn + (128 + k0) * 4)) + (*(const LAS f32x4*)(L + SEGT + sbn + (256 + k0) * 4) + *(const LAS f32x4*)(L + SEGT + sbn + (384 + k0) * 4)); }
    }
    __builtin_amdgcn_sched_barrier(0);
    if (outw) {
        f32x16 o;
#pragma unroll
        for (int i = 0; i < 16; ++i) o[i] = 0.f;
#pragma unroll
        for (int ks = 0; ks < 8; ++ks) o = __builtin_amdgcn_mfma_f32_32x32x16_bf16(oa[ks], ob[ks], o, 0, 0, 0);
#pragma unroll
        for (int ss = 0; ss < 4; ++ss) { if (ss < 2 || ti == 1) o = __builtin_amdgcn_mfma_f32_32x32x16_bf16(pa[ss], pv[ss], o, 0, 0, 0); }
        if (wide) {
            LAS unsigned char* Tp = L + pp + (32 * ti) * RS2;
            asm volatile("s_nop 15\n\ts_nop 7" : "+v"(o));
#pragma unroll
            for (int qq = 0; qq < 8; ++qq) { const unsigned w = pg8::cvt_pk_bf16(o[2 * qq], o[2 * qq + 1]);
                *(LAS bf16_t*)(Tp + crow(2 * qq, hi) * RS2 + r32 * 2) = (bf16_t)(w & 0xffffu); *(LAS bf16_t*)(Tp + crow(2 * qq + 1, hi) * RS2 + r32 * 2) = (bf16_t)(w >> 16); }
            asm volatile("s_waitcnt lgkmcnt(0)" ::: "memory");
#pragma unroll
            for (int i = 0; i < 2; ++i) { const int row = (lane >> 2) + 16 * i, ch = lane & 3;
                const u32x4 v = *(const LAS u32x4*)(Tp + row * RS2 + ch * 16);
                if (do_keep) keep[i] = v;
                *(u32x4*)(Ob + (size_t)(32 * ti + row) * DM + ch * 8) = v; }
        } else {
        bf16_t* orow = Ob + (size_t)(32 * ti) * DM + r32;
#pragma unroll
        for (int q = 0; q < 16; ++q) orow[(size_t)crow(q, hi) * DM] = (bf16_t)f2bf(o[q]);
        }
    }
    if (it + 1 < 64) {
#pragma unroll
        for (int g = 0; g < 4; ++g) { const int k0 = 32 * mw + 8 * g + 4 * hi;
            *(LAS u32x2*)(L + sopn + r32 * RS + k0 * 2) = (brp != nullptr) ? pack4bf(S[4 * g] * __builtin_amdgcn_exp2f(sb[g][0]), S[4 * g + 1] * __builtin_amdgcn_exp2f(sb[g][1]), S[4 * g + 2] * __builtin_amdgcn_exp2f(sb[g][2]), S[4 * g + 3] * __builtin_amdgcn_exp2f(sb[g][3]))
                                                                              : pack4bf(S[4 * g] * __expf(sb[g][0]), S[4 * g + 1] * __expf(sb[g][1]), S[4 * g + 2] * __expf(sb[g][2]), S[4 * g + 3] * __expf(sb[g][3])); }
    }
}
template <int MODE>
__device__ __forceinline__ void hgrn_chunk3(const Params& p, unsigned char* lds_g) {
    using namespace hg3;
    LAS unsigned char* L = (LAS unsigned char*)lds_g;
    const int tid = threadIdx.x, lane = tid & 63, wave = __builtin_amdgcn_readfirstlane(tid >> 6), r32 = lane & 31, hi = lane >> 5;
    const bf16_t* Q0 = (const bf16_t*)(p.ws + WS_B); const bf16_t* V0 = (const bf16_t*)(p.ws + WS_B + 64 * MiB);
    const _Float16* LOGF16 = (const _Float16*)p.out; bf16_t* O0 = MODE == 2 ? (bf16_t*)((unsigned char*)p.out + 64 * MiB) : (bf16_t*)(p.ws + WS_E);
    const bool isP = wave < 4;
    const int sg = 2 * (wave & 3) + hi, k4 = 4 * r32;
    const int vs = (tid & 255) >> 2, v8 = (tid & 3) * 8;
    for (int unit = blockIdx.x; unit < 256; unit += gridDim.x) {
        const int bh = unit & 63, c4 = unit >> 6, b = bh >> 4, h = bh & 15;
        const size_t rowb = (size_t)b * SEQ; const int colb = h * HD;
        __syncthreads();
        f32x16 S;
#pragma unroll
        for (int i = 0; i < 16; ++i) S[i] = 0.f;
        Raw R0, R1, R2;
#define HG_LOAD(cn_, R_) do { int lo_ = hi * 8 * DM + k4, vo_ = vs * DM + v8; asm volatile("" : "+v"(lo_), "+v"(vo_));     \
            _Pragma("unroll") for (int i = 0; i < 8; ++i) { const size_t ro_ = (rowb + 64 * (cn_) + 8 * (2 * (wave & 3)) + i) * DM + colb;     \
            R_.lf[i] = *(const f16x4*)((LOGF16 + ro_) + lo_); R_.q[i] = *(const u32x2*)((Q0 + ro_) + lo_); } \
            R_.v = *(const u32x4*)((V0 + (rowb + 64 * (cn_)) * DM + colb + c4 * 32) + vo_); } while (0)
        if (isP) {
            __builtin_amdgcn_s_setprio(1);
            HgA2 st;
            if (MODE != 2) { HG_LOAD(0, R0); HG_LOAD(1, R1); hg3_a1(L, R0, sg, k4, 0); }
            LDS_BARRIER();
#define HG_PITER(it_, RC_, RN_, RF_) do { const int cn = (it_) + 1; LAS unsigned char* Sn = L + (cn & 1) * SETSZ; const int cf = cn + 2 < 63 ? cn + 2 : 63; \
            if (MODE != 2) { HG_LOAD(cf, RF_); hg3_a2h<0>(L, Sn, RC_, sg, k4, cn & 1, vs, v8, st); } LDS_BARRIER(); \
            if (MODE != 2) { hg3_a2h<1>(L, Sn, RC_, sg, k4, cn & 1, vs, v8, st); hg3_a1(L, RN_, sg, k4, (cn + 1) & 1); } LDS_BARRIER(); } while (0)
            for (int base = -1; base < 65; base += 3) { HG_PITER(base, R0, R1, R2); HG_PITER(base + 1, R1, R2, R0); HG_PITER(base + 2, R2, R0, R1); }
#undef HG_PITER
            __builtin_amdgcn_s_setprio(0);
        } else {
            LDS_BARRIER();
            for (int it = -1; it < 65; ++it) {
                LAS unsigned char* Sc = L + (it & 1) * SETSZ; const int sopc = (it & 1) ? SOP1 : SOP0, sopn = (it & 1) ? SOP0 : SOP1;
                if (MODE != 1 && it < 64) hg3_m1(L, Sc, it, wave - 4, r32, hi, S);
                LDS_BARRIER();
                if (MODE != 1 && it >= 0 && it < 64) hg3_m2(L, Sc, sopc, sopn, it, wave - 4, r32, hi, S, O0 + (rowb + 64 * it) * DM + colb + c4 * 32);
                LDS_BARRIER();
            }
        }
#undef HG_LOAD
    }
}
__device__ __forceinline__ void hn_unpack(const u32x4 v, float (&o)[8]) {
    o[0] = __uint_as_float(v.x << 16); o[1] = __uint_as_float(v.x & 0xffff0000u); o[2] = __uint_as_float(v.y << 16); o[3] = __uint_as_float(v.y & 0xffff0000u);
    o[4] = __uint_as_float(v.z << 16); o[5] = __uint_as_float(v.z & 0xffff0000u); o[6] = __uint_as_float(v.w << 16); o[7] = __uint_as_float(v.w & 0xffff0000u);
}
namespace hg4 {
constexpr int SETSZ = hg3::SETSZ + 512;
constexpr int PP0 = 3 * SETSZ, PP1 = PP0 + 9216, SOP0 = PP1 + 9216, SOP1 = SOP0 + 8704, SEGT = SOP1 + 8704, END = SEGT + 8192;
static_assert(END <= LDS_BYTES - 16, "hgrn_chunk4 LDS map");
}
__device__ __forceinline__ void hgrn_chunk4(const Params& p, unsigned char* lds_g) {
    using namespace hg3;
    LAS unsigned char* L = (LAS unsigned char*)lds_g;
    const int tid = threadIdx.x, lane = tid & 63, wave = __builtin_amdgcn_readfirstlane(tid >> 6), r32 = lane & 31, hi = lane >> 5;
    const bf16_t* Q0 = (const bf16_t*)(p.ws + WS_B); const bf16_t* V0 = (const bf16_t*)(p.ws + WS_B + 64 * MiB);
    const _Float16* LOGF16 = (const _Float16*)p.out; bf16_t* O0 = (bf16_t*)(p.ws + WS_E);
    const bool isP = wave < 4;
    const int sg = 2 * (wave & 3) + hi, k4 = 4 * r32;
    const int vs = (tid & 255) >> 2, v8 = (tid & 3) * 8;
    for (int unit = blockIdx.x; unit < 256; unit += gridDim.x) {
        const int bh = unit & 63, c4 = unit >> 6, b = bh >> 4, h = bh & 15;
        const size_t rowb = (size_t)b * SEQ; const int colb = h * HD;
        __syncthreads();
        f32x16 S;
#pragma unroll
        for (int i = 0; i < 16; ++i) S[i] = 0.f;
        Raw R0, R1, R2;
#define HG_LOAD(cn_, R_) do { int lo_ = hi * 8 * DM + k4, vo_ = vs * DM + v8; asm volatile("" : "+v"(lo_), "+v"(vo_));     \
            _Pragma("unroll") for (int i = 0; i < 8; ++i) { const size_t ro_ = (rowb + 64 * (cn_) + 8 * (2 * (wave & 3)) + i) * DM + colb;     \
            R_.lf[i] = *(const f16x4*)((LOGF16 + ro_) + lo_); R_.q[i] = *(const u32x2*)((Q0 + ro_) + lo_); } \
            R_.v = *(const u32x4*)((V0 + (rowb + 64 * (cn_)) * DM + colb + c4 * 32) + vo_); } while (0)
        if (isP) {
            __builtin_amdgcn_s_setprio(1);
            HgA2p st;
            HG_LOAD(0, R0); HG_LOAD(1, R1); hg3_a1(L, R0, sg, k4, 0, hg4::SEGT);
            LDS_BARRIER();
#define HG_PSTEP(s_, RC_, RN_, RF_) do { const int cn = (s_) + 1; LAS unsigned char* Sn = L + (cn % 3) * hg4::SETSZ; const int cf = cn + 2 < 63 ? cn + 2 : 63; \
            HG_LOAD(cf, RF_); hg3_a2p<0>(L, Sn, RC_, sg, k4, cn & 1, vs, v8, st, hg4::SEGT); hg3_a2p<1>(L, Sn, RC_, sg, k4, cn & 1, vs, v8, st, hg4::SEGT); \
            hg3_a1(L, RN_, sg, k4, (cn + 1) & 1, hg4::SEGT); LDS_BARRIER(); } while (0)
            for (int base = -1; base < 65; base += 3) { HG_PSTEP(base, R0, R1, R2); HG_PSTEP(base + 1, R1, R2, R0); HG_PSTEP(base + 2, R2, R0, R1); }
#undef HG_PSTEP
            __builtin_amdgcn_s_setprio(0);
        } else {
            LDS_BARRIER();
            const bool fused = gridDim.x == 256;
            const int mw = wave - 4, tio = mw - 2;
            unsigned* FL = (unsigned*)(p.ws + WS_BAR) + 3584;
            float* SSP = (float*)(p.ws + WS_G);
            const bf16_t* Z0 = (const bf16_t*)(p.ws + WS_D); bf16_t* ONp = (bf16_t*)(p.ws + WS_A);
            const bool fo = fused && mw >= 2, fr = fused && mw < 2; const int tl = mw & 1;
            for (int s = -1; s < 68; ++s) {
                int ln_ = lane; asm volatile("" : "+v"(ln_)); const int r32_ = ln_ & 31, hi_ = ln_ >> 5;
                const int c2 = s - 1;
                const int cf = c2 - 2, cz = c2 - 3;
                u32x4 zz[2], oo[2], kp[2]; unsigned fl = 0u; float pt[2];
                if (fr) {
                    if (cf >= 0 && cf < 64) fl = __hip_atomic_load(FL + (bh + 64 * (ln_ & 3)) * 2 + tl, __ATOMIC_RELAXED, __HIP_MEMORY_SCOPE_AGENT);
                    if (cz >= 0 && cz < 64) {
#pragma unroll
                        for (int i = 0; i < 2; ++i) { const int row = (ln_ >> 2) + 16 * i, ch = ln_ & 3; const size_t off = (rowb + 64 * cz + 32 * tl + row) * DM + colb + c4 * 32 + ch * 8;
                            pt[i] = __hip_atomic_load(SSP + ((size_t)(bh * 64 + cz) * 4 + ch) * 64 + 32 * tl + row, __ATOMIC_RELAXED, __HIP_MEMORY_SCOPE_AGENT);
                            oo[i] = *(const u32x4*)(O0 + off); zz[i] = *(const u32x4*)(Z0 + off); } }
                }
                if (c2 >= 0 && c2 < 64) hg3_m2(L, L + (c2 % 3) * hg4::SETSZ, (c2 & 1) ? hg4::SOP1 : hg4::SOP0, (c2 & 1) ? hg4::SOP0 : hg4::SOP1, c2, mw, r32_, hi_, S,
                                               O0 + (rowb + 64 * c2) * DM + colb + c4 * 32, (c2 & 1) ? hg4::PP1 : hg4::PP0, L + ((c2 + 1) % 3) * hg4::SETSZ + VEC + 1024, true, true, fused, kp);
                if (s < 64) hg3_m1(L, L + ((s + 3) % 3) * hg4::SETSZ, s, mw, r32_, hi_, S, (s & 1) ? hg4::PP1 : hg4::PP0, hg4::SOP0);
                if (fo && c2 - 1 >= 0 && c2 - 1 < 64) { asm volatile("s_waitcnt vmcnt(0)" ::: "memory");
                    if (ln_ == 0) __hip_atomic_store(FL + unit * 2 + tl, (unsigned)c2, __ATOMIC_RELAXED, __HIP_MEMORY_SCOPE_AGENT); }
                if (fo && c2 >= 0 && c2 < 64) {
#pragma unroll
                    for (int i = 0; i < 2; ++i) { float o8[8]; hn_unpack(kp[i], o8); float ss = 0.f;
#pragma unroll
                        for (int e = 0; e < 8; ++e) ss += o8[e] * o8[e];
                        ss += quad_x<0xB1>(ss); ss += quad_x<0x4E>(ss);
                        if ((ln_ & 3) == 0) __hip_atomic_store(SSP + ((size_t)(bh * 64 + c2) * 4 + c4) * 64 + 32 * tl + (ln_ >> 2) + 16 * i, ss, __ATOMIC_RELAXED, __HIP_MEMORY_SCOPE_AGENT); }
                }
                if (fr && cz >= 0 && cz < 64) {
#pragma unroll
                    for (int i = 0; i < 2; ++i) { const int row = (ln_ >> 2) + 16 * i, ch = ln_ & 3;
                        float tot = pt[i]; tot += quad_x<0xB1>(tot); tot += quad_x<0x4E>(tot);
                        const float rr = rsqrtf(tot * (1.f / HD) + RMS_EPS);
                        float o8[8], z8[8]; hn_unpack(oo[i], o8); hn_unpack(zz[i], z8);
#pragma unroll
                        for (int e = 0; e < 8; ++e) z8[e] = o8[e] * rr * (z8[e] * sigmoidf_(z8[e]));
                        u32x4 w; w.x = pk2(z8[0], z8[1]); w.y = pk2(z8[2], z8[3]); w.z = pk2(z8[4], z8[5]); w.w = pk2(z8[6], z8[7]);
                        *(u32x4*)(ONp + (rowb + 64 * cz + 32 * tl + row) * DM + colb + c4 * 32 + ch * 8) = w; }
                }
                if (fr && cf >= 0 && cf < 64) {
                    const unsigned* fp = FL + (bh + 64 * (ln_ & 3)) * 2 + tl;
                    for (int spin = 0; spin < (1 << 22) && !__all(fl >= (unsigned)(cf + 1)); ++spin) { __builtin_amdgcn_s_sleep(2); fl = __hip_atomic_load(fp, __ATOMIC_RELAXED, __HIP_MEMORY_SCOPE_AGENT); }
                    asm volatile("" ::: "memory");
                }
                if (s < 65) LDS_BARRIER();
            }
        }
#undef HG_LOAD
    }
}
__device__ __forceinline__ void hgrn_headnorm(const Params& p) {
    const int tid = threadIdx.x, lane = tid & 63, wave = tid >> 6, gw = blockIdx.x * 8 + wave, NGW = gridDim.x * 8;
    const bf16_t* O0 = (const bf16_t*)(p.ws + WS_E); const bf16_t* Z0 = (const bf16_t*)(p.ws + WS_D); bf16_t* ON = (bf16_t*)(p.ws + WS_A);
    const int sub = lane & 15;
    constexpr int NR4 = T * NH / 4;
    for (int r4 = gw; r4 < NR4; r4 += 4 * NGW) {
        size_t off[4]; u32x4 ov[4], zv[4];
#pragma unroll
        for (int u = 0; u < 4; ++u) { const int rr = r4 + u * NGW < NR4 ? r4 + u * NGW : r4; off[u] = ((size_t)rr * 4 + (lane >> 4)) * 128 + 8 * sub; ov[u] = *(const u32x4*)(O0 + off[u]); zv[u] = *(const u32x4*)(Z0 + off[u]); }
#pragma unroll
        for (int u = 0; u < 4; ++u) { float o[8], z[8]; hn_unpack(ov[u], o); hn_unpack(zv[u], z);
#pragma unroll
            for (int e = 0; e < 8; ++e) z[e] = z[e] * sigmoidf_(z[e]);
            float ss = 0.f;
#pragma unroll
            for (int e = 0; e < 8; ++e) ss += o[e] * o[e];
            ss += __shfl_xor(ss, 1); ss += __shfl_xor(ss, 2); ss += __shfl_xor(ss, 4); ss += __shfl_xor(ss, 8);
            const float rr = rsqrtf(ss * (1.f / HD) + RMS_EPS);
            u32x4 w; w.x = pk2(o[0] * rr * z[0], o[1] * rr * z[1]); w.y = pk2(o[2] * rr * z[2], o[3] * rr * z[3]);
            w.z = pk2(o[4] * rr * z[4], o[5] * rr * z[5]); w.w = pk2(o[6] * rr * z[6], o[7] * rr * z[7]);
            *(u32x4*)(ON + off[u]) = w; }
    }
}
template <bool OUT_BF16>
__device__ __forceinline__ void rows_rms2(const float* X, const float* gain, void* Ov, const int tidv) {
    const int lane = tidv & 63, gw = blockIdx.x * 8 + (tidv >> 6), NGW = gridDim.x * 8;
    const f32x4* gr = (const f32x4*)gain + lane;
    for (int m = gw; m < T; m += 2 * NGW) {
        const int m2 = m + NGW < T ? m + NGW : m;
        const f32x4* xa = (const f32x4*)(X + (size_t)m * DM) + lane; const f32x4* xb = (const f32x4*)(X + (size_t)m2 * DM) + lane;
        f32x4 va[8], vb[8]; float sa = 0.f, sb = 0.f;
#pragma unroll
        for (int j = 0; j < 8; ++j) va[j] = xa[64 * j];
#pragma unroll
        for (int j = 0; j < 8; ++j) vb[j] = xb[64 * j];
#pragma unroll
        for (int j = 0; j < 8; ++j) { sa += (va[j].x * va[j].x + va[j].y * va[j].y) + (va[j].z * va[j].z + va[j].w * va[j].w); sb += (vb[j].x * vb[j].x + vb[j].y * vb[j].y) + (vb[j].z * vb[j].z + vb[j].w * vb[j].w); }
        const float ra = rsqrtf(wave_sum(sa) * (1.f / DM) + RMS_EPS), rb = rsqrtf(wave_sum(sb) * (1.f / DM) + RMS_EPS);
        if (OUT_BF16) { u32x2* oa = (u32x2*)((bf16_t*)Ov + (size_t)m * DM) + lane; u32x2* ob = (u32x2*)((bf16_t*)Ov + (size_t)m2 * DM) + lane;
#pragma unroll
            for (int j = 0; j < 8; ++j) { const f32x4 g = gr[64 * j]; u32x2 w; w.x = pk2(va[j].x * ra * g.x, va[j].y * ra * g.y); w.y = pk2(va[j].z * ra * g.z, va[j].w * ra * g.w); oa[64 * j] = w;
                w.x = pk2(vb[j].x * rb * g.x, vb[j].y * rb * g.y); w.y = pk2(vb[j].z * rb * g.z, vb[j].w * rb * g.w); ob[64 * j] = w; } }
        else { f32x4* oa = (f32x4*)((float*)Ov + (size_t)m * DM) + lane; f32x4* ob = (f32x4*)((float*)Ov + (size_t)m2 * DM) + lane;
#pragma unroll
            for (int j = 0; j < 8; ++j) { const f32x4 g = gr[64 * j]; oa[64 * j] = va[j] * ra * g; ob[64 * j] = vb[j] * rb * g; } }
    }
}
template <bool OUT_BF16>
__device__ __forceinline__ void rows_rms_b(const bf16_t* X, const float* gain, void* Ov, const int tidv) {
    const int lane = tidv & 63, gw = blockIdx.x * 8 + (tidv >> 6), NGW = gridDim.x * 8;
    const f32x4* gr = (const f32x4*)gain + 2 * lane;
    for (int m = gw; m < T; m += 4 * NGW) {
        int mr[4]; u32x4 v[4][4]; float rr[4];
#pragma unroll
        for (int r = 0; r < 4; ++r) mr[r] = m + r * NGW < T ? m + r * NGW : m;
#pragma unroll
        for (int r = 0; r < 4; ++r)
#pragma unroll
            for (int j = 0; j < 4; ++j) v[r][j] = *((const u32x4*)(X + (size_t)mr[r] * DM) + lane + 64 * j);
#pragma unroll
        for (int r = 0; r < 4; ++r) { float s = 0.f;
#pragma unroll
            for (int j = 0; j < 4; ++j)
#pragma unroll
                for (int e = 0; e < 4; ++e) { const float lo = __uint_as_float(v[r][j][e] << 16), hi = __uint_as_float(v[r][j][e] & 0xffff0000u); s += lo * lo + hi * hi; }
            rr[r] = s; }
#pragma unroll
        for (int r = 0; r < 4; ++r) rr[r] = rsqrtf(wave_sum(rr[r]) * (1.f / DM) + RMS_EPS);
#pragma unroll
        for (int j = 0; j < 4; ++j) { const f32x4 g0 = gr[128 * j], g1 = gr[128 * j + 1];
#pragma unroll
            for (int r = 0; r < 4; ++r) { const u32x4 q = v[r][j]; const float k = rr[r];
                const f32x4 o0 = (f32x4){__uint_as_float(q.x << 16) * k * g0.x, __uint_as_float(q.x & 0xffff0000u) * k * g0.y, __uint_as_float(q.y << 16) * k * g0.z, __uint_as_float(q.y & 0xffff0000u) * k * g0.w};
                const f32x4 o1 = (f32x4){__uint_as_float(q.z << 16) * k * g1.x, __uint_as_float(q.z & 0xffff0000u) * k * g1.y, __uint_as_float(q.w << 16) * k * g1.z, __uint_as_float(q.w & 0xffff0000u) * k * g1.w};
                if (OUT_BF16) { u32x4 w; w.x = pk2(o0.x, o0.y); w.y = pk2(o0.z, o0.w); w.z = pk2(o1.x, o1.y); w.w = pk2(o1.z, o1.w); *((u32x4*)((bf16_t*)Ov + (size_t)mr[r] * DM) + lane + 64 * j) = w; }
                else { f32x4* o = (f32x4*)((float*)Ov + (size_t)mr[r] * DM) + 2 * lane + 128 * j; o[0] = o0; o[1] = o1; } } }
    }
}
__device__ __forceinline__ void rows_rms16(const float* X, const float* gain, bf16_t* O, const int tidv) {
    const int lane = tidv & 63, gw = blockIdx.x * 8 + (tidv >> 6), NGW = gridDim.x * 8;
    const f32x4* gr = (const f32x4*)gain + 2 * lane;
    for (int m = gw; m < T; m += 2 * NGW) {
        const int m2 = m + NGW < T ? m + NGW : m;
        const f32x4* xa = (const f32x4*)(X + (size_t)m * DM) + 2 * lane; const f32x4* xb = (const f32x4*)(X + (size_t)m2 * DM) + 2 * lane;
        f32x4 va[8], vb[8]; float sa = 0.f, sb = 0.f;
#pragma unroll
        for (int j = 0; j < 4; ++j) { va[2 * j] = xa[128 * j]; va[2 * j + 1] = xa[128 * j + 1]; }
#pragma unroll
        for (int j = 0; j < 4; ++j) { vb[2 * j] = xb[128 * j]; vb[2 * j + 1] = xb[128 * j + 1]; }
#pragma unroll
        for (int j = 0; j < 8; ++j) { sa += (va[j].x * va[j].x + va[j].y * va[j].y) + (va[j].z * va[j].z + va[j].w * va[j].w); sb += (vb[j].x * vb[j].x + vb[j].y * vb[j].y) + (vb[j].z * vb[j].z + vb[j].w * vb[j].w); }
        const float ra = rsqrtf(wave_sum(sa) * (1.f / DM) + RMS_EPS), rb = rsqrtf(wave_sum(sb) * (1.f / DM) + RMS_EPS);
        u32x4* oa = (u32x4*)(O + (size_t)m * DM) + lane; u32x4* ob = (u32x4*)(O + (size_t)m2 * DM) + lane;
#pragma unroll
        for (int j = 0; j < 4; ++j) { const f32x4 g0 = gr[128 * j], g1 = gr[128 * j + 1]; u32x4 w;
            w.x = pk2(va[2 * j].x * ra * g0.x, va[2 * j].y * ra * g0.y); w.y = pk2(va[2 * j].z * ra * g0.z, va[2 * j].w * ra * g0.w);
            w.z = pk2(va[2 * j + 1].x * ra * g1.x, va[2 * j + 1].y * ra * g1.y); w.w = pk2(va[2 * j + 1].z * ra * g1.z, va[2 * j + 1].w * ra * g1.w); oa[64 * j] = w;
            w.x = pk2(vb[2 * j].x * rb * g0.x, vb[2 * j].y * rb * g0.y); w.y = pk2(vb[2 * j].z * rb * g0.z, vb[2 * j].w * rb * g0.w);
            w.z = pk2(vb[2 * j + 1].x * rb * g1.x, vb[2 * j + 1].y * rb * g1.y); w.w = pk2(vb[2 * j + 1].z * rb * g1.z, vb[2 * j + 1].w * rb * g1.w); ob[64 * j] = w; }
    }
}
__device__ __forceinline__ void rows_rms_bf16(const float* X, const float* gain, bf16_t* O, const int tidv) { rows_rms2<true>(X, gain, O, tidv); }
__device__ __forceinline__ void rows_rms_f32(const float* X, const float* gain, float* O, const int tidv) { rows_rms2<false>(X, gain, O, tidv); }

__device__ __forceinline__ float gelu_tanh(float x) { const float u = 0.7978845608028654f * (x + 0.044715f * x * x * x); return 0.5f * x * (1.f + tanhf(u)); }
__device__ __forceinline__ void compress_naive(const Params& p, unsigned char* lds_g) {
    const int tid = threadIdx.x;
    const bf16_t* KV = (const bf16_t*)(p.ws + WS_E);
    const float* misc = (const float*)(p.ws + WS_MISC);
    float* xs = (float*)lds_g;
    float* red = xs + 144 * 128;
    float* hid = red + 4 * 8 * 128;
    const int n = tid & 127, part = tid >> 7;
    for (int unit = blockIdx.x; unit < 2 * 16 * 32; unit += gridDim.x) {
        const int which = unit / 512, bg = (unit % 512) / 32, i0 = (unit % 32) * 8, b = bg >> 2, g = bg & 3;
        const bf16_t* src = KV + (size_t)which * ((size_t)T * 512);
        const float* w1 = which ? p.pv_w1 : p.pk_w1; const float* w2 = which ? p.pv_w2 : p.pk_w2; const float* b1n = which ? p.pv_b1 : p.pk_b1; const float* cvp = misc + MISC_CVP / 4 + which * 8 * 128;
        bf16_t* dst = (bf16_t*)(p.ws + (which ? WS_VCMP : WS_KCMP)) + (size_t)bg * NCMPP * 128;
        __syncthreads();
        for (int e = tid; e < 144 * 128; e += 512) { const int tt = e >> 7, d = e & 127; const int tok = 16 * i0 + tt;
            xs[e] = tok < SEQ ? bf2f(src[(size_t)(b * SEQ + tok) * 512 + g * 128 + d]) : 0.f; }
        __syncthreads();
        float acc[8];
#pragma unroll
        for (int k = 0; k < 8; ++k) acc[k] = 0.f;
        for (int r = part * 1024; r < part * 1024 + 1024; ++r) {
            const float w = w1[(size_t)r * 128 + n]; const int j = r >> 7, d = r & 127;
#pragma unroll
            for (int k = 0; k < 8; ++k) acc[k] += xs[(16 * k + j) * 128 + d] * w;
        }
#pragma unroll
        for (int k = 0; k < 8; ++k) red[(part * 8 + k) * 128 + n] = acc[k];
        __syncthreads();
        for (int e = tid; e < 1024; e += 512) { const int k = e >> 7, nn = e & 127;
            float cvs = b1n[nn]; for (int sl = 0; sl < 8; ++sl) cvs += cvp[sl * 128 + nn];
            const float h = cvs + ((red[(0 * 8 + k) * 128 + nn] + red[(1 * 8 + k) * 128 + nn]) + (red[(2 * 8 + k) * 128 + nn] + red[(3 * 8 + k) * 128 + nn]));
            hid[e] = gelu_tanh(h); }
        __syncthreads();
        for (int e = tid; e < 1024; e += 512) { const int k = e >> 7, nn = e & 127; float s = 0.f;
            for (int m = 0; m < 128; ++m) s += hid[k * 128 + m] * w2[m * 128 + nn];
            const int i = i0 + k;
            dst[(size_t)i * 128 + nn] = (bf16_t)(i < NCMP ? f2bf(s) : 0u); }
    }
}

__device__ __forceinline__ void dot4(const bf16_t* krow, const float* qs, float (&a)[4]) {
    a[0] = a[1] = a[2] = a[3] = 0.f;
#pragma unroll 4
    for (int c = 0; c < 16; ++c) { const u32x4 kv = *(const u32x4*)(krow + 8 * c);
        float kf[8]; kf[0] = __uint_as_float(kv.x << 16); kf[1] = __uint_as_float(kv.x & 0xffff0000u); kf[2] = __uint_as_float(kv.y << 16); kf[3] = __uint_as_float(kv.y & 0xffff0000u);
        kf[4] = __uint_as_float(kv.z << 16); kf[5] = __uint_as_float(kv.z & 0xffff0000u); kf[6] = __uint_as_float(kv.w << 16); kf[7] = __uint_as_float(kv.w & 0xffff0000u);
#pragma unroll
        for (int h = 0; h < 4; ++h) { const f32x4 q0 = *(const f32x4*)(qs + h * 128 + 8 * c), q1 = *(const f32x4*)(qs + h * 128 + 8 * c + 4);
            a[h] += (kf[0] * q0.x + kf[1] * q0.y) + (kf[2] * q0.z + kf[3] * q0.w) + (kf[4] * q1.x + kf[5] * q1.y) + (kf[6] * q1.z + kf[7] * q1.w); } }
}
__device__ __forceinline__ void softmax4(f32x4* pl, int n, int lane) {
    const float NINF = -__builtin_inff();
    f32x4 m = {NINF, NINF, NINF, NINF};
    for (int i = lane; i < n; i += 64) { const f32x4 v = pl[i]; m.x = fmaxf(m.x, v.x); m.y = fmaxf(m.y, v.y); m.z = fmaxf(m.z, v.z); m.w = fmaxf(m.w, v.w); }
    m.x = wave_max(m.x); m.y = wave_max(m.y); m.z = wave_max(m.z); m.w = wave_max(m.w);
    f32x4 s = {0.f, 0.f, 0.f, 0.f};
    for (int i = lane; i < n; i += 64) { const f32x4 v = pl[i]; f32x4 e;
        e.x = m.x == NINF ? 0.f : __expf(v.x - m.x); e.y = m.y == NINF ? 0.f : __expf(v.y - m.y); e.z = m.z == NINF ? 0.f : __expf(v.z - m.z); e.w = m.w == NINF ? 0.f : __expf(v.w - m.w);
        pl[i] = e; s += e; }
    s.x = wave_sum(s.x); s.y = wave_sum(s.y); s.z = wave_sum(s.z); s.w = wave_sum(s.w);
    f32x4 inv; inv.x = s.x > 0.f ? 1.f / s.x : 0.f; inv.y = s.y > 0.f ? 1.f / s.y : 0.f; inv.z = s.z > 0.f ? 1.f / s.z : 0.f; inv.w = s.w > 0.f ? 1.f / s.w : 0.f;
    for (int i = lane; i < n; i += 64) pl[i] = pl[i] * inv;
}
__device__ __forceinline__ void pv_acc(const f32x4 pw, unsigned vv, float (&o)[4][2]) {
    const float v0 = __uint_as_float(vv << 16), v1 = __uint_as_float(vv & 0xffff0000u);
    o[0][0] += pw.x * v0; o[0][1] += pw.x * v1; o[1][0] += pw.y * v0; o[1][1] += pw.y * v1; o[2][0] += pw.z * v0; o[2][1] += pw.z * v1; o[3][0] += pw.w * v0; o[3][1] += pw.w * v1;
}
__device__ __forceinline__ void nsa_naive(const Params& p, unsigned char* lds_g, bf16_t* O1) {
    const int tid = threadIdx.x, lane = tid & 63, wave = tid >> 6;
    const bf16_t* Q1 = (const bf16_t*)(p.ws + WS_D); const bf16_t* KV = (const bf16_t*)(p.ws + WS_E); const bf16_t* Z1 = (const bf16_t*)(p.ws + WS_G);
    const float* GT = (const float*)(p.ws + WS_GATES); const bf16_t* KC = (const bf16_t*)(p.ws + WS_KCMP); const bf16_t* VC = (const bf16_t*)(p.ws + WS_VCMP);
    const float* biasp = (const float*)(p.ws + WS_MISC + MISC_BIASP);
    const size_t TS = (size_t)T * 512;
    const bf16_t* KS = KV + 2 * TS; const bf16_t* VS = KV + 3 * TS; const bf16_t* KW = KV + 4 * TS; const bf16_t* VW = KV + 5 * TS;
    float* qs = (float*)(lds_g + wave * 18432);
    f32x4* pl = (f32x4*)(lds_g + wave * 18432 + 2048);
    const float NINF = -__builtin_inff();
    const int gw = blockIdx.x * 8 + wave, NGW = gridDim.x * 8, NU = NB * NG * SEQ, niter = (NU + NGW - 1) / NGW;
    for (int it = 0; it < niter; ++it) {
        int unit = it * NGW + gw; const bool live = unit < NU; if (!live) unit = NU - 1;
        const int bg = unit / SEQ, t = unit % SEQ, b = bg >> 2, g = bg & 3;
        const size_t row = (size_t)b * SEQ + t;
        __syncthreads();
        { const bf16_t* qrow = Q1 + row * DM + g * 512;
          for (int e = lane; e < 512; e += 64) qs[e] = bf2f(qrow[e]); }
        __syncthreads();
        const float* bp = biasp + (g * 4) * 128;
        for (int c = 0; c < 4; ++c) { const int i = lane + 64 * c; float a[4]; dot4(KC + ((size_t)bg * NCMPP + i) * 128, qs, a);
            const int dist = t - (16 * i + 31); const bool valid = (i < NCMP) && dist >= 0;
            f32x4 l = {NINF, NINF, NINF, NINF};
            if (valid) { const bool nr = dist < 128; l.x = a[0] + (nr ? bp[dist] : 0.f); l.y = a[1] + (nr ? bp[128 + dist] : 0.f); l.z = a[2] + (nr ? bp[256 + dist] : 0.f); l.w = a[3] + (nr ? bp[384 + dist] : 0.f); }
            pl[i] = l; }
        __syncthreads();
        softmax4(pl, 256, lane);
        __syncthreads();
        float oc[4][2] = {};
        { const int imax = t >= 31 ? (t - 31) / 16 : -1;
          const unsigned* vb = (const unsigned*)(VC + (size_t)bg * NCMPP * 128) + lane;
#pragma unroll 8
          for (int i = 0; i <= imax; ++i) pv_acc(pl[i], vb[(size_t)i * 64], oc); }
        unsigned long long selmask;
        { const int j = lane; float imp = 0.f;
          for (int i = 4 * j - 1; i <= 4 * j + 3; ++i) if (i >= 0 && i < NCMP) { const f32x4 v = pl[i]; imp += (v.x + v.y) + (v.z + v.w); }
          const int cur = t >> 6; const bool forced = (j == 0) || (j == cur) || (j == cur - 1), visible = (j * 64 <= t);
          const float score = forced ? 1e9f : (visible ? imp : -1e30f);
          int rank = 0;
          for (int jj = 0; jj < 64; ++jj) { const float s2 = __shfl(score, jj); rank += (s2 > score || (s2 == score && jj < j)) ? 1 : 0; }
          selmask = __ballot(rank < 16); }
        __syncthreads();
        { int slot = 0;
          for (int jb = 0; jb < 64; ++jb) { if (!((selmask >> jb) & 1ull)) continue;
              const int pos = jb * 64 + lane; float a[4]; dot4(KS + ((size_t)b * SEQ + pos) * 512 + g * 128, qs, a);
              const int dist = t - pos; f32x4 l = {NINF, NINF, NINF, NINF};
              if (dist >= 0) { const bool nr = dist < 128; l.x = a[0] + (nr ? bp[dist] : 0.f); l.y = a[1] + (nr ? bp[128 + dist] : 0.f); l.z = a[2] + (nr ? bp[256 + dist] : 0.f); l.w = a[3] + (nr ? bp[384 + dist] : 0.f); }
              pl[slot * 64 + lane] = l; ++slot; } }
        __syncthreads();
        softmax4(pl, 1024, lane);
        __syncthreads();
        float os[4][2] = {};
        { int slot = 0;
          for (int jb = 0; jb < 64; ++jb) { if (!((selmask >> jb) & 1ull)) continue;
              if (jb * 64 <= t) { const unsigned* vb = (const unsigned*)(VS + ((size_t)b * SEQ + jb * 64) * 512 + g * 128) + lane;
#pragma unroll 8
                  for (int kk = 0; kk < 64; ++kk) pv_acc(pl[slot * 64 + kk], vb[(size_t)kk * 256], os); }
              ++slot; } }
        __syncthreads();
        for (int c = 0; c < 8; ++c) { const int m = lane + 64 * c, pos = t - 511 + m; const int pc = pos < 0 ? 0 : pos; float a[4]; dot4(KW + ((size_t)b * SEQ + pc) * 512 + g * 128, qs, a);
            const int dist = 511 - m; f32x4 l = {NINF, NINF, NINF, NINF};
            if (pos >= 0) { const bool nr = dist < 128; l.x = a[0] + (nr ? bp[dist] : 0.f); l.y = a[1] + (nr ? bp[128 + dist] : 0.f); l.z = a[2] + (nr ? bp[256 + dist] : 0.f); l.w = a[3] + (nr ? bp[384 + dist] : 0.f); }
            pl[m] = l; }
        __syncthreads();
        softmax4(pl, 512, lane);
        __syncthreads();
        float ow[4][2] = {};
        { const int m0 = t >= 511 ? 0 : 511 - t;
          const unsigned* vb = (const unsigned*)(VW + ((size_t)b * SEQ) * 512 + g * 128) + lane;
#pragma unroll 8
          for (int m = m0; m < 512; ++m) pv_acc(pl[m], vb[(size_t)(t - 511 + m) * 256], ow); }
        if (live) {
            const float* gt = GT + row * 48 + g * 12;
#pragma unroll
            for (int h = 0; h < 4; ++h) { const float gc = gate_of(gt + h * 3 + 0), gs = gate_of(gt + h * 3 + 1), gwn = gate_of(gt + h * 3 + 2);
                const unsigned zv = ((const unsigned*)(Z1 + row * DM + (g * 4 + h) * 128))[lane];
                const float z0 = __uint_as_float(zv << 16), z1 = __uint_as_float(zv & 0xffff0000u);
                const float r0 = (gc * oc[h][0] + gs * os[h][0] + gwn * ow[h][0]) * z0, r1 = (gc * oc[h][1] + gs * os[h][1] + gwn * ow[h][1]) * z1;
                ((unsigned*)(O1 + row * DM + (g * 4 + h) * 128))[lane] = pk2(r0, r1); }
        }
    }
}

__device__ __forceinline__ void compress_mfma(const Params& p, unsigned char* lds_g) {
    LAS unsigned char* L = (LAS unsigned char*)lds_g;
    const int tid = threadIdx.x, lane = tid & 63, wave = __builtin_amdgcn_readfirstlane(tid >> 6), r32 = lane & 31, hi = lane >> 5;
    const bf16_t* KV = (const bf16_t*)(p.ws + WS_E);
    const float* misc = (const float*)(p.ws + WS_MISC);
    constexpr int HRS = 272;
    const int nt = wave & 3, kh = wave >> 2;
    for (int unit = blockIdx.x; unit < 2 * 16 * 8; unit += gridDim.x) {
        const int which = unit >> 7, bg = (unit >> 3) & 15, i0 = (unit & 7) * 32, b = bg >> 2, g = bg & 3;
        const bf16_t* src = KV + (size_t)which * ((size_t)T * 512) + ((size_t)b * SEQ) * 512 + g * 128;
        const bf16_t* w1t = (const bf16_t*)(p.ws + (which ? WS_W1V : WS_W1K)); const bf16_t* w2t = (const bf16_t*)(p.ws + (which ? WS_W2V : WS_W2K));
        bf16_t* dst = (bf16_t*)(p.ws + (which ? WS_VCMP : WS_KCMP)) + (size_t)bg * NCMPP * 128;
        f32x16 acc;
#pragma unroll
        for (int i = 0; i < 16; ++i) acc[i] = 0.f;
        const bf16_t* arow = src + (size_t)(16 * (i0 + r32)) * 512 + 8 * hi;
        const bf16_t* brow = w1t + (size_t)(32 * nt + r32) * 4096 + 8 * hi;
        for (int sb_ = 128 * kh; sb_ < 128 * kh + 128; sb_ += 16) {
            bf16x8 fa[16], fb[16];
#pragma unroll
            for (int u = 0; u < 16; ++u) { const int s2 = sb_ + u, j = s2 >> 3, d0 = (s2 & 7) * 16; fa[u] = *(const bf16x8*)(arow + (size_t)j * 512 + d0); fb[u] = *(const bf16x8*)(brow + 16 * s2); }
            __builtin_amdgcn_sched_barrier(0);
#pragma unroll
            for (int u = 0; u < 16; ++u) acc = __builtin_amdgcn_mfma_f32_32x32x16_bf16(fa[u], fb[u], acc, 0, 0, 0);
            __builtin_amdgcn_sched_barrier(0);
        }
        __syncthreads();
        if (kh == 1) {
#pragma unroll
            for (int q = 0; q < 16; ++q) *(LAS float*)(L + 16384 + ((nt * 16 + q) * 64 + lane) * 4) = acc[q];
        }
        __syncthreads();
        if (kh == 0) {
            const float* b1 = which ? p.pv_b1 : p.pk_b1; const int n = 32 * nt + r32;
            float cv = b1[n];
#pragma unroll
            for (int sl = 0; sl < 8; ++sl) cv += misc[MISC_CVP / 4 + (which * 8 + sl) * 128 + n];
#pragma unroll
            for (int q = 0; q < 16; ++q) { const float h = acc[q] + *(const LAS float*)(L + 16384 + ((nt * 16 + q) * 64 + lane) * 4) + cv;
                *(LAS bf16_t*)(L + crow(q, hi) * HRS + n * 2) = (bf16_t)f2bf(gelu_tanh(h)); }
        }
        __syncthreads();
        if (kh == 0) {
            f32x16 o;
#pragma unroll
            for (int i = 0; i < 16; ++i) o[i] = 0.f;
#pragma unroll
            for (int s2 = 0; s2 < 8; ++s2) { const bf16x8 a = *(const LAS bf16x8*)(L + r32 * HRS + 32 * s2 + 16 * hi);
                const bf16x8 bb = *(const bf16x8*)(w2t + (size_t)(32 * nt + r32) * 128 + 16 * s2 + 8 * hi);
                o = __builtin_amdgcn_mfma_f32_32x32x16_bf16(a, bb, o, 0, 0, 0); }
#pragma unroll
            for (int q = 0; q < 16; ++q) { const int i = i0 + crow(q, hi); dst[(size_t)i * 128 + 32 * nt + r32] = (bf16_t)(i < NCMP ? f2bf(o[q]) : 0u); }
        }
    }
}

namespace at {
constexpr int SHM = 16384, BUF = 38912;
constexpr int L_V = 0, L_K = 16384, L_WS = 32768, L_BIAS = 34816, L_V1 = 38912, L_K1 = 55296, L_SEL = 71680, L_Q = 72192, L_IMP = L_Q + 65536, L_GT = L_IMP + 16384, L_END = L_GT + 8 * 64 * 4 * 4;
constexpr float LOG2E = 1.4426950408889634f;
constexpr float SM_THR = 8.f;
#define KSWZ(row, colB) ((row) * 256 + ((colB) ^ (((row) & 15) << 4)))
#define SBAR() __builtin_amdgcn_sched_barrier(0)
__device__ __forceinline__ int v_rd_base(int lane) { return ((lane & 3) << 3) | (((lane >> 2) & 3) << 6) | (((lane >> 4) & 1) << 5) | (((lane >> 5) & 1) << 8); }
constexpr int v_rd_off(int d0, int ks, int half) { return d0 * 512 + ks * 4096 + half * 2048; }
typedef short s16x4 __attribute__((ext_vector_type(4)));
__device__ __forceinline__ unsigned cvtpk(float lo, float hi) { unsigned r; asm volatile("v_cvt_pk_bf16_f32 %0, %1, %2" : "=v"(r) : "v"(lo), "v"(hi)); return r; }
struct DmaMap { int kr0, kc0, kr1, kc1, vr0, vc0, vr1, vc1; };
__device__ __forceinline__ DmaMap dma_map(int tid) {
    DmaMap m;
    { const int P = tid * 16, row = P >> 8; m.kr0 = row; m.kc0 = ((((P & 255) >> 4) ^ (row & 15))) * 8; m.kr1 = row + 32; m.kc1 = m.kc0; }
    { const int P = tid * 16, st = P >> 9, w = (P & 511) >> 1, kk = (st >> 2) * 8 + (w >> 5); m.vr0 = (kk & ~0xC) | ((kk & 4) << 1) | ((kk & 8) >> 1); m.vc0 = (st & 3) * 32 + (w & 31); }
    { const int P = tid * 16 + 8192, st = P >> 9, w = (P & 511) >> 1, kk = (st >> 2) * 8 + (w >> 5); m.vr1 = (kk & ~0xC) | ((kk & 4) << 1) | ((kk & 8) >> 1); m.vc1 = (st & 3) * 32 + (w & 31); }
    return m;
}
template <int VAR = 0>
__device__ __forceinline__ void dma_k(LAS unsigned char* Lb, const DmaMap& m, const bf16_t* Kp, int ld, int wave) {
    if constexpr ((VAR & 16) != 0) return;
    int o0 = m.kr0 * ld + m.kc0, o1 = m.kr1 * ld + m.kc1; asm volatile("" : "+v"(o0), "+v"(o1));
    __builtin_amdgcn_global_load_lds((const unsigned*)(Kp + o0), (LAS unsigned*)(Lb + L_K + wave * 1024), 16, 0, 0);
    __builtin_amdgcn_global_load_lds((const unsigned*)(Kp + o1), (LAS unsigned*)(Lb + L_K + wave * 1024 + 8192), 16, 0, 0);
}
template <int VAR = 0>
__device__ __forceinline__ void dma_v(LAS unsigned char* Lb, const DmaMap& m, const bf16_t* Vp, int ld, int wave) {
    if constexpr ((VAR & 16) != 0) return;
    int o0 = m.vr0 * ld + m.vc0, o1 = m.vr1 * ld + m.vc1; asm volatile("" : "+v"(o0), "+v"(o1));
    __builtin_amdgcn_global_load_lds((const unsigned*)(Vp + o0), (LAS unsigned*)(Lb + L_V + wave * 1024), 16, 0, 0);
    __builtin_amdgcn_global_load_lds((const unsigned*)(Vp + o1), (LAS unsigned*)(Lb + L_V + wave * 1024 + 8192), 16, 0, 0);
}
#define TILE_SYNC() do { asm volatile("s_waitcnt vmcnt(0) lgkmcnt(0)" ::: "memory"); if constexpr ((VAR & 8) == 0) __builtin_amdgcn_s_barrier(); asm volatile("" ::: "memory"); } while (0)
__device__ __forceinline__ int next_bit(unsigned long long m, int from) {
    const unsigned long long m2 = from >= 64 ? 0ull : (m & (~0ull << from));
    return m2 ? (int)__builtin_ctzll(m2) : -1;
}
template <int VAR, bool NEAR>
__device__ __forceinline__ void qkt_(f32x16& p0, f32x16& p1, int kaddr, int r32, int hi, const bf16x8* qr, const LAS float* bp) {
    if constexpr (NEAR) {
#pragma unroll
        for (int r = 0; r < 16; ++r) { const int c = (r & 3) + 8 * (r >> 2); p0[r] = bp[63 - c]; p1[r] = bp[31 - c]; }
    }
    int ka[4];
#pragma unroll
    for (int dd = 0; dd < 4; ++dd) ka[dd] = kaddr + KSWZ(r32, (dd * 16 + hi * 8) * 2);
    const int h1 = 128 - ((r32 & 8) << 5);
    bf16x8 kA[2][2], kB[2][2];
#define KRD(dst, a, off) asm volatile("ds_read_b128 %0, %1 offset:%2" : "=&v"(dst) : "v"(a), "i"(off) : "memory")
#define LOADG(G, K_) do { _Pragma("unroll") for (int e = 0; e < 2; ++e) { const int d0 = 2 * (G) + e; KRD(K_[e][0], ka[d0 & 3], 0); KRD(K_[e][1], ka[d0 & 3], 8192); } } while (0)
#define MMA1(G, e, K_, C0, C1) do { p0 = __builtin_amdgcn_mfma_f32_32x32x16_bf16(K_[e][0], qr[2 * (G) + e], C0, 0, 0, 0); p1 = __builtin_amdgcn_mfma_f32_32x32x16_bf16(K_[e][1], qr[2 * (G) + e], C1, 0, 0, 0); } while (0)
#define LGK(N) asm volatile("s_waitcnt lgkmcnt(" #N ")" ::: "memory")
    const f32x16 z16 = {0.f, 0.f, 0.f, 0.f, 0.f, 0.f, 0.f, 0.f, 0.f, 0.f, 0.f, 0.f, 0.f, 0.f, 0.f, 0.f};
    LOADG(0, kA); LOADG(1, kB);
#pragma unroll
    for (int dd = 0; dd < 4; ++dd) ka[dd] += h1;
    LGK(4); SBAR();
    if constexpr (NEAR) MMA1(0, 0, kA, p0, p1); else MMA1(0, 0, kA, z16, z16);
    MMA1(0, 1, kA, p0, p1); SBAR();
    LOADG(2, kA); LGK(4); SBAR();
    MMA1(1, 0, kB, p0, p1); MMA1(1, 1, kB, p0, p1); SBAR();
    LOADG(3, kB); LGK(4); SBAR();
    MMA1(2, 0, kA, p0, p1); MMA1(2, 1, kA, p0, p1); SBAR();
    LGK(0); SBAR();
    MMA1(3, 0, kB, p0, p1); MMA1(3, 1, kB, p0, p1);
#undef LGK
#undef MMA1
#undef LOADG
#undef KRD
}
template <int VAR = 0>
__device__ __forceinline__ void qkt(f32x16& p0, f32x16& p1, const LAS unsigned char* Kl, int r32, int hi, const bf16x8* qr, bool near = false, const LAS float* bp = nullptr) {
    const int kaddr = (int)(size_t)Kl;
    if (near) qkt_<VAR, true>(p0, p1, kaddr, r32, hi, qr, bp); else qkt_<VAR, false>(p0, p1, kaddr, r32, hi, qr, bp);
}
__device__ __forceinline__ void pv_tile(f32x16* o, int vb0, bf16x8 pa0, bf16x8 pa1, bf16x8 pa2, bf16x8 pa3) {
#define TRRD(dst, off) asm volatile("ds_read_b64_tr_b16 %0, %1 offset:%2" : "=&v"(dst) : "v"(vb0), "i"(off) : "memory")
#define PV_RD(d0, X) do { constexpr int b_ = v_rd_off(d0, 0, 0); \
        TRRD(X[0], b_); TRRD(X[1], b_ + 2048); TRRD(X[2], b_ + 4096); TRRD(X[3], b_ + 6144); TRRD(X[4], b_ + 8192); TRRD(X[5], b_ + 10240); TRRD(X[6], b_ + 12288); TRRD(X[7], b_ + 14336); } while (0)
#define PV_MM(d0, X) do { \
        o[d0] = __builtin_amdgcn_mfma_f32_32x32x16_bf16(pa0, (bf16x8){X[0][0], X[0][1], X[0][2], X[0][3], X[1][0], X[1][1], X[1][2], X[1][3]}, o[d0], 0, 0, 0); \
        o[d0] = __builtin_amdgcn_mfma_f32_32x32x16_bf16(pa1, (bf16x8){X[2][0], X[2][1], X[2][2], X[2][3], X[3][0], X[3][1], X[3][2], X[3][3]}, o[d0], 0, 0, 0); \
        o[d0] = __builtin_amdgcn_mfma_f32_32x32x16_bf16(pa2, (bf16x8){X[4][0], X[4][1], X[4][2], X[4][3], X[5][0], X[5][1], X[5][2], X[5][3]}, o[d0], 0, 0, 0); \
        o[d0] = __builtin_amdgcn_mfma_f32_32x32x16_bf16(pa3, (bf16x8){X[6][0], X[6][1], X[6][2], X[6][3], X[7][0], X[7][1], X[7][2], X[7][3]}, o[d0], 0, 0, 0); } while (0)
#define LGK(N) asm volatile("s_waitcnt lgkmcnt(" #N ")" ::: "memory")
    s16x4 xa[8], xb[8];
    PV_RD(0, xa); PV_RD(1, xb);
    LGK(8); SBAR(); PV_MM(0, xa); SBAR(); PV_RD(2, xa);
    LGK(8); SBAR(); PV_MM(1, xb); SBAR(); PV_RD(3, xb);
    LGK(8); SBAR(); PV_MM(2, xa); SBAR();
    LGK(0); SBAR(); PV_MM(3, xb);
#undef LGK
#undef PV_MM
#undef PV_RD
#undef TRRD
}
__device__ __forceinline__ void bias_mask(f32x16& p0, f32x16& p1, int dq, unsigned W, bool needmask, int hi) {
    const float NEG = -__builtin_inff();
    const int dq4 = dq - 4 * hi;
    if (needmask) {
#pragma unroll
        for (int r = 0; r < 16; ++r) { const int c = (r & 3) + 8 * (r >> 2);
            if ((unsigned)(dq4 - c) >= W) p0[r] = NEG;
            if ((unsigned)(dq4 - c - 32) >= W) p1[r] = NEG; }
    }
}
__device__ __forceinline__ void bias_mask_cmp(f32x16& p0, f32x16& p1, int dq, int dd, const LAS float* blx, int hi, bool needbias, bool needmask) {
    const float NEG = -__builtin_inff();
    const int dq4 = dq - 4 * hi, dd4 = dd - 64 * hi;
    if (needbias) {
        float bv[16];
#pragma unroll
        for (int r = 0; r < 16; ++r) { const int c = (r & 3) + 8 * (r >> 2); bv[r] = blx[64 + ((dd4 - 16 * c) & 127)]; }
        SBAR();
#pragma unroll
        for (int r = 0; r < 16; ++r) { const int c = (r & 3) + 8 * (r >> 2); p0[r] += ((unsigned)(dd4 - 16 * c) < 128u) ? bv[r] : 0.f; }
        SBAR();
#pragma unroll
        for (int r = 0; r < 16; ++r) { const int c = (r & 3) + 8 * (r >> 2); bv[r] = blx[64 + ((dd4 - 16 * c - 512) & 127)]; }
        SBAR();
#pragma unroll
        for (int r = 0; r < 16; ++r) { const int c = (r & 3) + 8 * (r >> 2); p1[r] += ((unsigned)(dd4 - 16 * c - 512) < 128u) ? bv[r] : 0.f; }
    }
    if (needmask) {
#pragma unroll
        for (int r = 0; r < 16; ++r) { const int c = (r & 3) + 8 * (r >> 2);
            if (c > dq4) p0[r] = NEG;
            if (c + 32 > dq4) p1[r] = NEG; }
    }
}
template <int CTRL> __device__ __forceinline__ float quad_perm(float v) { return __uint_as_float((unsigned)__builtin_amdgcn_update_dpp(0, (int)__float_as_uint(v), CTRL, 0xF, 0xF, true)); }
__device__ __forceinline__ float rowmax32(const f32x16& p0, const f32x16& p1) {
    float pmax = p0[0];
#pragma unroll
    for (int r = 1; r < 16; ++r) pmax = fmaxf(pmax, p0[r]);
#pragma unroll
    for (int r = 0; r < 16; ++r) pmax = fmaxf(pmax, p1[r]);
    auto rr = __builtin_amdgcn_permlane32_swap(__float_as_uint(pmax), __float_as_uint(pmax), false, false);
    return fmaxf(__uint_as_float(rr[0]), __uint_as_float(rr[1]));
}
__device__ __forceinline__ float halfswap_add(float ps) {
    auto rr = __builtin_amdgcn_permlane32_swap(__float_as_uint(ps), __float_as_uint(ps), false, false);
    return __uint_as_float(rr[0]) + __uint_as_float(rr[1]);
}
#define EXP_PK4(P, B_, OUT) do { _Pragma("unroll") for (int e_ = 0; e_ < 8; ++e_) { P[B_ + e_] = (VAR & 1) ? fmaf(P[B_ + e_], LOG2E, mnL) : __builtin_amdgcn_exp2f(fmaf(P[B_ + e_], LOG2E, mnL)); ps += P[B_ + e_]; } \
        unsigned a0 = cvtpk(P[B_ + 0], P[B_ + 1]), a1 = cvtpk(P[B_ + 2], P[B_ + 3]); \
        unsigned b0 = cvtpk(P[B_ + 4], P[B_ + 5]), b1 = cvtpk(P[B_ + 6], P[B_ + 7]); \
        auto r0 = __builtin_amdgcn_permlane32_swap(a0, b0, false, false); auto r1 = __builtin_amdgcn_permlane32_swap(a1, b1, false, false); \
        u32x4 w = {r0[0], r1[0], r0[1], r1[1]}; OUT = *reinterpret_cast<bf16x8*>(&w); } while (0)
template <int VAR = 0>
__device__ __forceinline__ void sm_pv(f32x16& p0, f32x16& p1, float& m_reg, float& l_reg, f32x16* o, int vb, LAS float* al, int r32, int hi, bool rowsel = true) {
    const float pmax = rowsel ? rowmax32(p0, p1) : -__builtin_inff();
    float alpha = 1.f;
    if (!__all(pmax - m_reg <= SM_THR)) {
        const float mn = fmaxf(m_reg, pmax);
        alpha = __builtin_amdgcn_exp2f((m_reg - mn) * LOG2E); m_reg = mn;
        if (hi == 0) al[r32] = alpha; asm volatile("s_waitcnt lgkmcnt(0)" ::: "memory");
        float av[16];
#pragma unroll
        for (int r = 0; r < 16; ++r) av[r] = al[crow(r, hi)];
        SBAR();
#pragma unroll
        for (int d_ = 0; d_ < 4; ++d_)
#pragma unroll
            for (int r = 0; r < 16; ++r) o[d_][r] *= av[r]; }
    const float mnL = rowsel ? -m_reg * LOG2E : -__builtin_inff();
    float ps = 0.f;
    bf16x8 pa0, pa1, pa2, pa3;
    EXP_PK4(p0, 0, pa0); EXP_PK4(p0, 8, pa1); EXP_PK4(p1, 0, pa2); EXP_PK4(p1, 8, pa3);
    l_reg = l_reg * alpha + halfswap_add(ps);
    SBAR();
    if constexpr ((VAR & 2) == 0) pv_tile(o, vb, pa0, pa1, pa2, pa3);
    else { asm volatile("" :: "v"(pa0), "v"(pa1), "v"(pa2), "v"(pa3)); }
}
}

template <int VAR = 0>
__device__ __forceinline__ void nsa_fused(const Params& p, unsigned char* lds_g, bf16_t* O1, const int tidv) {
    using namespace at;
    LAS unsigned char* L = (LAS unsigned char*)lds_g;
    const int tid = tidv, lane = tid & 63, wave = __builtin_amdgcn_readfirstlane(tid >> 6), r32 = lane & 31, hi = lane >> 5;
    const bf16_t* Q1 = (const bf16_t*)(p.ws + WS_D); const bf16_t* KV = (const bf16_t*)(p.ws + WS_E); const bf16_t* Z1 = (const bf16_t*)(p.ws + WS_G);
    const float* GT = (const float*)(p.ws + WS_GATES); const bf16_t* KC = (const bf16_t*)(p.ws + WS_KCMP); const bf16_t* VC = (const bf16_t*)(p.ws + WS_VCMP);
    const float* biasp = (const float*)(p.ws + WS_MISC + MISC_BIASP);
    const size_t TS = (size_t)T * 512;
    LAS float* wsf = (LAS float*)(L + L_WS) + wave * 64;
    LAS float* blw = (LAS float*)(L + L_BIAS);
    LAS float* impS = (LAS float*)(L + L_IMP);
    LAS unsigned* totL = (LAS unsigned*)(L + L_Q) + wave * 2048 + lane;
    LAS unsigned long long* selS = (LAS unsigned long long*)(L + L_SEL);
    const int vb0 = (int)(size_t)(L + L_V) + v_rd_base(lane);
    const int hh = r32 & 3, tl = r32 >> 2;
    const LAS float* bl = blw + hh * 256;
    const DmaMap dm = dma_map(tid);
    const int G = gridDim.x;
    if (wave >= 4) __builtin_amdgcn_s_setprio(1);
    for (int it = blockIdx.x; it < 16 * 32; it += G) {
        int bg, y;
        if (G == 256) { const int xcd = it & 7, q = it >> 3; bg = (xcd * 2 + (q / 32)) & 15; y = q % 32; } else { bg = it / 32; y = it % 32; }
        const int b = bg >> 2, g = bg & 3;
        __syncthreads();
        for (int e = tid; e < 1024; e += 512) { const int d_ = (e & 255) - 64; blw[e] = (d_ >= 0 && d_ < 128) ? biasp[(g * 4 + (e >> 8)) * 128 + d_] : 0.f; }
        for (int pass = 0; pass < 2; ++pass) {
            const int x = pass ? 63 - y : y;
            const int t0 = 64 * x, t = t0 + 8 * wave + tl;
            const size_t row = (size_t)b * SEQ + t;
            const bf16_t* Kb = KV + ((size_t)b * SEQ) * 512 + g * 128;
            const bf16_t* KCb = KC + (size_t)bg * NCMPP * 128; const bf16_t* VCb = VC + (size_t)bg * NCMPP * 128;
            __syncthreads();
            dma_k<VAR>(L, dm, KCb, 128, wave);
            bf16x8 qr[8];
            int qlo_ = lane; asm volatile("" : "+v"(qlo_)); qlo_ = (qlo_ & 3) * 128 + (qlo_ >> 5) * 8;
#pragma unroll
            for (int d0 = 0; d0 < 8; ++d0) qr[d0] = *(const bf16x8*)(Q1 + row * DM + (g * 4) * 128 + qlo_ + d0 * 16);
            LAS float* gtS = (LAS float*)(L + L_GT) + (wave * 64 + lane) * 4;
            { const float* gp_ = GT + row * 48 + (g * 4 + hh) * 3; float gq_[3][4];
#pragma unroll
              for (int c_ = 0; c_ < 3; ++c_)
#pragma unroll
                  for (int k_ = 0; k_ < 4; ++k_) gq_[c_][k_] = gp_[(size_t)k_ * T * 48 + c_];
#pragma unroll
              for (int c_ = 0; c_ < 3; ++c_) gtS[c_] = sigmoidf_((gq_[c_][0] + gq_[c_][1]) + (gq_[c_][2] + gq_[c_][3])); }
            __builtin_amdgcn_s_waitcnt(0x0F70);
            f32x16 o[4]; f32x16 p0, p1; float m_reg, l_reg;
#define BRANCH_INIT() do { m_reg = -1e30f; l_reg = 0.f; _Pragma("unroll") for (int d_ = 0; d_ < 4; ++d_) _Pragma("unroll") for (int r = 0; r < 16; ++r) o[d_][r] = 0.f; } while (0)
#define BRANCH_END(cidx, FIRST) do { \
            if (hi == 0) { wsf[r32] = l_reg > 0.f ? gtS[cidx] / l_reg : 0.f; } \
            asm volatile("s_waitcnt lgkmcnt(0)" ::: "memory"); \
            _Pragma("unroll") for (int r = 0; r < 8; ++r) { const float sc0_ = wsf[crow(2 * r, hi)], sc1_ = wsf[crow(2 * r + 1, hi)]; \
                _Pragma("unroll") for (int d_ = 0; d_ < 4; ++d_) { const unsigned tp_ = (FIRST) ? 0u : totL[(d_ * 8 + r) * 64]; \
                    totL[(d_ * 8 + r) * 64] = cvtpk(__uint_as_float(tp_ << 16) + o[d_][2 * r] * sc0_, __uint_as_float(tp_ & 0xffff0000u) + o[d_][2 * r + 1] * sc1_); } } \
            asm volatile("s_waitcnt lgkmcnt(0)" ::: "memory"); } while (0)
            const int ncmp_t = (VAR & 128) ? 0 : (4 * x + 2) / 64 + 1;
            const int ic = (t - 31) >> 4;
            int buf = 0;
            BRANCH_INIT();
            TILE_SYNC();
            for (int tt = 0; tt < ncmp_t; ++tt) {
                LAS unsigned char* Lb = L + buf * BUF; LAS unsigned char* Ln = L + (buf ^ 1) * BUF;
                if (tt + 1 < ncmp_t) dma_k<VAR>(Ln, dm, KCb + (size_t)(tt + 1) * 64 * 128, 128, wave);
                else { dma_k<VAR>(Ln, dm, KCb, 128, wave); dma_v<VAR>(Ln, dm, VCb, 128, wave); }
                qkt<VAR>(p0, p1, Lb + L_K, r32, hi, qr);
                bias_mask_cmp(p0, p1, ic - 64 * tt, t - 31 - 1024 * tt, bl, hi, (t0 + 8 * wave - 31) - 16 * (64 * tt + 63) < 128, 64 * tt + 63 > ((t0 + 8 * wave - 31) >> 4));
                const float pmax = rowmax32(p0, p1); const float mn = fmaxf(m_reg, pmax); const float alpha = __builtin_amdgcn_exp2f((m_reg - mn) * LOG2E); m_reg = mn;
                const float mnL = -mn * LOG2E; float ps = 0.f;
#pragma unroll
                for (int r = 0; r < 16; ++r) { ps += __builtin_amdgcn_exp2f(fmaf(p0[r], LOG2E, mnL)); ps += __builtin_amdgcn_exp2f(fmaf(p1[r], LOG2E, mnL)); }
                l_reg = l_reg * alpha + halfswap_add(ps);
                TILE_SYNC(); buf ^= 1;
            }
            const float m_c = m_reg, l_c = l_reg, il_c = l_c > 0.f ? 1.f / l_c : 0.f; float imp_carry = 0.f;
            for (int tt = 0; tt < ncmp_t; ++tt) {
                LAS unsigned char* Lb = L + buf * BUF; LAS unsigned char* Ln = L + (buf ^ 1) * BUF;
                if (tt + 1 < ncmp_t) { dma_k<VAR>(Ln, dm, KCb + (size_t)(tt + 1) * 64 * 128, 128, wave); dma_v<VAR>(Ln, dm, VCb + (size_t)(tt + 1) * 64 * 128, 128, wave); }
                qkt<VAR>(p0, p1, Lb + L_K, r32, hi, qr);
                bias_mask_cmp(p0, p1, ic - 64 * tt, t - 31 - 1024 * tt, bl, hi, (t0 + 8 * wave - 31) - 16 * (64 * tt + 63) < 128, 64 * tt + 63 > ((t0 + 8 * wave - 31) >> 4));
                const float mnL = -m_c * LOG2E;
#pragma unroll
                for (int r = 0; r < 16; ++r) { p0[r] = __builtin_amdgcn_exp2f(fmaf(p0[r], LOG2E, mnL)); p1[r] = __builtin_amdgcn_exp2f(fmaf(p1[r], LOG2E, mnL)); }
                { float qa[8], xo[8];
#pragma unroll
                  for (int gq = 0; gq < 8; ++gq) { const int rb = (gq & 3) * 4;
                      float qs_ = gq < 4 ? (p0[rb] + p0[rb + 1]) + (p0[rb + 2] + p0[rb + 3]) : (p1[rb] + p1[rb + 1]) + (p1[rb + 2] + p1[rb + 3]);
                      float ls_ = gq < 4 ? p0[rb + 3] : p1[rb + 3];
                      qs_ *= il_c; ls_ *= il_c;
                      qs_ += quad_perm<0xB1>(qs_); qs_ += quad_perm<0x4E>(qs_); ls_ += quad_perm<0xB1>(ls_); ls_ += quad_perm<0x4E>(ls_);
                      qa[gq] = qs_; { auto rr_ = __builtin_amdgcn_permlane32_swap(__float_as_uint(ls_), __float_as_uint(ls_), false, false); xo[gq] = __uint_as_float(hi ? rr_[0] : rr_[1]); } }
#pragma unroll
                  for (int gq = 0; gq < 8; ++gq) { const float prev = hi ? xo[gq] : (gq ? xo[gq - 1] : imp_carry);
                      if (hh == 0) impS[(8 * wave + tl) * 64 + 16 * tt + 2 * gq + hi] = qa[gq] + prev; }
                  imp_carry = xo[7]; }
                bf16x8 pa0, pa1, pa2, pa3;
#define PK4(P, B_, OUT) do { unsigned a0 = cvtpk(P[B_ + 0], P[B_ + 1]), a1 = cvtpk(P[B_ + 2], P[B_ + 3]); \
        unsigned b0 = cvtpk(P[B_ + 4], P[B_ + 5]), b1 = cvtpk(P[B_ + 6], P[B_ + 7]); \
        auto r0 = __builtin_amdgcn_permlane32_swap(a0, b0, false, false); auto r1 = __builtin_amdgcn_permlane32_swap(a1, b1, false, false); \
        u32x4 w = {r0[0], r1[0], r0[1], r1[1]}; OUT = *reinterpret_cast<bf16x8*>(&w); } while (0)
                PK4(p0, 0, pa0); PK4(p0, 8, pa1); PK4(p1, 0, pa2); PK4(p1, 8, pa3); SBAR();
#undef PK4
                pv_tile(o, vb0 + buf * BUF, pa0, pa1, pa2, pa3);
                TILE_SYNC(); buf ^= 1;
            }
            l_reg = l_c;
            { LAS unsigned char* Lb = L + buf * BUF; dma_k<VAR>(Lb, dm, Kb + 2 * TS, 512, wave); dma_v<VAR>(Lb, dm, Kb + 3 * TS, 512, wave); }
            if (x < 16) { if (lane == 0) { for (int i = 0; i < 8; ++i) selS[8 * wave + i] = ~0ull; } }
            else {
                int ia = (8 * wave * 64 + lane) * 4; asm volatile("" : "+v"(ia));
                const LAS float* ip = (const LAS float*)((LAS unsigned char*)impS + ia);
                const int j = lane;
                const bool forced = (j == 0) || (j == x) || (j == x - 1), visible = j <= x;
                unsigned key[8], thr[8];
#pragma unroll
                for (int i = 0; i < 8; ++i) { const float imp = ip[i * 64];
                    key[i] = forced ? 0xffffffffu : (visible ? __float_as_uint(imp) + 1u : 0u); thr[i] = 0u; }
#pragma unroll 1
                for (int bit = 31; bit >= 0; --bit) {
#pragma unroll
                    for (int i = 0; i < 8; ++i) { const unsigned c = thr[i] | (1u << bit); if (__popcll(__ballot(key[i] >= c)) >= 16) thr[i] = c; } }
#pragma unroll
                for (int i = 0; i < 8; ++i) {
                    const unsigned long long gt = __ballot(key[i] > thr[i]), eq = __ballot(key[i] == thr[i]);
                    const int need = 16 - __popcll(gt);
                    const bool pick = (key[i] > thr[i]) || ((key[i] == thr[i]) && (__popcll(eq & ((1ull << j) - 1ull)) < need));
                    const unsigned long long mk = __ballot(pick);
                    if (lane == 0) selS[8 * wave + i] = mk; }
            }
            TILE_SYNC();
            unsigned long long um = 0ull, wm = 0ull;
            for (int i = 0; i < 64; ++i) { const unsigned long long v = selS[i]; um |= v; if ((i >> 3) == wave) wm |= v; }
            const unsigned long long mym = selS[8 * wave + tl];
            um &= (x >= 63) ? ~0ull : ((1ull << (x + 1)) - 1ull);
            um = ((unsigned long long)__builtin_amdgcn_readfirstlane((unsigned)(um >> 32)) << 32) | (unsigned)__builtin_amdgcn_readfirstlane((unsigned)um);
            wm = ((unsigned long long)__builtin_amdgcn_readfirstlane((unsigned)(wm >> 32)) << 32) | (unsigned)__builtin_amdgcn_readfirstlane((unsigned)wm);
            int j = 0;
            if constexpr ((VAR & 256) != 0) j = -1;
            BRANCH_END(0, true);
            BRANCH_INIT();
            TILE_SYNC();
            while (j >= 0) {
                LAS unsigned char* Lb = L + buf * BUF; LAS unsigned char* Ln = L + (buf ^ 1) * BUF;
                const int jn = next_bit(um, j + 1);
                if (jn >= 0) { dma_k<VAR>(Ln, dm, Kb + 2 * TS + (size_t)(64 * jn) * 512, 512, wave); dma_v<VAR>(Ln, dm, Kb + 3 * TS + (size_t)(64 * jn) * 512, 512, wave); }
                else { const int jl = (x >= 8 ? x - 8 : 0); dma_k<VAR>(Ln, dm, Kb + 4 * TS + (size_t)(64 * jl) * 512, 512, wave); dma_v<VAR>(Ln, dm, Kb + 5 * TS + (size_t)(64 * jl) * 512, 512, wave); }
                if ((wm >> j) & 1ull) {
                    qkt<VAR>(p0, p1, Lb + L_K, r32, hi, qr, j + 2 >= x, bl + (t - 64 * j - 4 * hi + 1));
                    bias_mask(p0, p1, t - 64 * j, 0x7fffffffu, j == x, hi);
                    sm_pv<VAR>(p0, p1, m_reg, l_reg, o, vb0 + buf * BUF, wsf, r32, hi, (mym >> j) & 1ull); }
                TILE_SYNC(); buf ^= 1;
                j = jn;
            }
            BRANCH_END(1, false);
            BRANCH_INIT();
            for (int jw = (x >= 8 ? x - 8 : 0); jw <= x && !(VAR & 512); ++jw) {
                LAS unsigned char* Lb = L + buf * BUF; LAS unsigned char* Ln = L + (buf ^ 1) * BUF;
                if (jw < x) { dma_k<VAR>(Ln, dm, Kb + 4 * TS + (size_t)(64 * (jw + 1)) * 512, 512, wave); dma_v<VAR>(Ln, dm, Kb + 5 * TS + (size_t)(64 * (jw + 1)) * 512, 512, wave); }
                qkt<VAR>(p0, p1, Lb + L_K, r32, hi, qr, jw + 2 >= x, bl + (t - 64 * jw - 4 * hi + 1));
                bias_mask(p0, p1, t - 64 * jw, 512u, jw == x || jw + 8 == x, hi);
                sm_pv<VAR>(p0, p1, m_reg, l_reg, o, vb0 + buf * BUF, wsf, r32, hi);
                TILE_SYNC(); buf ^= 1;
            }
            BRANCH_END(2, false);
            { LAS unsigned char* Tt = L + (wave < 4 ? 0 : BUF) + (wave & 3) * 8192;
              int te_ = t0 + 8 * wave; asm volatile("" : "+s"(te_));
              u32x4 zz[8], tt8[8]; size_t eo[8]; int ln_e = lane; asm volatile("" : "+v"(ln_e));
#pragma unroll
              for (int i = 0; i < 8; ++i) { const int idx = ln_e + 64 * i, rw = idx >> 4, ch = idx & 15;
                  eo[i] = ((size_t)b * SEQ + te_ + (rw >> 2)) * DM + (g * 4 + (rw & 3)) * 128 + 8 * ch;
                  zz[i] = *(const u32x4*)(Z1 + eo[i]); }
              __builtin_amdgcn_sched_barrier(0);
#pragma unroll
              for (int r = 0; r < 8; ++r)
#pragma unroll
                  for (int d_ = 0; d_ < 4; ++d_) { const unsigned tp_ = totL[(d_ * 8 + r) * 64];
                      *(LAS bf16_t*)(Tt + crow(2 * r, hi) * 256 + (32 * d_ + r32) * 2) = (bf16_t)(tp_ & 0xffffu); *(LAS bf16_t*)(Tt + crow(2 * r + 1, hi) * 256 + (32 * d_ + r32) * 2) = (bf16_t)(tp_ >> 16); }
              asm volatile("s_waitcnt lgkmcnt(0)" ::: "memory");
#pragma unroll
              for (int i = 0; i < 8; ++i) { const int idx = ln_e + 64 * i, rw = idx >> 4, ch = idx & 15; tt8[i] = *(const LAS u32x4*)(Tt + rw * 256 + ch * 16); }
              __builtin_amdgcn_sched_barrier(0);
#pragma unroll
              for (int i = 0; i < 8; ++i) { u32x4 w;
#define MULPK(T_, Z_) cvtpk(__uint_as_float((T_) << 16) * __uint_as_float((Z_) << 16), __uint_as_float((T_) & 0xffff0000u) * __uint_as_float((Z_) & 0xffff0000u))
                  w.x = MULPK(tt8[i].x, zz[i].x); w.y = MULPK(tt8[i].y, zz[i].y); w.z = MULPK(tt8[i].z, zz[i].z); w.w = MULPK(tt8[i].w, zz[i].w);
#undef MULPK
                  *(u32x4*)(O1 + eo[i]) = w; }
              asm volatile("s_waitcnt lgkmcnt(0)" ::: "memory"); }
#undef BRANCH_INIT
#undef BRANCH_END
        }
    }
    __builtin_amdgcn_s_setprio(0);
}

#define XB_TMO      128
#define XB_XCNT(j)  (256  + 64 * (j))
#define XB_XSUB(j)  (1280 + 64 * (j))
#define XB_XGEN(j)  (2304 + 64 * (j))
#define XB_TOP      3328
#define XB_TOPGEN   3392
#define XCD_BAR_WORDS 3456
#define XB_SPIN_CAP (1u << 22)
__device__ __forceinline__ unsigned xb_ld(unsigned* p)              { return __hip_atomic_load(p, __ATOMIC_RELAXED, __HIP_MEMORY_SCOPE_AGENT); }
__device__ __forceinline__ unsigned xb_add(unsigned* p, unsigned v) { return __hip_atomic_fetch_add(p, v, __ATOMIC_RELAXED, __HIP_MEMORY_SCOPE_AGENT); }
__device__ __forceinline__ unsigned xb_xcc_id() { return (unsigned)__builtin_amdgcn_s_getreg((3 << 11) | 20) & 0xFu; }
#define XB_SPIN(cond, bar) do { unsigned _sp = 0; while (cond) { __builtin_amdgcn_s_sleep(1); \
    if ((++_sp & 255u) == 0u) { if (xb_ld(&(bar)[XB_TMO])) break; if (_sp > XB_SPIN_CAP) { atomicAdd(&(bar)[XB_TMO], 1u); break; } } } } while (0)
struct XcdBarrier { unsigned* bar; unsigned x; volatile LAS unsigned* st; };
__device__ __forceinline__ XcdBarrier xcd_barrier_post(unsigned* bar, volatile LAS unsigned* st) {
    XcdBarrier b; b.bar = bar; b.x = xb_xcc_id(); b.st = st;
    if (threadIdx.x == 0) (void)xb_add(&bar[XB_XCNT(b.x)], 1u);
    return b;
}
__device__ __forceinline__ void xcd_barrier_complete(unsigned* bar, unsigned x, unsigned& nloc, unsigned& nx) {
    const unsigned G = gridDim.x * gridDim.y * gridDim.z;
    unsigned sum, cnt, mine, sp = 0u;
    for (;;) {
        sum = 0u; cnt = 0u; mine = 0u;
#pragma unroll
        for (unsigned j = 0; j < 16; ++j) { const unsigned c = xb_ld(&bar[XB_XCNT(j)]); sum += c; cnt += (c > 0u) ? 1u : 0u; mine = (j == x) ? c : mine; }
        if (sum == G) break;
        __builtin_amdgcn_s_sleep(1);
        if ((++sp & 255u) == 0u) { if (xb_ld(&bar[XB_TMO])) break; if (sp > XB_SPIN_CAP) { atomicAdd(&bar[XB_TMO], 1u); break; } }
    }
    nloc = mine > 0u ? mine : 1u; nx = cnt > 0u ? cnt : 1u;
}
__device__ __forceinline__ void xcd_barrier(const XcdBarrier& b, const int tidv) {
    asm volatile("s_waitcnt vmcnt(0)" ::: "memory");
    __syncthreads();
    if (tidv == 0) {
        unsigned* bar = b.bar;
        __builtin_amdgcn_s_waitcnt(0);
        unsigned nloc = b.st[0], nx = b.st[1];
        if (nloc == 0u) { xcd_barrier_complete(bar, b.x, nloc, nx); b.st[0] = nloc; b.st[1] = nx; }
        const unsigned old = xb_add(&bar[XB_XSUB(b.x)], 1u);
        const unsigned gen = old / nloc;
        if (old + 1u == (gen + 1u) * nloc) {
            __builtin_amdgcn_fence(__ATOMIC_RELEASE, "agent");
            asm volatile("s_waitcnt vmcnt(0)" ::: "memory");
            const unsigned og = xb_add(&bar[XB_TOP], 1u);
            const unsigned tg = og / nx;
            if (og + 1u == (tg + 1u) * nx) xb_add(&bar[XB_TOPGEN], 1u);
            else XB_SPIN(xb_ld(&bar[XB_TOPGEN]) == tg, bar);
            __builtin_amdgcn_fence(__ATOMIC_ACQUIRE, "agent");
            xb_add(&bar[XB_XGEN(b.x)], 1u);
            asm volatile("s_waitcnt vmcnt(0)" ::: "memory");
        } else {
            XB_SPIN(xb_ld(&bar[XB_XGEN(b.x)]) == gen, bar);
            __builtin_amdgcn_fence(__ATOMIC_ACQUIRE, "agent");
            asm volatile("s_waitcnt vmcnt(0)" ::: "memory");
        }
    }
    __syncthreads();
}

constexpr int NPHASE = 11;
__global__ void __launch_bounds__(512, 2) mk_fwd(Params p) {
    extern __shared__ __attribute__((aligned(16))) unsigned char lds[];
    cg::grid_group grid = cg::this_grid();
    const int lo = p.ph_lo, hi = p.ph_hi;
    PG8_LAS unsigned char* ldsl = (PG8_LAS unsigned char*)lds;
    unsigned char* ws = p.ws;
    bf16_t* A = (bf16_t*)(ws + WS_A);
    if (threadIdx.x < 4) ((LAS unsigned*)((LAS unsigned char*)lds + LDS_BYTES - 16))[threadIdx.x] = 0u;
    __syncthreads();
    XcdBarrier xbar = xcd_barrier_post((unsigned*)(p.ws + WS_BAR), (volatile LAS unsigned*)((LAS unsigned char*)lds + LDS_BYTES - 16));
#define IN(k) (lo <= (k) && (k) < hi)
#define SEAM(k) do { if (IN(k) && IN((k) + 1)) xcd_barrier(xbar, tidv); } while (0)
    if (p.ws == nullptr) grid.sync();
#define RUN(k, BODY) do { if (IN(k)) { BODY; } if (PROBE_REP == (k)) { xcd_barrier(xbar, tidv); BODY; } SEAM(k); } while (0)
#define GEMM_PHASE(EPI, BT, N_, ...) do { pg8::Gemm g{A, (const bf16_t*)(ws + (BT)), T, (N_), DM}; pg8::StaticOrder S; S.init(T, (N_), gridDim.x, blockIdx.x); \
        pg8::EPI E{__VA_ARGS__}; pg8::gemm_phase<pg8::EPI, pg8::StaticOrder, true, true>(ldsl, g, S, E, tidv); } while (0)
    const int wv_s = __builtin_amdgcn_readfirstlane(threadIdx.x >> 6);
    int tidv = threadIdx.x;
    RUN(0, (p0_prep(p, lds), rows_rms16(p.x, p.norm_gains, A, tidv)));
#if !MK_SKEL
    RUN(1, GEMM_PHASE(EpiHgrnIn, WS_W0IN, N0IN, ws, p.out, (const float*)(ws + WS_MISC + MISC_LB)));
#if HGRN_NAIVE
    RUN(2, hgrn_naive(p, lds));
#else
    RUN(2, hgrn_chunk4(p, lds));
#if PROBE_REP == 21
    xcd_barrier(xbar, tidv); hgrn_chunk3<1>(p, lds);
#elif PROBE_REP == 22
    xcd_barrier(xbar, tidv); hgrn_chunk3<2>(p, lds);
#endif
#endif
    if (gridDim.x != 256) { RUN(3, hgrn_headnorm(p)); }
    RUN(4, ({ pg8::Gemm g{A, (const bf16_t*)(ws + WS_W0OUT), T, DM, DM}; pg8::StaticOrder S; S.init(T, DM, gridDim.x, blockIdx.x);
        pg8::EpiResidInit<true, true> E{p.x, (bf16_t*)(ws + WS_B), (float*)(ws + WS_SSQ)}; pg8::gemm_phase<pg8::EpiResidInit<true, true>, pg8::StaticOrder, true, true>(ldsl, g, S, E, tidv); }));
    RUN(6, ({ pg8::Gemm g{(const bf16_t*)(ws + WS_B), (const bf16_t*)(ws + WS_W1IN), T, N1PAD, DM}; pg8::SplitTailOrder S; S.init(T, N1PAD - 256, gridDim.x, blockIdx.x);
        pg8::EpiNsaIn E{ws, (float*)(ws + WS_GATES), ldsl, (const float*)(ws + WS_SSQ)}; pg8::gemm_phase<pg8::EpiNsaIn, pg8::SplitTailOrder, true, true>(ldsl, g, S, E, tidv); }));
#if NSA_NAIVE
    RUN(7, compress_naive(p, lds));
    RUN(8, nsa_naive(p, lds, A));
#else
    RUN(7, compress_mfma(p, lds));
#if NSA_DIFF
    if (IN(8)) { bf16_t* OA = (bf16_t*)(ws + WS_W0IN); nsa_naive(p, lds, OA); grid.sync(); nsa_fused(p, lds, A, tidv); grid.sync();
        for (size_t e = (size_t)blockIdx.x * 512 + threadIdx.x; e < (size_t)T * DM; e += (size_t)gridDim.x * 512) { const float a = bf2f(A[e]), r = bf2f(OA[e]); A[e] = (bf16_t)f2bf(a + NSA_AMP * (a - r)); } } SEAM(8);
#else
    tidv = wv_s * 64 + (int)__builtin_amdgcn_mbcnt_hi(~0u, __builtin_amdgcn_mbcnt_lo(~0u, 0u));
    RUN(8, nsa_fused(p, lds, A, tidv));
#ifdef PROBE_VAR
    if (IN(9)) { tidv = wv_s * 64 + (int)__builtin_amdgcn_mbcnt_hi(~0u, __builtin_amdgcn_mbcnt_lo(~0u, 0u)); nsa_fused<PROBE_VAR>(p, lds, (bf16_t*)(ws + WS_W0IN), tidv);
        tidv = wv_s * 64 + (int)__builtin_amdgcn_mbcnt_hi(~0u, __builtin_amdgcn_mbcnt_lo(~0u, 0u)); xcd_barrier(xbar, tidv); }
#endif
#endif
#endif
    RUN(9, GEMM_PHASE(EpiResidInit<false>, WS_W1OUT, DM, (const bf16_t*)(ws + WS_B), (bf16_t*)(ws + WS_B)));
    RUN(10, rows_rms_b<false>((const bf16_t*)(ws + WS_B), p.final_gain, p.out, tidv));
#else
    for (int k = 1; k < 10; ++k) { SEAM(k); }
    if (IN(10)) { rows_rms_f32(p.x, p.final_gain, p.out, tidv); }
#endif
#undef IN
#undef SEAM
#undef RUN
#undef GEMM_PHASE
}

extern "C" void kernel_launch(void* const* d_in, const int* in_sizes, int n_in, void* d_out, int out_size, void* d_ws, size_t ws_size, hipStream_t stream) {
    static int grid = 0;
    if (grid == 0) {
        if (n_in != 18 || in_sizes[0] != T * DM || out_size != T * DM || ws_size < WS_END) {
            fprintf(stderr, "kernel_launch: unexpected shapes (n_in %d, in0 %d, out %d, ws %zu)\n", n_in, n_in > 0 ? in_sizes[0] : -1, out_size, ws_size); grid = -1; return; }
        int dev = 0, cus = 0, per_cu = 0;
        if (hipGetDevice(&dev) != hipSuccess || hipDeviceGetAttribute(&cus, hipDeviceAttributeMultiprocessorCount, dev) != hipSuccess) { grid = -1; return; }
        if (hipFuncSetAttribute((const void*)mk_fwd, hipFuncAttributeMaxDynamicSharedMemorySize, LDS_BYTES) != hipSuccess) { fprintf(stderr, "kernel_launch: hipFuncSetAttribute failed\n"); grid = -1; return; }
        if (hipOccupancyMaxActiveBlocksPerMultiprocessor(&per_cu, (const void*)mk_fwd, 512, LDS_BYTES) != hipSuccess || per_cu < 1) { fprintf(stderr, "kernel_launch: occupancy query says %d\n", per_cu); per_cu = 1; }
        (void)hipGetLastError();
        grid = cus;
    }
    if (grid < 0) return;
    Params p{};
    p.x = (const float*)d_in[0]; p.norm_gains = (const float*)d_in[1]; p.final_gain = (const float*)d_in[2]; p.rel_bias = (const float*)d_in[3]; p.hgrn_lb = (const float*)d_in[4];
    p.hgrn_w_in = (const float*)d_in[5]; p.hgrn_head_gain = (const float*)d_in[6]; p.hgrn_w_out = (const float*)d_in[7]; p.nsa_w_in = (const float*)d_in[8];
    p.pe_k = (const float*)d_in[9]; p.pe_v = (const float*)d_in[10]; p.pk_w1 = (const float*)d_in[11]; p.pk_b1 = (const float*)d_in[12]; p.pk_w2 = (const float*)d_in[13];
    p.pv_w1 = (const float*)d_in[14]; p.pv_b1 = (const float*)d_in[15]; p.pv_w2 = (const float*)d_in[16]; p.nsa_w_out = (const float*)d_in[17];
    p.out = (float*)d_out; p.ws = (unsigned char*)d_ws;
#if MK_MULTI
    for (int k = 0; k < NPHASE; ++k) { p.ph_lo = k; p.ph_hi = k + 1; hipLaunchKernelGGL(mk_fwd, dim3(grid), dim3(512), LDS_BYTES, stream, p); }
#else
    p.ph_lo = 0; p.ph_hi = NPHASE;
    if (hipMemsetAsync((unsigned char*)d_ws + WS_BAR, 0, BAR_BYTES, stream) != hipSuccess) { fprintf(stderr, "kernel_launch: memset of the barrier words failed\n"); return; }
    void* args[] = {&p};
    hipError_t e = hipLaunchCooperativeKernel((const void*)mk_fwd, dim3(grid), dim3(512), args, LDS_BYTES, stream);
    if (e != hipSuccess) fprintf(stderr, "kernel_launch: cooperative launch failed: %s (grid %d)\n", hipGetErrorString(e), grid);
#endif
}
```

```cpp
#include <hip/hip_runtime.h>
#include <hip/hip_cooperative_groups.h>
#include <cstdio>
#include <cstdint>
namespace cg = cooperative_groups;

#ifndef MK_SKEL
#define MK_SKEL 0
#endif
#ifndef HGRN_NAIVE
#define HGRN_NAIVE 0
#endif
#ifndef NSA_NAIVE
#define NSA_NAIVE 0
#endif
#ifndef NSA_DIFF
#define NSA_DIFF 0
#endif
#define NSA_AMP 64.f
#ifndef PROBE_REP
#define PROBE_REP -1
#endif
#ifndef MK_MULTI
constexpr bool LOGF_L2 = true;
#define MK_MULTI 0
#endif

#define LAS __attribute__((address_space(3)))
typedef unsigned short bf16_t;
typedef short bf16x8 __attribute__((ext_vector_type(8)));
typedef float f32x4 __attribute__((ext_vector_type(4)));
typedef float f32x2 __attribute__((ext_vector_type(2)));
typedef unsigned u32x4 __attribute__((ext_vector_type(4)));
typedef unsigned u32x2 __attribute__((ext_vector_type(2)));
typedef _Float16 f16x8 __attribute__((ext_vector_type(8)));
typedef _Float16 f16x4 __attribute__((ext_vector_type(4)));

constexpr int NB = 4, SEQ = 4096, T = NB * SEQ, DM = 2048;
constexpr int NH = 16, HD = 128, NG = 4;
constexpr int N0IN = 8192;
constexpr int N1IN = 7216, N1PAD = 7424;
constexpr int NCMP = 255, NCMPP = 256;
constexpr float RMS_EPS = 1e-6f;
constexpr float QSCALE = 0.08838834764831845f;

constexpr size_t MiB = 1u << 20;
constexpr size_t WS_A = 0;
constexpr size_t WS_B = 64 * MiB;
constexpr size_t WS_D = 192 * MiB;
constexpr size_t WS_E = 256 * MiB;
constexpr size_t WS_G = 352 * MiB;
constexpr size_t WS_SSQ = 160 * MiB;
constexpr size_t WS_W0IN = 416 * MiB;
constexpr size_t WS_W0OUT = 448 * MiB;
constexpr size_t WS_W1IN = 456 * MiB;
constexpr size_t WS_W1OUT = 486 * MiB;
constexpr size_t WS_GATES = 128 * MiB;
constexpr size_t WS_KCMP = 497 * MiB;
constexpr size_t WS_VCMP = 498 * MiB;
constexpr size_t WS_MISC = 499 * MiB;
constexpr size_t WS_W1K = 500 * MiB;
constexpr size_t WS_W1V = 501 * MiB;
constexpr size_t WS_W2K = 502 * MiB;
constexpr size_t WS_W2V = 502 * MiB + 65536;
constexpr size_t WS_BAR = 503 * MiB;
constexpr size_t BAR_BYTES = 16384;
constexpr size_t WS_END = 504 * MiB;
constexpr size_t MISC_LB = 0, MISC_BIASP = 8192, MISC_CVP = 16384;

constexpr int LDS_BYTES = 160 * 1024;

struct Params {
    const float* x; const float* norm_gains; const float* final_gain; const float* rel_bias; const float* hgrn_lb;
    const float* hgrn_w_in; const float* hgrn_head_gain; const float* hgrn_w_out; const float* nsa_w_in;
    const float* pe_k; const float* pe_v; const float* pk_w1; const float* pk_b1; const float* pk_w2;
    const float* pv_w1; const float* pv_b1; const float* pv_w2; const float* nsa_w_out;
    float* out; unsigned char* ws;
    int ph_lo, ph_hi;
};

__device__ __forceinline__ float bf2f(bf16_t b) { return __uint_as_float(((unsigned)b) << 16); }
__device__ __forceinline__ unsigned f2bf(float f) { unsigned u = __float_as_uint(f); return (u + 0x7fffu + ((u >> 16) & 1u)) >> 16; }
__device__ __forceinline__ unsigned pk2(float lo, float hi) { return f2bf(lo) | (f2bf(hi) << 16); }
__device__ __forceinline__ float wave_sum(float v) {
#pragma unroll
    for (int o = 1; o < 64; o <<= 1) v += __shfl_xor(v, o);
    return v;
}
__device__ __forceinline__ float wave_max(float v) {
#pragma unroll
    for (int o = 1; o < 64; o <<= 1) v = fmaxf(v, __shfl_xor(v, o));
    return v;
}
__device__ __forceinline__ float sigmoidf_(float x) { return __builtin_amdgcn_rcpf(1.f + __expf(-x)); }
__device__ __forceinline__ float gate_of(const float* g) { return sigmoidf_((g[0] + g[(size_t)T * 48]) + (g[(size_t)2 * T * 48] + g[(size_t)3 * T * 48])); }
#define LDS_WAIT() asm volatile("s_waitcnt lgkmcnt(0)" ::: "memory")
#define LDS_BARRIER() do { asm volatile("s_waitcnt lgkmcnt(0)" ::: "memory"); __builtin_amdgcn_s_barrier(); asm volatile("" ::: "memory"); } while (0)

template <int CTRL> __device__ __forceinline__ float quad_x(float v) { return __uint_as_float((unsigned)__builtin_amdgcn_update_dpp(0, (int)__float_as_uint(v), CTRL, 0xF, 0xF, true)); }
__device__ __forceinline__ float lane_x16(float v, int sel) { auto r = __builtin_amdgcn_permlane16_swap(__float_as_uint(v), __float_as_uint(v), false, false); return __uint_as_float((sel & 1) ? r[0] : r[1]); }
__device__ __forceinline__ float lane_x32(float v, int sel) { auto r = __builtin_amdgcn_permlane32_swap(__float_as_uint(v), __float_as_uint(v), false, false); return __uint_as_float((sel & 2) ? r[0] : r[1]); }
namespace pg8 {
#define PG8_LAS __attribute__((address_space(3)))
constexpr int BM = 256, BK = 64, HALF = 128, HTB = HALF * BK * 2, STAGE_BYTES = 8 * HTB, NXCD = 8, WGM = 8;
__host__ __device__ __forceinline__ int lds_byte(int r, int c) { const int st = (r >> 4) * 2 + (c >> 5), rr = r & 15, cc = c & 31, ob = rr * 64 + cc * 2; return st * 1024 + (ob ^ (((ob >> 9) & 1) << 5)); }
__host__ __device__ __forceinline__ void stage_rc(int b, int& R, int& C) { const int st = b / 1024, sb = b % 1024, swz = sb ^ (((sb >> 9) & 1) << 5); R = (st >> 1) * 16 + swz / 64; C = (st & 1) * 32 + (swz % 64) / 2; }
__host__ __device__ __forceinline__ int perm32(int rho) { const int n = rho >> 4, i = rho & 15; return 8 * (i >> 2) + 4 * n + (i & 3); }
struct Unit { int pm, pn, ks; };
struct Gemm { const bf16_t* A; const bf16_t* Bt; int M, N, K; };
struct StaticOrder {
    int nM, nN, nwg, G, c;
    __host__ __device__ void init(int M, int N, int G_, int c_) { nM = M / BM; nN = N / BM; nwg = nM * nN; G = G_; c = c_; }
    __host__ __device__ bool next(int i, Unit& u) const {
        const long L = (long)i * G + c; if (L >= nwg) return false;
        int wgid = (int)L; { const int q = nwg / NXCD, r = nwg % NXCD, xcd = wgid % NXCD, off = wgid / NXCD; wgid = (xcd < r ? xcd * (q + 1) : r * (q + 1) + (xcd - r) * q) + off; }
        const int nig = WGM * nN, gid = wgid / nig, fm = gid * WGM, gsz = (nM - fm) < WGM ? (nM - fm) : WGM;
        u.pm = fm + ((wgid % nig) % gsz); u.pn = (wgid % nig) / gsz; u.ks = 0; return true;
    }
    __device__ __forceinline__ int nt(const Unit&, int ntf) const { return ntf; }
    __device__ __forceinline__ size_t kbytes(const Unit&, int) const { return 0; }
    __device__ __forceinline__ void a_ready(const Unit&) const {}
    __device__ __forceinline__ void done(const Unit&) const {}
};
struct SplitTailOrder {
    StaticOrder so;
    __host__ __device__ void init(int M, int Nfull, int G_, int c_) { so.init(M, Nfull, G_, c_); }
    __host__ __device__ bool next(int i, Unit& u) const {
        const long L = (long)i * so.G + so.c;
        if (L < so.nwg) return so.next(i, u);
        const int idx = (int)(L - so.nwg); if (idx >= so.nM * 4) return false;
        u.pm = idx >> 2; u.pn = so.nN; u.ks = idx & 3; return true;
    }
    __device__ __forceinline__ int nt(const Unit& u, int ntf) const { return u.pn == so.nN ? (ntf >> 2) : ntf; }
    __device__ __forceinline__ size_t kbytes(const Unit& u, int K) const { return u.pn == so.nN ? (size_t)u.ks * (size_t)(K >> 2) * 2 : 0; }
    __device__ __forceinline__ void a_ready(const Unit&) const {}
    __device__ __forceinline__ void done(const Unit&) const {}
};
__device__ __forceinline__ unsigned cvt_pk_bf16(float lo, float hi) { unsigned r; asm volatile("v_cvt_pk_bf16_f32 %0, %1, %2" : "=v"(r) : "v"(lo), "v"(hi)); return r; }


struct EpiHgrnIn {
    static constexpr bool PERM = true, AFTER_DRAIN = false, INIT = false, ROWSCALE = false;
    unsigned char* ws; float* LOGF; const float* lb;
    __device__ __forceinline__ void operator()(const f32x4 (&acc)[2][2][4][2], const Unit& u, int wr, int wc, int fr, int fq) const {
        const int row0 = u.pm * BM + wr * 64 + fr, sect = u.pn >> 3, col0 = (u.pn & 7) * BM + wc * 32 + 8 * fq;
        if (sect == 1) {
            f32x4 lbv[2][2];
#pragma unroll
            for (int bj = 0; bj < 2; ++bj)
#pragma unroll
                for (int n = 0; n < 2; ++n) lbv[bj][n] = *(const f32x4*)(lb + col0 + bj * HALF + 4 * n);
#pragma unroll
            for (int ai = 0; ai < 2; ++ai)
#pragma unroll
                for (int m = 0; m < 4; ++m) { _Float16* rowp = (_Float16*)LOGF + (size_t)(row0 + ai * HALF + m * 16) * DM + col0;
#pragma unroll
                    for (int bj = 0; bj < 2; ++bj) { f16x8 o;
#pragma unroll
                        for (int n = 0; n < 2; ++n) { const f32x4 x = acc[ai][bj][m][n], l = lbv[bj][n];
#pragma unroll
                            for (int e = 0; e < 4; ++e) { const float sg = sigmoidf_(x[e]); o[4 * n + e] = (_Float16)(LOGF_L2 ? __log2f(l[e] + (1.f - l[e]) * sg) : __logf(l[e] + (1.f - l[e]) * sg)); } }
                        *(f16x8*)(rowp + bj * HALF) = o; } }
        } else {
            const size_t boff = sect == 0 ? WS_B : (sect == 2 ? WS_B + 64 * MiB : WS_D);
            bf16_t* base = (bf16_t*)(ws + boff);
#pragma unroll
            for (int ai = 0; ai < 2; ++ai)
#pragma unroll
                for (int m = 0; m < 4; ++m) { bf16_t* rowp = base + (size_t)(row0 + ai * HALF + m * 16) * DM + col0;
#pragma unroll
                    for (int bj = 0; bj < 2; ++bj) { f32x4 v0 = acc[ai][bj][m][0], v1 = acc[ai][bj][m][1];
                        if (sect == 0) { v0 = v0 * QSCALE; v1 = v1 * QSCALE; }
                        u32x4 w; w.x = cvt_pk_bf16(v0[0], v0[1]); w.y = cvt_pk_bf16(v0[2], v0[3]); w.z = cvt_pk_bf16(v1[0], v1[1]); w.w = cvt_pk_bf16(v1[2], v1[3]);
                        *(u32x4*)(rowp + bj * HALF) = w; } }
        }
    }
};
template <bool RF32>
struct EpiResidT {
    static constexpr bool PERM = true, AFTER_DRAIN = false, INIT = false, ROWSCALE = false;
    const void* R; bf16_t* O;
    __device__ __forceinline__ void operator()(const f32x4 (&acc)[2][2][4][2], const Unit& u, int wr, int wc, int fr, int fq) const {
        const int row0 = u.pm * BM + wr * 64 + fr, col0 = u.pn * BM + wc * 32 + 8 * fq;
#pragma unroll
        for (int ai = 0; ai < 2; ++ai) { f32x4 rv[4][2][RF32 ? 2 : 1];
#pragma unroll
            for (int m = 0; m < 4; ++m) { const size_t off = (size_t)(row0 + ai * HALF + m * 16) * DM + col0;
#pragma unroll
                for (int bj = 0; bj < 2; ++bj) {
                    if constexpr (RF32) { rv[m][bj][0] = *(const f32x4*)((const float*)R + off + bj * HALF); rv[m][bj][1] = *(const f32x4*)((const float*)R + off + bj * HALF + 4); }
                    else rv[m][bj][0] = *(const f32x4*)((const bf16_t*)R + off + bj * HALF); } }
            __builtin_amdgcn_sched_barrier(0);
#pragma unroll
            for (int m = 0; m < 4; ++m) { const size_t off = (size_t)(row0 + ai * HALF + m * 16) * DM + col0;
#pragma unroll
                for (int bj = 0; bj < 2; ++bj) { f32x4 r0, r1;
                    if constexpr (RF32) { r0 = rv[m][bj][0]; r1 = rv[m][bj][1]; }
                    else { const f32x4 q = rv[m][bj][0]; const unsigned a = __float_as_uint(q.x), b = __float_as_uint(q.y), c = __float_as_uint(q.z), d = __float_as_uint(q.w);
                        r0 = (f32x4){__uint_as_float(a << 16), __uint_as_float(a & 0xffff0000u), __uint_as_float(b << 16), __uint_as_float(b & 0xffff0000u)};
                        r1 = (f32x4){__uint_as_float(c << 16), __uint_as_float(c & 0xffff0000u), __uint_as_float(d << 16), __uint_as_float(d & 0xffff0000u)}; }
                    const f32x4 v0 = r0 + acc[ai][bj][m][0], v1 = r1 + acc[ai][bj][m][1];
                    u32x4 w; w.x = cvt_pk_bf16(v0[0], v0[1]); w.y = cvt_pk_bf16(v0[2], v0[3]); w.z = cvt_pk_bf16(v1[0], v1[1]); w.w = cvt_pk_bf16(v1[2], v1[3]);
                    *(u32x4*)(O + off + bj * HALF) = w; } }
            __builtin_amdgcn_sched_barrier(0); }
    }
};
template <bool RF32, bool SSQ = false>
struct EpiResidInit {
    static constexpr bool PERM = true, AFTER_DRAIN = false, INIT = true, ROWSCALE = false;
    const void* R; bf16_t* O; float* SS = nullptr;
    __device__ __forceinline__ void init(f32x4 (&acc)[2][2][4][2], const Unit& u, int wr, int wc, int fr, int fq) const {
        const int row0 = u.pm * BM + wr * 64 + fr, col0 = u.pn * BM + wc * 32 + 8 * fq;
#pragma unroll
        for (int ai = 0; ai < 2; ++ai)
#pragma unroll
            for (int m = 0; m < 4; ++m) { const size_t off = (size_t)(row0 + ai * HALF + m * 16) * DM + col0;
#pragma unroll
                for (int bj = 0; bj < 2; ++bj) {
                    if constexpr (RF32) { acc[ai][bj][m][0] = *(const f32x4*)((const float*)R + off + bj * HALF); acc[ai][bj][m][1] = *(const f32x4*)((const float*)R + off + bj * HALF + 4); }
                    else { const f32x4 q = *(const f32x4*)((const bf16_t*)R + off + bj * HALF); const unsigned a = __float_as_uint(q.x), b = __float_as_uint(q.y), c = __float_as_uint(q.z), d = __float_as_uint(q.w);
                        acc[ai][bj][m][0] = (f32x4){__uint_as_float(a << 16), __uint_as_float(a & 0xffff0000u), __uint_as_float(b << 16), __uint_as_float(b & 0xffff0000u)};
                        acc[ai][bj][m][1] = (f32x4){__uint_as_float(c << 16), __uint_as_float(c & 0xffff0000u), __uint_as_float(d << 16), __uint_as_float(d & 0xffff0000u)}; } } }
    }
    __device__ __forceinline__ void operator()(const f32x4 (&acc)[2][2][4][2], const Unit& u, int wr, int wc, int fr, int fq) const {
        const int row0 = u.pm * BM + wr * 64 + fr, col0 = u.pn * BM + wc * 32 + 8 * fq;
#pragma unroll
        for (int ai = 0; ai < 2; ++ai)
#pragma unroll
            for (int m = 0; m < 4; ++m) { const size_t off = (size_t)(row0 + ai * HALF + m * 16) * DM + col0; float ss = 0.f;
#pragma unroll
                for (int bj = 0; bj < 2; ++bj) { const f32x4 v0 = acc[ai][bj][m][0], v1 = acc[ai][bj][m][1];
                    if constexpr (SSQ) ss += ((v0[0] * v0[0] + v0[1] * v0[1]) + (v0[2] * v0[2] + v0[3] * v0[3])) + ((v1[0] * v1[0] + v1[1] * v1[1]) + (v1[2] * v1[2] + v1[3] * v1[3]));
                    u32x4 w; w.x = cvt_pk_bf16(v0[0], v0[1]); w.y = cvt_pk_bf16(v0[2], v0[3]); w.z = cvt_pk_bf16(v1[0], v1[1]); w.w = cvt_pk_bf16(v1[2], v1[3]);
                    *(u32x4*)(O + off + bj * HALF) = w; }
                if constexpr (SSQ) { ss += lane_x16(ss, fq); ss += lane_x32(ss, fq);
                    if (fq == 0) SS[(size_t)(row0 + ai * HALF + m * 16) * 32 + u.pn * 4 + wc] = ss; } }
    }
};
struct EpiNsaIn {
    static constexpr bool PERM = true, AFTER_DRAIN = false, INIT = false, ROWSCALE = true;
    unsigned char* ws; float* GT; PG8_LAS unsigned char* ldsb; const float* SS;
    static constexpr int RS_OFF = STAGE_BYTES;
    __device__ __forceinline__ void load_rowscale(int pm, int tid) const {
        asm volatile("s_waitcnt lgkmcnt(0)" ::: "memory"); __builtin_amdgcn_s_barrier();
        if (tid < BM) { const f32x4* pp = (const f32x4*)(SS + (size_t)(pm * BM + tid) * 32); f32x4 a = pp[0];
#pragma unroll
            for (int i = 1; i < 8; ++i) a += pp[i];
            ((PG8_LAS float*)(ldsb + RS_OFF))[tid] = rsqrtf(((a.x + a.y) + (a.z + a.w)) * (1.f / DM) + RMS_EPS); }
        asm volatile("s_waitcnt lgkmcnt(0)" ::: "memory"); __builtin_amdgcn_s_barrier();
    }
    __device__ __forceinline__ void operator()(const f32x4 (&acc)[2][2][4][2], const Unit& u, int wr, int wc, int fr, int fq) const {
        const int row0 = u.pm * BM + wr * 64 + fr, pn = u.pn, cl = wc * 32 + 8 * fq;
        if (pn == 28) {
#pragma unroll
            for (int ai = 0; ai < 2; ++ai)
#pragma unroll
                for (int m = 0; m < 4; ++m) { float* rowp = GT + ((size_t)u.ks * T + (size_t)(row0 + ai * HALF + m * 16)) * 48;
                    const float r_ = ((const PG8_LAS float*)(ldsb + RS_OFF))[wr * 64 + fr + ai * HALF + m * 16];
                    if (cl < 48) {
#pragma unroll
                        for (int n = 0; n < 2; ++n) *(f32x4*)(rowp + cl + 4 * n) = acc[ai][0][m][n] * r_; } }
            return;
        }
        size_t boff; int ld, colb; int mode = 0;
        if (pn < 8) { boff = WS_D; ld = DM; colb = pn * BM; mode = 1; }
        else if (pn < 20) { const int idx = pn - 8; boff = WS_E + (size_t)(idx >> 1) * ((size_t)T * 512 * 2); ld = 512; colb = (idx & 1) * BM; }
        else { boff = WS_G; ld = DM; colb = (pn - 20) * BM; mode = 2; }
        bf16_t* base = (bf16_t*)(ws + boff);
#pragma unroll
        for (int ai = 0; ai < 2; ++ai)
#pragma unroll
            for (int m = 0; m < 4; ++m) { bf16_t* rowp = base + (size_t)(row0 + ai * HALF + m * 16) * ld + colb + cl;
                const float r0_ = ((const PG8_LAS float*)(ldsb + RS_OFF))[wr * 64 + fr + ai * HALF + m * 16], r_ = mode == 1 ? r0_ * QSCALE : r0_;
#pragma unroll
                for (int bj = 0; bj < 2; ++bj) { f32x4 v0 = acc[ai][bj][m][0] * r_, v1 = acc[ai][bj][m][1] * r_;
                    if (mode == 2) {
#pragma unroll
                        for (int e = 0; e < 4; ++e) { v0[e] = v0[e] * sigmoidf_(v0[e]); v1[e] = v1[e] * sigmoidf_(v1[e]); } }
                    u32x4 w; w.x = cvt_pk_bf16(v0[0], v0[1]); w.y = cvt_pk_bf16(v0[2], v0[3]); w.z = cvt_pk_bf16(v1[0], v1[1]); w.w = cvt_pk_bf16(v1[2], v1[3]);
                    *(u32x4*)(rowp + bj * HALF) = w; } }
    }
};

template <class Epi, class Sched, bool ALIGN_EPI = false, bool SP2 = false>
__device__ __forceinline__ void gemm_phase(PG8_LAS unsigned char* lds, const Gemm g, const Sched& S, const Epi& E, const int tidv) {
    const int tid = tidv, wid = __builtin_amdgcn_readfirstlane(tid >> 6), lane = tid & 63, wr = wid >> 2, wc = wid & 3, fr = lane & 15, fq = lane >> 4;
    const int K = g.K, nt = K / BK;
    unsigned voffA[2], voffB[2];
#pragma unroll
    for (int i = 0; i < 2; ++i) { int R, C; stage_rc(tid * 16 + i * 8192, R, C); const int Rb = Epi::PERM ? ((R & ~31) + perm32(R & 31)) : R;
        voffA[i] = (unsigned)(R * K + C) * 2u; voffB[i] = (unsigned)(Rb * K + C) * 2u; }
    const size_t kstep = (size_t)(BK * 2);
    const size_t hstep = (size_t)HALF * K * 2;
    const size_t tstep = 2 * hstep;
    const unsigned ldsw = (unsigned)wid * 1024u;
    const int aoff = lds_byte(wr * 64 + fr, fq * 8), boff = lds_byte(wc * 32 + fr, fq * 8);
#define PG8_SA(b, h) (((b) * 2 + (h)) * HTB)
#define PG8_SB(b, h) ((4 + (b) * 2 + (h)) * HTB)
#define PG8_STAGE(bufoff, gbase, voff) do { _Pragma("unroll") for (int _i = 0; _i < 2; ++_i) \
        __builtin_amdgcn_global_load_lds((const unsigned*)((const char*)(gbase) + (voff)[_i]), (PG8_LAS unsigned*)(lds + (bufoff) + ldsw + _i * 8192), 16, 0, 0); } while (0)
#define PG8_LDA(dst, b, h) do { _Pragma("unroll") for (int m = 0; m < 4; ++m) _Pragma("unroll") for (int k = 0; k < 2; ++k) dst[m][k] = *(const PG8_LAS bf16x8*)(lds + PG8_SA(b, h) + aoff + m * 2048 + k * 1024); } while (0)
#define PG8_LDB(dst, b, h) do { _Pragma("unroll") for (int n = 0; n < 2; ++n) _Pragma("unroll") for (int k = 0; k < 2; ++k) dst[n][k] = *(const PG8_LAS bf16x8*)(lds + PG8_SB(b, h) + boff + n * 2048 + k * 1024); } while (0)
#define PG8_MMA(ai, bj, At, Bt) do { __builtin_amdgcn_s_setprio(1); _Pragma("unroll") for (int m = 0; m < 4; ++m) _Pragma("unroll") for (int n = 0; n < 2; ++n) _Pragma("unroll") for (int k = 0; k < 2; ++k) \
        acc[ai][bj][m][n] = __builtin_amdgcn_mfma_f32_16x16x32_bf16(Bt[n][k], At[m][k], acc[ai][bj][m][n], 0, 0, 0); __builtin_amdgcn_s_setprio(0); } while (0)
#define PG8_WAIT_V(n) asm volatile("s_waitcnt vmcnt(" #n ")" ::: "memory")
#define PG8_WAIT_L(n) asm volatile("s_waitcnt lgkmcnt(" #n ")" ::: "memory")
#define PG8_BAR __builtin_amdgcn_s_barrier()
#define PG8_SCHED __builtin_amdgcn_sched_barrier(0)
    Unit cur, nxt; int ui = 0;
    if (!S.next(0, cur)) return;
    f32x4 acc[2][2][4][2];
    if constexpr (Epi::ROWSCALE) E.load_rowscale(cur.pm, tid);
    if constexpr (Epi::INIT) E.init(acc, cur, wr, wc, fr, fq);
    else {
#pragma unroll
    for (int a = 0; a < 2; ++a)
#pragma unroll
        for (int b = 0; b < 2; ++b)
#pragma unroll
            for (int m = 0; m < 4; ++m)
#pragma unroll
                for (int n = 0; n < 2; ++n) acc[a][b][m][n] = (f32x4){0.f, 0.f, 0.f, 0.f};
    }
    bf16x8 At[4][2], B0[2][2], B1[2][2];
    const char* cA = (const char*)g.A + (size_t)cur.pm * tstep + S.kbytes(cur, K); const char* cB = (const char*)g.Bt + (size_t)cur.pn * tstep + S.kbytes(cur, K);
    S.a_ready(cur);
    if constexpr (SP2) {
        PG8_STAGE(PG8_SB(0, 0), cB, voffB); PG8_STAGE(PG8_SB(0, 1), cB + hstep, voffB); PG8_STAGE(PG8_SA(0, 0), cA, voffA); PG8_STAGE(PG8_SA(0, 1), cA + hstep, voffA);
        if (wr == 1) PG8_BAR;
        PG8_WAIT_V(2); PG8_BAR;
        PG8_STAGE(PG8_SB(1, 0), cB + kstep, voffB); PG8_STAGE(PG8_SA(1, 0), cA + kstep, voffA); PG8_STAGE(PG8_SB(1, 1), cB + hstep + kstep, voffB);
        PG8_WAIT_V(6); PG8_BAR;
    } else {
        PG8_STAGE(PG8_SB(0, 0), cB, voffB); PG8_STAGE(PG8_SA(0, 0), cA, voffA); PG8_STAGE(PG8_SB(0, 1), cB + hstep, voffB); PG8_STAGE(PG8_SA(0, 1), cA + hstep, voffA);
        if (wr == 1) PG8_BAR;
        PG8_WAIT_V(4); PG8_BAR;
        PG8_STAGE(PG8_SB(1, 0), cB + kstep, voffB); PG8_STAGE(PG8_SA(1, 0), cA + kstep, voffA); PG8_STAGE(PG8_SB(1, 1), cB + hstep + kstep, voffB);
        PG8_WAIT_V(6); PG8_BAR;
    }
    for (;;) {
        const bool has_next = S.next(ui + 1, nxt);
        const char* nA = has_next ? (const char*)g.A + (size_t)nxt.pm * tstep + S.kbytes(nxt, K) : cA; const char* nB = has_next ? (const char*)g.Bt + (size_t)nxt.pn * tstep + S.kbytes(nxt, K) : cB;
        const int ntc = S.nt(cur, nt);
        for (int t = 0; t < ntc; t += 2) {
            const bool last = (t == ntc - 2);
            const char* a1 = cA + (size_t)(t + 1) * kstep;
            const char* a2 = last ? nA : cA + (size_t)(t + 2) * kstep; const char* b2 = last ? nB : cB + (size_t)(t + 2) * kstep;
            const char* a3 = a2 + kstep; const char* b3 = b2 + kstep;
            if (last && has_next) S.a_ready(nxt);
            if constexpr (SP2) {
            PG8_LDB(B0, 0, 0); PG8_LDB(B1, 0, 1); PG8_SCHED; PG8_LDA(At, 0, 0); PG8_STAGE(PG8_SA(1, 1), a1 + hstep, voffA);
            PG8_WAIT_V(8); PG8_WAIT_L(0); PG8_BAR; PG8_MMA(0, 0, At, B0); PG8_MMA(0, 1, At, B1); PG8_BAR; PG8_SCHED;
            PG8_LDA(At, 0, 1); PG8_STAGE(PG8_SB(0, 0), b2, voffB); PG8_STAGE(PG8_SB(0, 1), b2 + hstep, voffB); PG8_STAGE(PG8_SA(0, 0), a2, voffA);
            PG8_WAIT_V(8); PG8_WAIT_L(0); PG8_BAR; PG8_MMA(1, 0, At, B0); PG8_MMA(1, 1, At, B1); PG8_BAR; PG8_SCHED;
            PG8_LDB(B0, 1, 0); PG8_LDB(B1, 1, 1); PG8_SCHED; PG8_LDA(At, 1, 0); PG8_STAGE(PG8_SA(0, 1), a2 + hstep, voffA);
            PG8_WAIT_V(8); PG8_WAIT_L(0); PG8_BAR; PG8_MMA(0, 0, At, B0); PG8_MMA(0, 1, At, B1); PG8_BAR; PG8_SCHED;
            PG8_LDA(At, 1, 1); PG8_STAGE(PG8_SB(1, 0), b3, voffB); PG8_STAGE(PG8_SB(1, 1), b3 + hstep, voffB); PG8_STAGE(PG8_SA(1, 0), a3, voffA);
            PG8_WAIT_V(8); PG8_WAIT_L(0); PG8_BAR; PG8_MMA(1, 0, At, B0); PG8_MMA(1, 1, At, B1); PG8_BAR; PG8_SCHED;
            } else {
            PG8_LDB(B0, 0, 0); PG8_SCHED; PG8_LDA(At, 0, 0); PG8_STAGE(PG8_SA(1, 1), a1 + hstep, voffA);
            PG8_WAIT_L(8); PG8_BAR; PG8_WAIT_L(0); PG8_MMA(0, 0, At, B0); PG8_BAR; PG8_SCHED;
            PG8_LDB(B1, 0, 1); PG8_STAGE(PG8_SB(0, 0), b2, voffB);
            PG8_BAR; PG8_WAIT_L(0); PG8_MMA(0, 1, At, B1); PG8_BAR;
            PG8_LDA(At, 0, 1); PG8_STAGE(PG8_SA(0, 0), a2, voffA);
            PG8_BAR; PG8_WAIT_L(0); PG8_MMA(1, 0, At, B0); PG8_BAR; PG8_SCHED;
            PG8_STAGE(PG8_SB(0, 1), b2 + hstep, voffB);
            PG8_WAIT_V(6); PG8_BAR; PG8_MMA(1, 1, At, B1); PG8_BAR;
            PG8_LDB(B0, 1, 0); PG8_SCHED; PG8_LDA(At, 1, 0); PG8_STAGE(PG8_SA(0, 1), a2 + hstep, voffA);
            PG8_WAIT_L(8); PG8_BAR; PG8_WAIT_L(0); PG8_MMA(0, 0, At, B0); PG8_BAR; PG8_SCHED;
            PG8_LDB(B1, 1, 1); PG8_STAGE(PG8_SB(1, 0), b3, voffB);
            PG8_BAR; PG8_WAIT_L(0); PG8_MMA(0, 1, At, B1); PG8_BAR;
            PG8_LDA(At, 1, 1); PG8_STAGE(PG8_SA(1, 0), a3, voffA);
            PG8_BAR; PG8_WAIT_L(0); PG8_MMA(1, 0, At, B0); PG8_BAR; PG8_SCHED;
            PG8_STAGE(PG8_SB(1, 1), b3 + hstep, voffB);
            PG8_WAIT_V(6); PG8_BAR; PG8_MMA(1, 1, At, B1); PG8_BAR;
            }
        }
        if constexpr (ALIGN_EPI) { if (wr == 0) PG8_BAR; }
        if constexpr (!Epi::AFTER_DRAIN) { E(acc, cur, wr, wc, fr, fq); S.done(cur); }
        if (!has_next) break;
        if constexpr (Epi::ROWSCALE) { if (nxt.pm != cur.pm) E.load_rowscale(nxt.pm, tid); }
        if constexpr (Epi::INIT) E.init(acc, nxt, wr, wc, fr, fq);
        else {
#pragma unroll
        for (int a = 0; a < 2; ++a)
#pragma unroll
            for (int b = 0; b < 2; ++b)
#pragma unroll
                for (int m = 0; m < 4; ++m)
#pragma unroll
                    for (int n = 0; n < 2; ++n) acc[a][b][m][n] = (f32x4){0.f, 0.f, 0.f, 0.f};
        }
        cur = nxt; cA = nA; cB = nB; ++ui;
        if constexpr (ALIGN_EPI) { if (wr == 1) PG8_BAR; }
    }
    PG8_WAIT_V(0);
    if constexpr (!ALIGN_EPI) { if (wr == 0) PG8_BAR; }
    PG8_BAR;
#undef PG8_SA
#undef PG8_SB
#undef PG8_STAGE
#undef PG8_LDA
#undef PG8_LDB
#undef PG8_MMA
#undef PG8_WAIT_V
#undef PG8_WAIT_L
#undef PG8_BAR
#undef PG8_SCHED
}
}

__device__ __forceinline__ int t5_bucket(int n) {
    if (n < 16) return n;
    const int large = 16 + (int)(logf((float)n / 16.f) / 2.0794415416798357f * 16.f);
    return large < 31 ? large : 31;
}
template <class ColMap>
__device__ __forceinline__ void transpose_item(const float* W, int Nsrc, int K, bf16_t* WT, LAS float* scr, int kb, int nb, int lane, ColMap cm, const float* kgain = nullptr, int kmask = -1) {
    const int k0 = 64 * kb, n0 = 32 * nb;
    const int kq = lane >> 3, n4 = 4 * (lane & 7);
    const int nsrc = cm(n0 + n4);
    f32x4 wv[8];
#pragma unroll
    for (int i = 0; i < 8; ++i) wv[i] = nsrc >= 0 ? *(const f32x4*)(W + (size_t)(k0 + 8 * i + kq) * Nsrc + nsrc) : (f32x4){0.f, 0.f, 0.f, 0.f};
    if (kgain != nullptr) {
#pragma unroll
        for (int i = 0; i < 8; ++i) wv[i] = wv[i] * kgain[(k0 + 8 * i + kq) & kmask]; }
#pragma unroll
    for (int i = 0; i < 8; ++i) { LAS float* d = scr + (8 * i + kq) * 33 + n4; d[0] = wv[i].x; d[1] = wv[i].y; d[2] = wv[i].z; d[3] = wv[i].w; }
    LDS_WAIT(); asm volatile("" ::: "memory");
    const int c = lane & 7;
#pragma unroll
    for (int j = 0; j < 4; ++j) { const int n = (lane >> 3) + 8 * j; const LAS float* s = scr + (8 * c) * 33 + n;
        u32x4 o; o.x = pk2(s[0 * 33], s[1 * 33]); o.y = pk2(s[2 * 33], s[3 * 33]); o.z = pk2(s[4 * 33], s[5 * 33]); o.w = pk2(s[6 * 33], s[7 * 33]);
        *(u32x4*)(WT + (size_t)(n0 + n) * K + k0 + 8 * c) = o; }
    LDS_WAIT(); asm volatile("" ::: "memory");
}
struct CmIdent { __device__ __forceinline__ int operator()(int n) const { return n; } };
struct CmNsaIn { __device__ __forceinline__ int operator()(int n) const { return n < 5120 ? n : (n < 7168 ? n + 48 : (n < N1IN ? n - 2048 : -1)); } };

__device__ __forceinline__ void rms_row_bf16(const float* xrow, const float* gain, bf16_t* orow, int lane) {
    const f32x4* xr = (const f32x4*)xrow + lane; const f32x4* gr = (const f32x4*)gain + lane;
    f32x4 v[8]; float s = 0.f;
#pragma unroll
    for (int j = 0; j < 8; ++j) { v[j] = xr[64 * j]; s += (v[j].x * v[j].x + v[j].y * v[j].y) + (v[j].z * v[j].z + v[j].w * v[j].w); }
    const float r = rsqrtf(wave_sum(s) * (1.f / DM) + RMS_EPS);
    u32x2* o8 = (u32x2*)orow + lane;
#pragma unroll
    for (int j = 0; j < 8; ++j) { const f32x4 g = gr[64 * j]; u32x2 w; w.x = pk2(v[j].x * r * g.x, v[j].y * r * g.y); w.y = pk2(v[j].z * r * g.z, v[j].w * r * g.w); o8[64 * j] = w; }
}
__device__ __forceinline__ void rms_row_f32(const float* xrow, const float* gain, float* orow, int lane) {
    const f32x4* xr = (const f32x4*)xrow + lane; const f32x4* gr = (const f32x4*)gain + lane;
    f32x4 v[8]; float s = 0.f;
#pragma unroll
    for (int j = 0; j < 8; ++j) { v[j] = xr[64 * j]; s += (v[j].x * v[j].x + v[j].y * v[j].y) + (v[j].z * v[j].z + v[j].w * v[j].w); }
    const float r = rsqrtf(wave_sum(s) * (1.f / DM) + RMS_EPS);
    f32x4* o = (f32x4*)orow + lane;
#pragma unroll
    for (int j = 0; j < 8; ++j) { const f32x4 g = gr[64 * j]; o[64 * j] = v[j] * r * g; }
}

__device__ __forceinline__ void p0_prep(const Params& p, unsigned char* lds_g) {
    const int tid = threadIdx.x, lane = tid & 63, wave = tid >> 6, G = gridDim.x, bx = blockIdx.x;
    const int gw = bx * 8 + wave, NGW = G * 8;
    float* misc = (float*)(p.ws + WS_MISC);
    if (bx == 0) {
        for (int c = tid; c < DM; c += 512) { const float a = p.hgrn_lb[c], b = p.hgrn_lb[DM + c], d = p.hgrn_lb[2 * DM + c]; const float m = fmaxf(a, fmaxf(b, d));
            const float ea = expf(a - m), eb = expf(b - m), ed = expf(d - m); misc[MISC_LB / 4 + c] = ea / (ea + eb + ed); }
    }
    if (bx == 1 % G) {
        for (int e = tid; e < NH * 128; e += 512) { const int head = e >> 7, dist = e & 127; misc[MISC_BIASP / 4 + e] = p.rel_bias[t5_bucket(dist) * NH + head] - p.rel_bias[31 * NH + head]; }
    }
    if (bx >= 2 && bx < 18 && G >= 18) {
        const int which = (bx - 2) >> 3, slice = (bx - 2) & 7;
        const float* pe = which ? p.pe_v : p.pe_k; const float* w1 = which ? p.pv_w1 : p.pk_w1;
        float* red = (float*)lds_g;
        const int n = tid & 127, part = tid >> 7; float s = 0.f;
        const int r0 = slice * 512 + part * 128;
#pragma unroll 16
        for (int r = r0; r < r0 + 128; ++r) s += pe[r] * w1[(size_t)r * 128 + n];
        __syncthreads(); red[part * 128 + n] = s; __syncthreads();
        if (tid < 128) misc[MISC_CVP / 4 + (which * 8 + slice) * 128 + tid] = (red[tid] + red[128 + tid]) + (red[256 + tid] + red[384 + tid]);
        __syncthreads();
    }
    LAS float* scr = (LAS float*)((LAS unsigned char*)lds_g + 4096 + wave * 8704);
    constexpr int I0IN = 32 * (N0IN / 32), IOUT = 32 * (DM / 32), I1IN = 32 * (N1PAD / 32);
    constexpr int IW1 = (4096 / 64) * (128 / 32), IW2 = (128 / 64) * (128 / 32);
    constexpr int NITEMS = I0IN + IOUT + I1IN + IOUT + 2 * IW1 + 2 * IW2;
    for (int it = gw; it < NITEMS; it += NGW) {
        int r = it;
        if (r < I0IN) { transpose_item(p.hgrn_w_in, N0IN, DM, (bf16_t*)(p.ws + WS_W0IN), scr, r / (N0IN / 32), r % (N0IN / 32), lane, CmIdent()); continue; } r -= I0IN;
        if (r < IOUT) { transpose_item(p.hgrn_w_out, DM, DM, (bf16_t*)(p.ws + WS_W0OUT), scr, r / (DM / 32), r % (DM / 32), lane, CmIdent(), p.hgrn_head_gain, HD - 1); continue; } r -= IOUT;
        if (r < I1IN) { transpose_item(p.nsa_w_in, N1IN, DM, (bf16_t*)(p.ws + WS_W1IN), scr, r / (N1PAD / 32), r % (N1PAD / 32), lane, CmNsaIn(), p.norm_gains + DM); continue; } r -= I1IN;
        if (r < IOUT) { transpose_item(p.nsa_w_out, DM, DM, (bf16_t*)(p.ws + WS_W1OUT), scr, r / (DM / 32), r % (DM / 32), lane, CmIdent()); continue; } r -= IOUT;
        if (r < IW1) { transpose_item(p.pk_w1, 128, 4096, (bf16_t*)(p.ws + WS_W1K), scr, r / 4, r % 4, lane, CmIdent()); continue; } r -= IW1;
        if (r < IW1) { transpose_item(p.pv_w1, 128, 4096, (bf16_t*)(p.ws + WS_W1V), scr, r / 4, r % 4, lane, CmIdent()); continue; } r -= IW1;
        if (r < IW2) { transpose_item(p.pk_w2, 128, 128, (bf16_t*)(p.ws + WS_W2K), scr, r / 4, r % 4, lane, CmIdent()); continue; } r -= IW2;
        transpose_item(p.pv_w2, 128, 128, (bf16_t*)(p.ws + WS_W2V), scr, r / 4, r % 4, lane, CmIdent());
    }
}

__device__ __forceinline__ void hgrn_naive(const Params& p, unsigned char* lds_g) {
    const int tid = threadIdx.x;
    const bf16_t* Q0 = (const bf16_t*)(p.ws + WS_B); const bf16_t* V0 = (const bf16_t*)(p.ws + WS_B + 64 * MiB);
    const float* LOGF = p.out; bf16_t* O0 = (bf16_t*)(p.ws + WS_E);
    float* qs = (float*)lds_g; float* fs = qs + 16 * 128; float* part = fs + 16 * 128;
    const int v = tid & 127, kq = tid >> 7;
    for (int unit = blockIdx.x; unit < NB * NH; unit += gridDim.x) {
        const int b = unit / NH, h = unit % NH;
        float S[32];
#pragma unroll
        for (int i = 0; i < 32; ++i) S[i] = 0.f;
        for (int t0 = 0; t0 < SEQ; t0 += 16) {
            __syncthreads();
            for (int e = tid; e < 2048; e += 512) { const int tt = e >> 7, k = e & 127; const size_t idx = (size_t)(b * SEQ + t0 + tt) * DM + h * HD + k;
                qs[e] = bf2f(Q0[idx]); fs[e] = __expf(LOGF[idx]); }
            __syncthreads();
            for (int tt = 0; tt < 16; ++tt) {
                const float vv = bf2f(V0[(size_t)(b * SEQ + t0 + tt) * DM + h * HD + v]);
                float o = 0.f;
#pragma unroll
                for (int kk = 0; kk < 32; ++kk) { const float f = fs[tt * 128 + kq * 32 + kk]; S[kk] = f * S[kk] + (1.f - f) * vv; o += S[kk] * qs[tt * 128 + kq * 32 + kk]; }
                part[(tt * 4 + kq) * 128 + v] = o;
            }
            __syncthreads();
            for (int e = tid; e < 2048; e += 512) { const int tt = e >> 7, vx = e & 127;
                const float o = (part[(tt * 4 + 0) * 128 + vx] + part[(tt * 4 + 1) * 128 + vx]) + (part[(tt * 4 + 2) * 128 + vx] + part[(tt * 4 + 3) * 128 + vx]);
                O0[(size_t)(b * SEQ + t0 + tt) * DM + h * HD + vx] = (bf16_t)f2bf(o); }
        }
    }
}
typedef float f32x16 __attribute__((ext_vector_type(16)));
__device__ __forceinline__ int crow(int r, int hi) { return (r & 3) + 8 * (r >> 2) + 4 * hi; }
namespace hg {
constexpr int RS = 272, RS2 = 144;
constexpr int QS = 0, QD = 17408, KS = 34816, KST = 52224, VT = 70656, PP = 75264, SOP0 = 84480, SOP1 = 93184, SEGT = 101888, VEC = 105984;
}
__device__ __forceinline__ u32x2 pack4bf(float a, float b, float c, float d) { u32x2 w; w.x = pg8::cvt_pk_bf16(a, b); w.y = pg8::cvt_pk_bf16(c, d); return w; }
__device__ __forceinline__ void hgrn_chunk(const Params& p, unsigned char* lds_g) {
    using namespace hg;
    LAS unsigned char* L = (LAS unsigned char*)lds_g;
    const int tid = threadIdx.x, lane = tid & 63, wave = __builtin_amdgcn_readfirstlane(tid >> 6), r32 = lane & 31, hi = lane >> 5;
    const bf16_t* Q0 = (const bf16_t*)(p.ws + WS_B); const bf16_t* V0 = (const bf16_t*)(p.ws + WS_B + 64 * MiB);
    const float* LOGF = p.out; bf16_t* O0 = (bf16_t*)(p.ws + WS_E);
    const int vs = tid >> 3, vv4 = (tid & 7) * 4;
    for (int unit = blockIdx.x; unit < 256; unit += gridDim.x) {
        const int bh = unit & 63, c4 = unit >> 6, b = bh >> 4, h = bh & 15;
        const size_t rowb = (size_t)b * SEQ; const int colb = h * HD;
        f32x16 S;
#pragma unroll
        for (int i = 0; i < 16; ++i) S[i] = 0.f;
        __syncthreads();
        for (int e = tid; e < (SOP1 - SOP0) / 4; e += 512) ((LAS unsigned*)(L + SOP0))[e] = 0u;
        int cur = 0;
        f32x2 lf[8]; unsigned qv[8]; u32x2 vraw;
#pragma unroll
        for (int i = 0; i < 8; ++i) { const size_t idx = (rowb + 8 * wave + i) * DM + colb + 2 * lane; lf[i] = *(const f32x2*)(LOGF + idx); qv[i] = *(const unsigned*)(Q0 + idx); }
        vraw = *(const u32x2*)(V0 + (rowb + vs) * DM + colb + c4 * 32 + vv4);
        for (int c = 0; c < 64; ++c) {
            float c0[8], c1[8]; float s0 = 0.f, s1 = 0.f;
#pragma unroll
            for (int i = 0; i < 8; ++i) { s0 += lf[i].x; c0[i] = s0; s1 += lf[i].y; c1[i] = s1; }
            *(LAS f32x2*)(L + SEGT + (wave * 128 + 2 * lane) * 4) = (f32x2){s0, s1};
            LDS_BARRIER();
            float pre0 = 0.f, pre1 = 0.f, br0 = 0.f, br1 = 0.f, bl0 = 0.f, bl1 = 0.f;
#pragma unroll
            for (int w = 0; w < 8; ++w) { const f32x2 v = *(const LAS f32x2*)(L + SEGT + (w * 128 + 2 * lane) * 4);
                if (w < wave) { pre0 += v.x; pre1 += v.y; } if (w < 4) { br0 += v.x; br1 += v.y; } bl0 += v.x; bl1 += v.y; }
            const float er0 = __expf(br0), er1 = __expf(br1);
            if (wave == 0) { *(LAS f32x2*)(L + VEC + (2 * lane) * 4) = (f32x2){__expf(bl0 - br0), __expf(bl1 - br1)}; *(LAS f32x2*)(L + VEC + 512 + (2 * lane) * 4) = (f32x2){__expf(bl0), __expf(bl1)}; }
            float kt0[8], kt1[8];
#pragma unroll
            for (int i = 0; i < 8; ++i) { const int t = 8 * wave + i;
                const float q0 = __uint_as_float(qv[i] << 16), q1 = __uint_as_float(qv[i] & 0xffff0000u);
                const float d0 = fminf(fmaxf(pre0 + c0[i] - br0, -80.f), 80.f), d1 = fminf(fmaxf(pre1 + c1[i] - br1, -80.f), 80.f);
                const float k0 = 1.f - __expf(lf[i].x), k1 = 1.f - __expf(lf[i].y);
                const float qs0 = q0 * __expf(d0), qs1 = q1 * __expf(d1), ks0 = k0 * __expf(-d0), ks1 = k1 * __expf(-d1);
                *(LAS unsigned*)(L + QS + t * RS + 4 * lane) = pg8::cvt_pk_bf16(qs0, qs1);
                *(LAS unsigned*)(L + QD + t * RS + 4 * lane) = pg8::cvt_pk_bf16(qs0 * er0, qs1 * er1);
                *(LAS unsigned*)(L + KS + t * RS + 4 * lane) = pg8::cvt_pk_bf16(ks0, ks1);
                kt0[i] = ks0; kt1[i] = ks1; }
            { u32x4 w0, w1;
              w0.x = pg8::cvt_pk_bf16(kt0[0], kt0[1]); w0.y = pg8::cvt_pk_bf16(kt0[2], kt0[3]); w0.z = pg8::cvt_pk_bf16(kt0[4], kt0[5]); w0.w = pg8::cvt_pk_bf16(kt0[6], kt0[7]);
              w1.x = pg8::cvt_pk_bf16(kt1[0], kt1[1]); w1.y = pg8::cvt_pk_bf16(kt1[2], kt1[3]); w1.z = pg8::cvt_pk_bf16(kt1[4], kt1[5]); w1.w = pg8::cvt_pk_bf16(kt1[6], kt1[7]);
              *(LAS u32x4*)(L + KST + (2 * lane) * RS2 + 16 * wave) = w0; *(LAS u32x4*)(L + KST + (2 * lane + 1) * RS2 + 16 * wave) = w1; }
            { LAS bf16_t* vt = (LAS bf16_t*)(L + VT);
              vt[(vv4 + 0) * (RS2 / 2) + vs] = (bf16_t)(vraw.x & 0xffff); vt[(vv4 + 1) * (RS2 / 2) + vs] = (bf16_t)(vraw.x >> 16);
              vt[(vv4 + 2) * (RS2 / 2) + vs] = (bf16_t)(vraw.y & 0xffff); vt[(vv4 + 3) * (RS2 / 2) + vs] = (bf16_t)(vraw.y >> 16); }
            if (c + 1 < 64) {
#pragma unroll
                for (int i = 0; i < 8; ++i) { const size_t idx = (rowb + 64 * (c + 1) + 8 * wave + i) * DM + colb + 2 * lane; lf[i] = *(const f32x2*)(LOGF + idx); qv[i] = *(const unsigned*)(Q0 + idx); }
                vraw = *(const u32x2*)(V0 + (rowb + 64 * (c + 1) + vs) * DM + colb + c4 * 32 + vv4);
            }
            LDS_BARRIER();
            const int sopc = cur ? SOP1 : SOP0, sopn = cur ? SOP0 : SOP1;
            if (wave < 3) {
                const int si = wave >> 1, ti = (wave + 1) >> 1;
                f32x16 acc;
#pragma unroll
                for (int i = 0; i < 16; ++i) acc[i] = 0.f;
#pragma unroll
                for (int ks = 0; ks < 8; ++ks) { const bf16x8 a = *(const LAS bf16x8*)(L + KS + (32 * si + r32) * RS + 32 * ks + 16 * hi);
                    const bf16x8 bq = *(const LAS bf16x8*)(L + QS + (32 * ti + r32) * RS + 32 * ks + 16 * hi);
                    acc = __builtin_amdgcn_mfma_f32_32x32x16_bf16(a, bq, acc, 0, 0, 0); }
                const int t = 32 * ti + r32;
#pragma unroll
                for (int q = 0; q < 16; ++q) { const int sidx = 32 * si + crow(q, hi); if (sidx > t) acc[q] = 0.f; }
#pragma unroll
                for (int g = 0; g < 4; ++g) *(LAS u32x2*)(L + PP + t * RS2 + (32 * si + 8 * g + 4 * hi) * 2) = pack4bf(acc[4 * g], acc[4 * g + 1], acc[4 * g + 2], acc[4 * g + 3]);
            } else if (wave >= 4) {
                const int kt = wave - 4;
                f32x16 U;
#pragma unroll
                for (int i = 0; i < 16; ++i) U[i] = 0.f;
#pragma unroll
                for (int ss = 0; ss < 4; ++ss) { const bf16x8 a = *(const LAS bf16x8*)(L + KST + (32 * kt + r32) * RS2 + 32 * ss + 16 * hi);
                    const bf16x8 bv = *(const LAS bf16x8*)(L + VT + r32 * RS2 + 32 * ss + 16 * hi);
                    U = __builtin_amdgcn_mfma_f32_32x32x16_bf16(a, bv, U, 0, 0, 0); }
#pragma unroll
                for (int g = 0; g < 4; ++g) { const int k0 = 32 * kt + 8 * g + 4 * hi;
                    const f32x4 el = *(const LAS f32x4*)(L + VEC + k0 * 4), dl = *(const LAS f32x4*)(L + VEC + 512 + k0 * 4);
#pragma unroll
                    for (int e = 0; e < 4; ++e) S[4 * g + e] = dl[e] * S[4 * g + e] + el[e] * U[4 * g + e];
                    *(LAS u32x2*)(L + sopn + r32 * RS + k0 * 2) = pack4bf(S[4 * g], S[4 * g + 1], S[4 * g + 2], S[4 * g + 3]); }
            }
            LDS_BARRIER();
            if (wave < 2) {
                const int ti = wave;
                f32x16 o;
#pragma unroll
                for (int i = 0; i < 16; ++i) o[i] = 0.f;
#pragma unroll
                for (int ks = 0; ks < 8; ++ks) { const bf16x8 a = *(const LAS bf16x8*)(L + QD + (32 * ti + r32) * RS + 32 * ks + 16 * hi);
                    const bf16x8 bs = *(const LAS bf16x8*)(L + sopc + r32 * RS + 32 * ks + 16 * hi);
                    o = __builtin_amdgcn_mfma_f32_32x32x16_bf16(a, bs, o, 0, 0, 0); }
#pragma unroll
                for (int ss = 0; ss < 4; ++ss) { if (ss < 2 || ti == 1) {
                    const bf16x8 a = *(const LAS bf16x8*)(L + PP + (32 * ti + r32) * RS2 + 32 * ss + 16 * hi);
                    const bf16x8 bv = *(const LAS bf16x8*)(L + VT + r32 * RS2 + 32 * ss + 16 * hi);
                    o = __builtin_amdgcn_mfma_f32_32x32x16_bf16(a, bv, o, 0, 0, 0); } }
                bf16_t* orow = O0 + (rowb + 64 * c + 32 * ti) * DM + colb + c4 * 32 + r32;
#pragma unroll
                for (int q = 0; q < 16; ++q) orow[(size_t)crow(q, hi) * DM] = (bf16_t)f2bf(o[q]);
            }
            cur ^= 1;
        }
    }
}
namespace hg2 {
constexpr int RS = 272, RS2 = 144;
constexpr int QS = 0, KS = 17408, KST = 34816, VT = 53248, VEC = 57856, SETSZ = 59392;
constexpr int PP = 2 * SETSZ, SOP0 = PP + 9216, SOP1 = SOP0 + 8704, SEGT = SOP1 + 8704;
}
__device__ __forceinline__ void hgrn_chunk2(const Params& p, unsigned char* lds_g) {
    using namespace hg2;
    LAS unsigned char* L = (LAS unsigned char*)lds_g;
    const int tid = threadIdx.x, lane = tid & 63, wave = __builtin_amdgcn_readfirstlane(tid >> 6), r32 = lane & 31, hi = lane >> 5;
    const bf16_t* Q0 = (const bf16_t*)(p.ws + WS_B); const bf16_t* V0 = (const bf16_t*)(p.ws + WS_B + 64 * MiB);
    const float* LOGF = p.out; bf16_t* O0 = (bf16_t*)(p.ws + WS_E);
    const bool isP = wave < 4;
    const int vs = (tid & 255) >> 2, v8 = (tid & 3) * 8;
    for (int unit = blockIdx.x; unit < 256; unit += gridDim.x) {
        const int bh = unit & 63, c4 = unit >> 6, b = bh >> 4, h = bh & 15;
        const size_t rowb = (size_t)b * SEQ; const int colb = h * HD;
        __syncthreads();
        f32x16 S;
#pragma unroll
        for (int i = 0; i < 16; ++i) S[i] = 0.f;
        f32x2 lf[16], lfn[16]; unsigned qv[16], qvn[16]; u32x4 vraw, vrawn;
#define HG_LOAD_RAW(cn_, lf, qv, vraw) do { _Pragma("unroll") for (int i = 0; i < 16; ++i) { const size_t ro_ = (rowb + 64 * (cn_) + 16 * wave + i) * DM + colb;     \
            lf[i] = *(const f32x2*)((LOGF + ro_) + 2 * lane); qv[i] = *(const unsigned*)((Q0 + ro_) + 2 * lane); } \
            vraw = *(const u32x4*)((V0 + (rowb + 64 * (cn_)) * DM + colb + c4 * 32) + vs * DM + v8); } while (0)
        if (isP) HG_LOAD_RAW(0, lf, qv, vraw);
        for (int it = -1; it < 64; ++it) {
            const int cn = it + 1;
            LAS unsigned char* Sc = L + (it & 1) * SETSZ;
            LAS unsigned char* Sn = L + (cn & 1) * SETSZ;
            const int sopc = (it & 1) ? SOP1 : SOP0, sopn = (it & 1) ? SOP0 : SOP1;
            if (isP) {
                if (cn < 64) {
                    float s0 = 0.f, s1 = 0.f;
#pragma unroll
                    for (int i = 0; i < 16; ++i) { s0 += lf[i].x; s1 += lf[i].y; }
                    *(LAS f32x2*)(L + SEGT + (wave * 128 + 2 * lane) * 4) = (f32x2){s0, s1};
                }
            } else {
                const int mw = wave - 4;
                if (it < 0) { for (int e = lane + 64 * mw; e < 8704 / 4; e += 256) ((LAS unsigned*)(L + SOP0))[e] = 0u; }
                else {
                    f32x16 U;
#pragma unroll
                    for (int i = 0; i < 16; ++i) U[i] = 0.f;
#pragma unroll
                    for (int ss = 0; ss < 4; ++ss) { const bf16x8 a = *(const LAS bf16x8*)(Sc + KST + (32 * mw + r32) * RS2 + 32 * ss + 16 * hi);
                        const bf16x8 bv = *(const LAS bf16x8*)(Sc + VT + r32 * RS2 + 32 * ss + 16 * hi);
                        U = __builtin_amdgcn_mfma_f32_32x32x16_bf16(a, bv, U, 0, 0, 0); }
#pragma unroll
                    for (int g = 0; g < 4; ++g) { const int k0 = 32 * mw + 8 * g + 4 * hi;
                        const f32x4 el = *(const LAS f32x4*)(Sc + VEC + k0 * 4), dl = *(const LAS f32x4*)(Sc + VEC + 512 + k0 * 4);
#pragma unroll
                        for (int e = 0; e < 4; ++e) S[4 * g + e] = dl[e] * S[4 * g + e] + el[e] * U[4 * g + e]; }
                    if (mw < 3) {
                        const int si = mw >> 1, ti = (mw + 1) >> 1;
                        f32x16 acc;
#pragma unroll
                        for (int i = 0; i < 16; ++i) acc[i] = 0.f;
#pragma unroll
                        for (int ks = 0; ks < 8; ++ks) { const bf16x8 a = *(const LAS bf16x8*)(Sc + KS + (32 * si + r32) * RS + 32 * ks + 16 * hi);
                            const bf16x8 bq = *(const LAS bf16x8*)(Sc + QS + (32 * ti + r32) * RS + 32 * ks + 16 * hi);
                            acc = __builtin_amdgcn_mfma_f32_32x32x16_bf16(a, bq, acc, 0, 0, 0); }
                        const int t = 32 * ti + r32;
#pragma unroll
                        for (int q = 0; q < 16; ++q) { const int sidx = 32 * si + crow(q, hi); if (sidx > t) acc[q] = 0.f; }
#pragma unroll
                        for (int g = 0; g < 4; ++g) *(LAS u32x2*)(L + PP + t * RS2 + (32 * si + 8 * g + 4 * hi) * 2) = pack4bf(acc[4 * g], acc[4 * g + 1], acc[4 * g + 2], acc[4 * g + 3]);
                    }
                }
            }
            LDS_BARRIER();
            if (isP) {
                if (cn < 64) {
                    if (cn + 1 < 64) HG_LOAD_RAW(cn + 1, lfn, qvn, vrawn);
                    float pre0 = 0.f, pre1 = 0.f, br0 = 0.f, br1 = 0.f, bl0 = 0.f, bl1 = 0.f;
#pragma unroll
                    for (int w = 0; w < 4; ++w) { const f32x2 v = *(const LAS f32x2*)(L + SEGT + (w * 128 + 2 * lane) * 4);
                        if (w < wave) { pre0 += v.x; pre1 += v.y; } if (w < 2) { br0 += v.x; br1 += v.y; } bl0 += v.x; bl1 += v.y; }
                    if (wave == 0) { *(LAS f32x2*)(Sn + VEC + (2 * lane) * 4) = (f32x2){__expf(bl0 - br0), __expf(bl1 - br1)}; *(LAS f32x2*)(Sn + VEC + 512 + (2 * lane) * 4) = (f32x2){__expf(bl0), __expf(bl1)}; }
                    unsigned kt0[8], kt1[8]; float kp0 = 0.f, kp1 = 0.f;
                    float b0 = pre0 - br0, b1 = pre1 - br1;
#pragma unroll
                    for (int i = 0; i < 16; ++i) { const int t = 16 * wave + i;
                        const float q0 = __uint_as_float(qv[i] << 16), q1 = __uint_as_float(qv[i] & 0xffff0000u);
                        b0 += lf[i].x; b1 += lf[i].y;
                        const float d0 = fminf(fmaxf(b0, -80.f), 80.f), d1 = fminf(fmaxf(b1, -80.f), 80.f);
                        const float ks0 = (1.f - __expf(lf[i].x)) * __expf(-d0), ks1 = (1.f - __expf(lf[i].y)) * __expf(-d1);
                        *(LAS unsigned*)(Sn + QS + t * RS + 4 * lane) = pg8::cvt_pk_bf16(q0 * __expf(d0), q1 * __expf(d1));
                        *(LAS unsigned*)(Sn + KS + t * RS + 4 * lane) = pg8::cvt_pk_bf16(ks0, ks1);
                        if (i & 1) { kt0[i >> 1] = pg8::cvt_pk_bf16(kp0, ks0); kt1[i >> 1] = pg8::cvt_pk_bf16(kp1, ks1); }
                        else { kp0 = ks0; kp1 = ks1; } }
                    *(LAS u32x4*)(Sn + KST + (2 * lane) * RS2 + 32 * wave) = (u32x4){kt0[0], kt0[1], kt0[2], kt0[3]}; *(LAS u32x4*)(Sn + KST + (2 * lane) * RS2 + 32 * wave + 16) = (u32x4){kt0[4], kt0[5], kt0[6], kt0[7]};
                    *(LAS u32x4*)(Sn + KST + (2 * lane + 1) * RS2 + 32 * wave) = (u32x4){kt1[0], kt1[1], kt1[2], kt1[3]}; *(LAS u32x4*)(Sn + KST + (2 * lane + 1) * RS2 + 32 * wave + 16) = (u32x4){kt1[4], kt1[5], kt1[6], kt1[7]};
                    { LAS bf16_t* vt = (LAS bf16_t*)(Sn + VT);
                      vt[(v8 + 0) * (RS2 / 2) + vs] = (bf16_t)(vraw.x & 0xffff); vt[(v8 + 1) * (RS2 / 2) + vs] = (bf16_t)(vraw.x >> 16);
                      vt[(v8 + 2) * (RS2 / 2) + vs] = (bf16_t)(vraw.y & 0xffff); vt[(v8 + 3) * (RS2 / 2) + vs] = (bf16_t)(vraw.y >> 16);
                      vt[(v8 + 4) * (RS2 / 2) + vs] = (bf16_t)(vraw.z & 0xffff); vt[(v8 + 5) * (RS2 / 2) + vs] = (bf16_t)(vraw.z >> 16);
                      vt[(v8 + 6) * (RS2 / 2) + vs] = (bf16_t)(vraw.w & 0xffff); vt[(v8 + 7) * (RS2 / 2) + vs] = (bf16_t)(vraw.w >> 16); }
#pragma unroll
                    for (int i = 0; i < 16; ++i) { lf[i] = lfn[i]; qv[i] = qvn[i]; }
                    vraw = vrawn;
                }
            } else if (it >= 0) {
                const int mw = wave - 4;
                if (cn < 64) {
#pragma unroll
                    for (int g = 0; g < 4; ++g) { const int k0 = 32 * mw + 8 * g + 4 * hi;
                        const f32x4 s0 = *(const LAS f32x4*)(L + SEGT + k0 * 4), s1 = *(const LAS f32x4*)(L + SEGT + (128 + k0) * 4);
                        *(LAS u32x2*)(L + sopn + r32 * RS + k0 * 2) = pack4bf(S[4 * g] * __expf(s0[0] + s1[0]), S[4 * g + 1] * __expf(s0[1] + s1[1]), S[4 * g + 2] * __expf(s0[2] + s1[2]), S[4 * g + 3] * __expf(s0[3] + s1[3])); }
                }
                if (mw < 2) {
                    const int ti = mw;
                    f32x16 o;
#pragma unroll
                    for (int i = 0; i < 16; ++i) o[i] = 0.f;
#pragma unroll
                    for (int ks = 0; ks < 8; ++ks) { const bf16x8 a = *(const LAS bf16x8*)(Sc + QS + (32 * ti + r32) * RS + 32 * ks + 16 * hi);
                        const bf16x8 bs = *(const LAS bf16x8*)(L + sopc + r32 * RS + 32 * ks + 16 * hi);
                        o = __builtin_amdgcn_mfma_f32_32x32x16_bf16(a, bs, o, 0, 0, 0); }
#pragma unroll
                    for (int ss = 0; ss < 4; ++ss) { if (ss < 2 || ti == 1) {
                        const bf16x8 a = *(const LAS bf16x8*)(L + PP + (32 * ti + r32) * RS2 + 32 * ss + 16 * hi);
                        const bf16x8 bv = *(const LAS bf16x8*)(Sc + VT + r32 * RS2 + 32 * ss + 16 * hi);
                        o = __builtin_amdgcn_mfma_f32_32x32x16_bf16(a, bv, o, 0, 0, 0); } }
                    bf16_t* orow = O0 + (rowb + 64 * it + 32 * ti) * DM + colb + c4 * 32 + r32;
#pragma unroll
                    for (int q = 0; q < 16; ++q) orow[(size_t)crow(q, hi) * DM] = (bf16_t)f2bf(o[q]);
                }
            }
            LDS_BARRIER();
        }
#undef HG_LOAD_RAW
    }
}
namespace hg3 {
constexpr int RS = 272, RS2 = 144;
constexpr int QS = 0, KS = 17408, VT = 33792, VEC = 37888, SETSZ = 38912;
constexpr int PP = 2 * SETSZ, SOP0 = PP + 9216, SOP1 = SOP0 + 8704, SEGT = SOP1 + 8704;
struct Raw { f16x4 lf[8]; u32x2 q[8]; u32x4 v; };
typedef short v4i16_t __attribute__((ext_vector_type(4)));
__device__ __forceinline__ int offb(int row, int ch) { return 256 * row + 16 * (ch ^ (((row & 3) << 2) | ((row >> 2) & 3))); }
__device__ __forceinline__ v4i16_t trrd(const LAS unsigned char* p) { return __builtin_amdgcn_ds_read_tr16_b64_v4i16((LAS v4i16_t*)p); }
__device__ __forceinline__ bf16x8 tr_frag_ks(const LAS unsigned char* Kb, int lane, int c, int ks) {
    const int h = lane >> 5, blk = (lane >> 4) & 1, q = (lane & 15) >> 2, pp = lane & 3, r0 = 16 * ks + 8 * h + q, ch = 4 * c + 2 * blk + (pp >> 1);
    const v4i16_t lo = trrd(Kb + offb(r0, ch) + 8 * (pp & 1)), hi4 = trrd(Kb + offb(r0 + 4, ch) + 8 * (pp & 1));
    return (bf16x8){lo[0], lo[1], lo[2], lo[3], hi4[0], hi4[1], hi4[2], hi4[3]};
}
__device__ __forceinline__ bf16x8 tr_frag_v(const LAS unsigned char* Vb, int lane, int ks) {
    const int h = lane >> 5, blk = (lane >> 4) & 1, q = (lane & 15) >> 2, pp = lane & 3;
    const LAS unsigned char* a = Vb + (16 * ks + 8 * h + q) * 64 + (2 * blk + (pp >> 1)) * 16 + 8 * (pp & 1);
    const v4i16_t lo = trrd(a), hi4 = trrd(a + 4 * 64);
    return (bf16x8){lo[0], lo[1], lo[2], lo[3], hi4[0], hi4[1], hi4[2], hi4[3]};
}
}
__device__ __forceinline__ void hg3_a1(LAS unsigned char* L, const hg3::Raw& R, int sg, int k4, int sb, int segt = hg3::SEGT) {
    f32x4 s = __builtin_convertvector(R.lf[0], f32x4);
#pragma unroll
    for (int i = 1; i < 8; ++i) s += __builtin_convertvector(R.lf[i], f32x4);
    *(LAS f32x4*)(L + segt + sb * 4096 + (sg * 128 + k4) * 4) = s;
}
struct HgA2 { f32x4 bb; };
template <int HALF>
__device__ __forceinline__ void hg3_a2h(LAS unsigned char* L, LAS unsigned char* Sn, const hg3::Raw& R, int sg, int k4, int sb, int vs, int v8, HgA2& st, int segt = hg3::SEGT, bool wr_br = false) {
    using namespace hg3;
    if (HALF == 0) {
        f32x4 pre = {0.f, 0.f, 0.f, 0.f}, br = pre, bl = pre;
#pragma unroll
        for (int w = 0; w < 8; ++w) { const f32x4 v = *(const LAS f32x4*)(L + segt + sb * 4096 + (w * 128 + k4) * 4); if (w < sg) pre += v; if (w < 4) br += v; bl += v; }
        if (sg == 0) { f32x4 el, dl;
#pragma unroll
            for (int e = 0; e < 4; ++e) { el[e] = __expf(bl[e] - br[e]); dl[e] = __expf(bl[e]); }
            *(LAS f32x4*)(Sn + VEC + k4 * 4) = el; *(LAS f32x4*)(Sn + VEC + 512 + k4 * 4) = dl; if (wr_br) *(LAS f32x4*)(Sn + VEC + 1024 + k4 * 4) = br; }
        st.bb = pre - br;
    }
#pragma unroll
    for (int i = 4 * HALF; i < 4 * HALF + 4; ++i) { const int t = 8 * sg + i;
        float q[4]; q[0] = __uint_as_float(R.q[i].x << 16); q[1] = __uint_as_float(R.q[i].x & 0xffff0000u); q[2] = __uint_as_float(R.q[i].y << 16); q[3] = __uint_as_float(R.q[i].y & 0xffff0000u);
        const f32x4 lfi = __builtin_convertvector(R.lf[i], f32x4);
        st.bb += lfi;
        float qs[4], ks[4];
#pragma unroll
        for (int e = 0; e < 4; ++e) { const float d = fminf(fmaxf(st.bb[e], -80.f), 80.f); qs[e] = q[e] * __expf(d); ks[e] = (1.f - __expf(lfi[e])) * __expf(-d); }
        *(LAS u32x2*)(Sn + QS + t * RS + k4 * 2) = pack4bf(qs[0], qs[1], qs[2], qs[3]);
        *(LAS u32x2*)(Sn + KS + offb(t, k4 >> 3) + (k4 & 4) * 2) = pack4bf(ks[0], ks[1], ks[2], ks[3]); }
    if (HALF == 1) *(LAS u32x4*)(Sn + VT + vs * 64 + v8 * 2) = R.v;
}
struct HgA2p { f32x4 tt; };
template <int HALF>
__device__ __forceinline__ void hg3_a2p(LAS unsigned char* L, LAS unsigned char* Sn, const hg3::Raw& R, int sg, int k4, int sb, int vs, int v8, HgA2p& st, int segt) {
    using namespace hg3;
    if (HALF == 0) {
        f32x4 pre = {0.f, 0.f, 0.f, 0.f}, br = pre, bl = pre;
#pragma unroll
        for (int w = 0; w < 8; ++w) { const f32x4 v = *(const LAS f32x4*)(L + segt + sb * 4096 + (w * 128 + k4) * 4); if (w < sg) pre += v; if (w < 4) br += v; bl += v; }
        if (sg == 0) { f32x4 el, dl;
#pragma unroll
            for (int e = 0; e < 4; ++e) { el[e] = __builtin_amdgcn_exp2f(bl[e] - br[e]); dl[e] = __builtin_amdgcn_exp2f(bl[e]); }
            *(LAS f32x4*)(Sn + VEC + k4 * 4) = el; *(LAS f32x4*)(Sn + VEC + 512 + k4 * 4) = dl; *(LAS f32x4*)(Sn + VEC + 1024 + k4 * 4) = br; }
#pragma unroll
        for (int e = 0; e < 4; ++e) st.tt[e] = __builtin_amdgcn_exp2f(fminf(fmaxf(pre[e] - br[e], -115.f), 115.f));
    }
#pragma unroll
    for (int i = 4 * HALF; i < 4 * HALF + 4; ++i) { const int t = 8 * sg + i;
        float q[4]; q[0] = __uint_as_float(R.q[i].x << 16); q[1] = __uint_as_float(R.q[i].x & 0xffff0000u); q[2] = __uint_as_float(R.q[i].y << 16); q[3] = __uint_as_float(R.q[i].y & 0xffff0000u);
        const f32x4 lfi = __builtin_convertvector(R.lf[i], f32x4);
        float qs[4], ks[4];
#pragma unroll
        for (int e = 0; e < 4; ++e) { const float f = __builtin_amdgcn_exp2f(lfi[e]); const float tn = fminf(fmaxf(st.tt[e] * f, 1.8e-35f), 5.5e34f); st.tt[e] = tn;
            qs[e] = q[e] * tn; ks[e] = (1.f - f) * __builtin_amdgcn_rcpf(tn); }
        *(LAS u32x2*)(Sn + QS + t * RS + k4 * 2) = pack4bf(qs[0], qs[1], qs[2], qs[3]);
        *(LAS u32x2*)(Sn + KS + offb(t, k4 >> 3) + (k4 & 4) * 2) = pack4bf(ks[0], ks[1], ks[2], ks[3]); }
    if (HALF == 1) *(LAS u32x4*)(Sn + VT + vs * 64 + v8 * 2) = R.v;
}
__device__ __forceinline__ void hg3_m1(LAS unsigned char* L, LAS unsigned char* Sc, int it, int mw, int r32, int hi, f32x16& S, int pp = hg3::PP, int sop0 = hg3::SOP0) {
    using namespace hg3;
    const int lane = hi * 32 + r32;
    if (it < 0) { for (int e = lane + 64 * mw; e < 8704 / 4; e += 256) ((LAS unsigned*)(L + sop0))[e] = 0u; return; }
    bf16x8 ua[4], ub[4];
#pragma unroll
    for (int ss = 0; ss < 4; ++ss) { ua[ss] = tr_frag_ks(Sc + KS, lane, mw, ss); ub[ss] = tr_frag_v(Sc + VT, lane, ss); }
    f32x4 el[4], dl[4];
#pragma unroll
    for (int g = 0; g < 4; ++g) { const int k0 = 32 * mw + 8 * g + 4 * hi; el[g] = *(const LAS f32x4*)(Sc + VEC + k0 * 4); dl[g] = *(const LAS f32x4*)(Sc + VEC + 512 + k0 * 4); }
    const int si = mw >> 1, ti = (mw + 1) >> 1;
    bf16x8 sa[8], sq[8];
    if (mw < 3) {
#pragma unroll
        for (int ks = 0; ks < 8; ++ks) { sa[ks] = *(const LAS bf16x8*)(Sc + KS + offb(32 * si + r32, 2 * ks + hi)); sq[ks] = *(const LAS bf16x8*)(Sc + QS + (32 * ti + r32) * RS + 32 * ks + 16 * hi); }
    }
    __builtin_amdgcn_sched_barrier(0);
    f32x16 U;
#pragma unroll
    for (int i = 0; i < 16; ++i) U[i] = 0.f;
#pragma unroll
    for (int ss = 0; ss < 4; ++ss) U = __builtin_amdgcn_mfma_f32_32x32x16_bf16(ua[ss], ub[ss], U, 0, 0, 0);
    if (mw < 3) {
        f32x16 acc;
#pragma unroll
        for (int i = 0; i < 16; ++i) acc[i] = 0.f;
#pragma unroll
        for (int ks = 0; ks < 8; ++ks) acc = __builtin_amdgcn_mfma_f32_32x32x16_bf16(sa[ks], sq[ks], acc, 0, 0, 0);
        const int t = 32 * ti + r32;
#pragma unroll
        for (int q = 0; q < 16; ++q) { const int sidx = 32 * si + crow(q, hi); if (sidx > t) acc[q] = 0.f; }
#pragma unroll
        for (int g = 0; g < 4; ++g) *(LAS u32x2*)(L + pp + t * RS2 + (32 * si + 8 * g + 4 * hi) * 2) = pack4bf(acc[4 * g], acc[4 * g + 1], acc[4 * g + 2], acc[4 * g + 3]);
    }
#pragma unroll
    for (int g = 0; g < 4; ++g)
#pragma unroll
        for (int e = 0; e < 4; ++e) S[4 * g + e] = dl[g][e] * S[4 * g + e] + el[g][e] * U[4 * g + e];
}
__device__ __forceinline__ void hg4_m1(LAS unsigned char* L, LAS unsigned char* Sc, int it, int mw, int r32, int hi, f32x16& S, int pp, int sop0) {
    using namespace hg3;
    const int lane = hi * 32 + r32;
    if (it < 0) { for (int e = lane + 64 * mw; e < 8704 / 4; e += 256) ((LAS unsigned*)(L + sop0))[e] = 0u; return; }
    bf16x8 ua[4], ub[4];
#pragma unroll
    for (int ss = 0; ss < 4; ++ss) { ua[ss] = tr_frag_ks(Sc + KS, lane, mw, ss); ub[ss] = tr_frag_v(Sc + VT, lane, ss); }
    f32x4 el[4], dl[4];
#pragma unroll
    for (int g = 0; g < 4; ++g) { const int k0 = 32 * mw + 8 * g + 4 * hi; el[g] = *(const LAS f32x4*)(Sc + VEC + k0 * 4); dl[g] = *(const LAS f32x4*)(Sc + VEC + 512 + k0 * 4); }
    const int si = mw, ti0 = mw;
    bf16x8 sa[8], sq[8];
    if (mw < 2) {
#pragma unroll
        for (int ks = 0; ks < 8; ++ks) { sa[ks] = *(const LAS bf16x8*)(Sc + KS + offb(32 * si + r32, 2 * ks + hi)); sq[ks] = *(const LAS bf16x8*)(Sc + QS + (32 * ti0 + r32) * RS + 32 * ks + 16 * hi); }
    }
    __builtin_amdgcn_sched_barrier(0);
    f32x16 U;
#pragma unroll
    for (int i = 0; i < 16; ++i) U[i] = 0.f;
#pragma unroll
    for (int ss = 0; ss < 4; ++ss) U = __builtin_amdgcn_mfma_f32_32x32x16_bf16(ua[ss], ub[ss], U, 0, 0, 0);
    if (mw < 2) {
        f32x16 acc;
#pragma unroll
        for (int i = 0; i < 16; ++i) acc[i] = 0.f;
#pragma unroll
        for (int ks = 0; ks < 8; ++ks) acc = __builtin_amdgcn_mfma_f32_32x32x16_bf16(sa[ks], sq[ks], acc, 0, 0, 0);
        if (mw == 0) {
#pragma unroll
            for (int ks = 0; ks < 8; ++ks) sq[ks] = *(const LAS bf16x8*)(Sc + QS + (32 + r32) * RS + 32 * ks + 16 * hi);
        }
        { const int t = 32 * ti0 + r32;
#pragma unroll
          for (int q = 0; q < 16; ++q) { const int sidx = 32 * si + crow(q, hi); if (sidx > t) acc[q] = 0.f; }
#pragma unroll
          for (int g = 0; g < 4; ++g) *(LAS u32x2*)(L + pp + t * RS2 + (32 * si + 8 * g + 4 * hi) * 2) = pack4bf(acc[4 * g], acc[4 * g + 1], acc[4 * g + 2], acc[4 * g + 3]); }
        if (mw == 0) {
            __builtin_amdgcn_sched_barrier(0);
            f32x16 ac2;
#pragma unroll
            for (int i = 0; i < 16; ++i) ac2[i] = 0.f;
#pragma unroll
            for (int ks = 0; ks < 8; ++ks) ac2 = __builtin_amdgcn_mfma_f32_32x32x16_bf16(sa[ks], sq[ks], ac2, 0, 0, 0);
            const int t = 32 + r32;
#pragma unroll
            for (int g = 0; g < 4; ++g) *(LAS u32x2*)(L + pp + t * RS2 + (8 * g + 4 * hi) * 2) = pack4bf(ac2[4 * g], ac2[4 * g + 1], ac2[4 * g + 2], ac2[4 * g + 3]);
        }
    }
#pragma unroll
    for (int g = 0; g < 4; ++g)
#pragma unroll
        for (int e = 0; e < 4; ++e) S[4 * g + e] = dl[g][e] * S[4 * g + e] + el[g][e] * U[4 * g + e];
}
__device__ __forceinline__ void hg3_m2(LAS unsigned char* L, LAS unsigned char* Sc, int sopc, int sopn, int it, int mw, int r32, int hi, const f32x16& S, bf16_t* Ob, int pp = hg3::PP, const LAS unsigned char* brp = nullptr, bool out_hi = false, bool wide = false, bool do_keep = false, u32x4* keep = nullptr) {
    using namespace hg3;
    const int lane = hi * 32 + r32;
    const int sbn = ((it + 1) & 1) * 4096;
    const int ti = out_hi ? mw - 2 : mw;
    const bool outw = out_hi ? (mw >= 2) : (mw < 2);
    bf16x8 oa[8], ob[8], pa[4], pv[4];
    if (outw) {
#pragma unroll
        for (int ks = 0; ks < 8; ++ks) { oa[ks] = *(const LAS bf16x8*)(Sc + QS + (32 * ti + r32) * RS + 32 * ks + 16 * hi); ob[ks] = *(const LAS bf16x8*)(L + sopc + r32 * RS + 32 * ks + 16 * hi); }
#pragma unroll
        for (int ss = 0; ss < 4; ++ss) { pa[ss] = *(const LAS bf16x8*)(L + pp + (32 * ti + r32) * RS2 + 32 * ss + 16 * hi); pv[ss] = tr_frag_v(Sc + VT, lane, ss); }
    }
    f32x4 sb[4];
    if (it + 1 < 64) {
#pragma unroll
        for (int g = 0; g < 4; ++g) { const int k0 = 32 * mw + 8 * g + 4 * hi;
            if (brp != nullptr) sb[g] = *(const LAS f32x4*)(brp + k0 * 4);
            else sb[g] = (*(const LAS f32x4*)(L + SEGT + sbn + k0 * 4) + *(const LAS f32x4*)(L + SEGT + sbn + (128 + k0) * 4)) + (*(const LAS f32x4*)(L + SEGT + sbn + (256 + k0) * 4) + *(const LAS f32x4*)(L + SEGT + sbn + (384 + k0) * 4)); }
    }
    __builtin_amdgcn_sched_barrier(0);
    if (outw) {
        f32x16 o;
#pragma unroll
        for (int i = 0; i < 16; ++i) o[i] = 0.f;
#pragma unroll
        for (int ks = 0; ks < 8; ++ks) o = __builtin_amdgcn_mfma_f32_32x32x16_bf16(oa[ks], ob[ks], o, 0, 0, 0);
#pragma unroll
        for (int ss = 0; ss < 4; ++ss) { if (ss < 2 || ti == 1) o = __builtin_amdgcn_mfma_f32_32x32x16_bf16(pa[ss], pv[ss], o, 0, 0, 0); }
        if (wide) {
            LAS unsigned char* Tp = L + pp + (32 * ti) * RS2;
            asm volatile("s_nop 15\n\ts_nop 7" : "+v"(o));
#pragma unroll
            for (int qq = 0; qq < 8; ++qq) { const unsigned w = pg8::cvt_pk_bf16(o[2 * qq], o[2 * qq + 1]);
                *(LAS bf16_t*)(Tp + crow(2 * qq, hi) * RS2 + r32 * 2) = (bf16_t)(w & 0xffffu); *(LAS bf16_t*)(Tp + crow(2 * qq + 1, hi) * RS2 + r32 * 2) = (bf16_t)(w >> 16); }
            asm volatile("s_waitcnt lgkmcnt(0)" ::: "memory");
#pragma unroll
            for (int i = 0; i < 2; ++i) { const int row = (lane >> 2) + 16 * i, ch = lane & 3;
                const u32x4 v = *(const LAS u32x4*)(Tp + row * RS2 + ch * 16);
                if (do_keep) keep[i] = v;
                *(u32x4*)(Ob + (size_t)(32 * ti + row) * DM + ch * 8) = v; }
        } else {
        bf16_t* orow = Ob + (size_t)(32 * ti) * DM + r32;
#pragma unroll
        for (int q = 0; q < 16; ++q) orow[(size_t)crow(q, hi) * DM] = (bf16_t)f2bf(o[q]);
        }
    }
    if (it + 1 < 64) {
#pragma unroll
        for (int g = 0; g < 4; ++g) { const int k0 = 32 * mw + 8 * g + 4 * hi;
            *(LAS u32x2*)(L + sopn + r32 * RS + k0 * 2) = (brp != nullptr) ? pack4bf(S[4 * g] * __builtin_amdgcn_exp2f(sb[g][0]), S[4 * g + 1] * __builtin_amdgcn_exp2f(sb[g][1]), S[4 * g + 2] * __builtin_amdgcn_exp2f(sb[g][2]), S[4 * g + 3] * __builtin_amdgcn_exp2f(sb[g][3]))
                                                                              : pack4bf(S[4 * g] * __expf(sb[g][0]), S[4 * g + 1] * __expf(sb[g][1]), S[4 * g + 2] * __expf(sb[g][2]), S[4 * g + 3] * __expf(sb[g][3])); }
    }
}
template <int MODE>
__device__ __forceinline__ void hgrn_chunk3(const Params& p, unsigned char* lds_g) {
    using namespace hg3;
    LAS unsigned char* L = (LAS unsigned char*)lds_g;
    const int tid = threadIdx.x, lane = tid & 63, wave = __builtin_amdgcn_readfirstlane(tid >> 6), r32 = lane & 31, hi = lane >> 5;
    const bf16_t* Q0 = (const bf16_t*)(p.ws + WS_B); const bf16_t* V0 = (const bf16_t*)(p.ws + WS_B + 64 * MiB);
    const _Float16* LOGF16 = (const _Float16*)p.out; bf16_t* O0 = MODE == 2 ? (bf16_t*)((unsigned char*)p.out + 64 * MiB) : (bf16_t*)(p.ws + WS_E);
    const bool isP = wave < 4;
    const int sg = 2 * (wave & 3) + hi, k4 = 4 * r32;
    const int vs = (tid & 255) >> 2, v8 = (tid & 3) * 8;
    for (int unit = blockIdx.x; unit < 256; unit += gridDim.x) {
        const int bh = unit & 63, c4 = unit >> 6, b = bh >> 4, h = bh & 15;
        const size_t rowb = (size_t)b * SEQ; const int colb = h * HD;
        __syncthreads();
        f32x16 S;
#pragma unroll
        for (int i = 0; i < 16; ++i) S[i] = 0.f;
        Raw R0, R1, R2;
#define HG_LOAD(cn_, R_) do { int lo_ = hi * 8 * DM + k4, vo_ = vs * DM + v8; asm volatile("" : "+v"(lo_), "+v"(vo_));     \
            _Pragma("unroll") for (int i = 0; i < 8; ++i) { const size_t ro_ = (rowb + 64 * (cn_) + 8 * (2 * (wave & 3)) + i) * DM + colb;     \
            R_.lf[i] = *(const f16x4*)((LOGF16 + ro_) + lo_); R_.q[i] = *(const u32x2*)((Q0 + ro_) + lo_); } \
            R_.v = *(const u32x4*)((V0 + (rowb + 64 * (cn_)) * DM + colb + c4 * 32) + vo_); } while (0)
        if (isP) {
            __builtin_amdgcn_s_setprio(1);
            HgA2 st;
            if (MODE != 2) { HG_LOAD(0, R0); HG_LOAD(1, R1); hg3_a1(L, R0, sg, k4, 0); }
            LDS_BARRIER();
#define HG_PITER(it_, RC_, RN_, RF_) do { const int cn = (it_) + 1; LAS unsigned char* Sn = L + (cn & 1) * SETSZ; const int cf = cn + 2 < 63 ? cn + 2 : 63; \
            if (MODE != 2) { HG_LOAD(cf, RF_); hg3_a2h<0>(L, Sn, RC_, sg, k4, cn & 1, vs, v8, st); } LDS_BARRIER(); \
            if (MODE != 2) { hg3_a2h<1>(L, Sn, RC_, sg, k4, cn & 1, vs, v8, st); hg3_a1(L, RN_, sg, k4, (cn + 1) & 1); } LDS_BARRIER(); } while (0)
            for (int base = -1; base < 65; base += 3) { HG_PITER(base, R0, R1, R2); HG_PITER(base + 1, R1, R2, R0); HG_PITER(base + 2, R2, R0, R1); }
#undef HG_PITER
            __builtin_amdgcn_s_setprio(0);
        } else {
            LDS_BARRIER();
            for (int it = -1; it < 65; ++it) {
                LAS unsigned char* Sc = L + (it & 1) * SETSZ; const int sopc = (it & 1) ? SOP1 : SOP0, sopn = (it & 1) ? SOP0 : SOP1;
                if (MODE != 1 && it < 64) hg3_m1(L, Sc, it, wave - 4, r32, hi, S);
                LDS_BARRIER();
                if (MODE != 1 && it >= 0 && it < 64) hg3_m2(L, Sc, sopc, sopn, it, wave - 4, r32, hi, S, O0 + (rowb + 64 * it) * DM + colb + c4 * 32);
                LDS_BARRIER();
            }
        }
#undef HG_LOAD
    }
}
__device__ __forceinline__ void hn_unpack(const u32x4 v, float (&o)[8]) {
    o[0] = __uint_as_float(v.x << 16); o[1] = __uint_as_float(v.x & 0xffff0000u); o[2] = __uint_as_float(v.y << 16); o[3] = __uint_as_float(v.y & 0xffff0000u);
    o[4] = __uint_as_float(v.z << 16); o[5] = __uint_as_float(v.z & 0xffff0000u); o[6] = __uint_as_float(v.w << 16); o[7] = __uint_as_float(v.w & 0xffff0000u);
}
namespace hg4 {
constexpr int SETSZ = hg3::SETSZ + 512;
constexpr int PP0 = 3 * SETSZ, PP1 = PP0 + 9216, SOP0 = PP1 + 9216, SOP1 = SOP0 + 8704, SEGT = SOP1 + 8704, END = SEGT + 8192;
static_assert(END <= LDS_BYTES - 16, "hgrn_chunk4 LDS map");
}
__device__ __forceinline__ void hgrn_chunk4(const Params& p, unsigned char* lds_g) {
    using namespace hg3;
    LAS unsigned char* L = (LAS unsigned char*)lds_g;
    const int tid = threadIdx.x, lane = tid & 63, wave = __builtin_amdgcn_readfirstlane(tid >> 6), r32 = lane & 31, hi = lane >> 5;
    const bf16_t* Q0 = (const bf16_t*)(p.ws + WS_B); const bf16_t* V0 = (const bf16_t*)(p.ws + WS_B + 64 * MiB);
    const _Float16* LOGF16 = (const _Float16*)p.out; bf16_t* O0 = (bf16_t*)(p.ws + WS_E);
    const bool isP = wave < 4;
    const int sg = 2 * (wave & 3) + hi, k4 = 4 * r32;
    const int vs = (tid & 255) >> 2, v8 = (tid & 3) * 8;
    for (int unit = blockIdx.x; unit < 256; unit += gridDim.x) {
        const int bh = unit & 63, c4 = unit >> 6, b = bh >> 4, h = bh & 15;
        const size_t rowb = (size_t)b * SEQ; const int colb = h * HD;
        __syncthreads();
        f32x16 S;
#pragma unroll
        for (int i = 0; i < 16; ++i) S[i] = 0.f;
        Raw R0, R1, R2;
#define HG_LOAD(cn_, R_) do { int lo_ = hi * 8 * DM + k4, vo_ = vs * DM + v8; asm volatile("" : "+v"(lo_), "+v"(vo_));     \
            _Pragma("unroll") for (int i = 0; i < 8; ++i) { const size_t ro_ = (rowb + 64 * (cn_) + 8 * (2 * (wave & 3)) + i) * DM + colb;     \
            R_.lf[i] = *(const f16x4*)((LOGF16 + ro_) + lo_); R_.q[i] = *(const u32x2*)((Q0 + ro_) + lo_); } \
            R_.v = *(const u32x4*)((V0 + (rowb + 64 * (cn_)) * DM + colb + c4 * 32) + vo_); } while (0)
        if (isP) {
            __builtin_amdgcn_s_setprio(1);
            HgA2p st;
            HG_LOAD(0, R0); HG_LOAD(1, R1); hg3_a1(L, R0, sg, k4, 0, hg4::SEGT);
            LDS_BARRIER();
#define HG_PSTEP(s_, RC_, RN_, RF_) do { const int cn = (s_) + 1; LAS unsigned char* Sn = L + (cn % 3) * hg4::SETSZ; const int cf = cn + 2 < 63 ? cn + 2 : 63; \
            HG_LOAD(cf, RF_); hg3_a2p<0>(L, Sn, RC_, sg, k4, cn & 1, vs, v8, st, hg4::SEGT); hg3_a2p<1>(L, Sn, RC_, sg, k4, cn & 1, vs, v8, st, hg4::SEGT); \
            hg3_a1(L, RN_, sg, k4, (cn + 1) & 1, hg4::SEGT); LDS_BARRIER(); } while (0)
            for (int base = -1; base < 65; base += 3) { HG_PSTEP(base, R0, R1, R2); HG_PSTEP(base + 1, R1, R2, R0); HG_PSTEP(base + 2, R2, R0, R1); }
#undef HG_PSTEP
            __builtin_amdgcn_s_setprio(0);
        } else {
            LDS_BARRIER();
            const bool fused = gridDim.x == 256;
            const int mw = wave - 4, tio = mw - 2;
            unsigned* FL = (unsigned*)(p.ws + WS_BAR) + 3584;
            float* SSP = (float*)(p.ws + WS_G);
            const bf16_t* Z0 = (const bf16_t*)(p.ws + WS_D); bf16_t* ONp = (bf16_t*)(p.ws + WS_A);
            const bool fo = fused && mw >= 2, fr = fused && mw < 2; const int tl = mw & 1;
            for (int s = -1; s < 68; ++s) {
                int ln_ = lane; asm volatile("" : "+v"(ln_)); const int r32_ = ln_ & 31, hi_ = ln_ >> 5;
                const int c2 = s - 1;
                const int cf = c2 - 2, cz = c2 - 3;
                u32x4 zz[2], oo[2], kp[2]; unsigned fl = 0u; float pt[2];
                if (fr) {
                    if (cf >= 0 && cf < 64) fl = __hip_atomic_load(FL + (bh + 64 * (ln_ & 3)) * 2 + tl, __ATOMIC_RELAXED, __HIP_MEMORY_SCOPE_AGENT);
                    if (cz >= 0 && cz < 64) {
#pragma unroll
                        for (int i = 0; i < 2; ++i) { const int row = (ln_ >> 2) + 16 * i, ch = ln_ & 3; const size_t off = (rowb + 64 * cz + 32 * tl + row) * DM + colb + c4 * 32 + ch * 8;
                            pt[i] = __hip_atomic_load(SSP + ((size_t)(bh * 64 + cz) * 4 + ch) * 64 + 32 * tl + row, __ATOMIC_RELAXED, __HIP_MEMORY_SCOPE_AGENT);
                            oo[i] = *(const u32x4*)(O0 + off); zz[i] = *(const u32x4*)(Z0 + off); } }
                }
                if (c2 >= 0 && c2 < 64) hg3_m2(L, L + (c2 % 3) * hg4::SETSZ, (c2 & 1) ? hg4::SOP1 : hg4::SOP0, (c2 & 1) ? hg4::SOP0 : hg4::SOP1, c2, mw, r32_, hi_, S,
                                               O0 + (rowb + 64 * c2) * DM + colb + c4 * 32, (c2 & 1) ? hg4::PP1 : hg4::PP0, L + ((c2 + 1) % 3) * hg4::SETSZ + VEC + 1024, true, true, fused, kp);
                if (s < 64) hg3_m1(L, L + ((s + 3) % 3) * hg4::SETSZ, s, mw, r32_, hi_, S, (s & 1) ? hg4::PP1 : hg4::PP0, hg4::SOP0);
                if (fo && c2 - 1 >= 0 && c2 - 1 < 64) {
                    if (c2 < 64) asm volatile("s_waitcnt vmcnt(2)" ::: "memory"); else asm volatile("s_waitcnt vmcnt(0)" ::: "memory");
                    if (ln_ == 0) __hip_atomic_store(FL + unit * 2 + tl, (unsigned)c2, __ATOMIC_RELAXED, __HIP_MEMORY_SCOPE_AGENT); }
                if (fo && c2 >= 0 && c2 < 64) {
#pragma unroll
                    for (int i = 0; i < 2; ++i) { float o8[8]; hn_unpack(kp[i], o8); float ss = 0.f;
#pragma unroll
                        for (int e = 0; e < 8; ++e) ss += o8[e] * o8[e];
                        ss += quad_x<0xB1>(ss); ss += quad_x<0x4E>(ss);
                        if ((ln_ & 3) == 0) __hip_atomic_store(SSP + ((size_t)(bh * 64 + c2) * 4 + c4) * 64 + 32 * tl + (ln_ >> 2) + 16 * i, ss, __ATOMIC_RELAXED, __HIP_MEMORY_SCOPE_AGENT); }
                }
                if (fr && cz >= 0 && cz < 64) {
#pragma unroll
                    for (int i = 0; i < 2; ++i) { const int row = (ln_ >> 2) + 16 * i, ch = ln_ & 3;
                        float tot = pt[i]; tot += quad_x<0xB1>(tot); tot += quad_x<0x4E>(tot);
                        const float rr = rsqrtf(tot * (1.f / HD) + RMS_EPS);
                        float o8[8], z8[8]; hn_unpack(oo[i], o8); hn_unpack(zz[i], z8);
#pragma unroll
                        for (int e = 0; e < 8; ++e) z8[e] = o8[e] * rr * (z8[e] * sigmoidf_(z8[e]));
                        u32x4 w; w.x = pk2(z8[0], z8[1]); w.y = pk2(z8[2], z8[3]); w.z = pk2(z8[4], z8[5]); w.w = pk2(z8[6], z8[7]);
                        *(u32x4*)(ONp + (rowb + 64 * cz + 32 * tl + row) * DM + colb + c4 * 32 + ch * 8) = w; }
                }
                if (fr && cf >= 0 && cf < 64) {
                    const unsigned* fp = FL + (bh + 64 * (ln_ & 3)) * 2 + tl;
                    for (int spin = 0; spin < (1 << 22) && !__all(fl >= (unsigned)(cf + 1)); ++spin) { __builtin_amdgcn_s_sleep(2); fl = __hip_atomic_load(fp, __ATOMIC_RELAXED, __HIP_MEMORY_SCOPE_AGENT); }
                    asm volatile("" ::: "memory");
                }
                if (s < 65) LDS_BARRIER();
            }
        }
#undef HG_LOAD
    }
}
__device__ __forceinline__ void hgrn_headnorm(const Params& p) {
    const int tid = threadIdx.x, lane = tid & 63, wave = tid >> 6, gw = blockIdx.x * 8 + wave, NGW = gridDim.x * 8;
    const bf16_t* O0 = (const bf16_t*)(p.ws + WS_E); const bf16_t* Z0 = (const bf16_t*)(p.ws + WS_D); bf16_t* ON = (bf16_t*)(p.ws + WS_A);
    const int sub = lane & 15;
    constexpr int NR4 = T * NH / 4;
    for (int r4 = gw; r4 < NR4; r4 += 4 * NGW) {
        size_t off[4]; u32x4 ov[4], zv[4];
#pragma unroll
        for (int u = 0; u < 4; ++u) { const int rr = r4 + u * NGW < NR4 ? r4 + u * NGW : r4; off[u] = ((size_t)rr * 4 + (lane >> 4)) * 128 + 8 * sub; ov[u] = *(const u32x4*)(O0 + off[u]); zv[u] = *(const u32x4*)(Z0 + off[u]); }
#pragma unroll
        for (int u = 0; u < 4; ++u) { float o[8], z[8]; hn_unpack(ov[u], o); hn_unpack(zv[u], z);
#pragma unroll
            for (int e = 0; e < 8; ++e) z[e] = z[e] * sigmoidf_(z[e]);
            float ss = 0.f;
#pragma unroll
            for (int e = 0; e < 8; ++e) ss += o[e] * o[e];
            ss += __shfl_xor(ss, 1); ss += __shfl_xor(ss, 2); ss += __shfl_xor(ss, 4); ss += __shfl_xor(ss, 8);
            const float rr = rsqrtf(ss * (1.f / HD) + RMS_EPS);
            u32x4 w; w.x = pk2(o[0] * rr * z[0], o[1] * rr * z[1]); w.y = pk2(o[2] * rr * z[2], o[3] * rr * z[3]);
            w.z = pk2(o[4] * rr * z[4], o[5] * rr * z[5]); w.w = pk2(o[6] * rr * z[6], o[7] * rr * z[7]);
            *(u32x4*)(ON + off[u]) = w; }
    }
}
template <bool OUT_BF16>
__device__ __forceinline__ void rows_rms2(const float* X, const float* gain, void* Ov, const int tidv) {
    const int lane = tidv & 63, gw = blockIdx.x * 8 + (tidv >> 6), NGW = gridDim.x * 8;
    const f32x4* gr = (const f32x4*)gain + lane;
    for (int m = gw; m < T; m += 2 * NGW) {
        const int m2 = m + NGW < T ? m + NGW : m;
        const f32x4* xa = (const f32x4*)(X + (size_t)m * DM) + lane; const f32x4* xb = (const f32x4*)(X + (size_t)m2 * DM) + lane;
        f32x4 va[8], vb[8]; float sa = 0.f, sb = 0.f;
#pragma unroll
        for (int j = 0; j < 8; ++j) va[j] = xa[64 * j];
#pragma unroll
        for (int j = 0; j < 8; ++j) vb[j] = xb[64 * j];
#pragma unroll
        for (int j = 0; j < 8; ++j) { sa += (va[j].x * va[j].x + va[j].y * va[j].y) + (va[j].z * va[j].z + va[j].w * va[j].w); sb += (vb[j].x * vb[j].x + vb[j].y * vb[j].y) + (vb[j].z * vb[j].z + vb[j].w * vb[j].w); }
        const float ra = rsqrtf(wave_sum(sa) * (1.f / DM) + RMS_EPS), rb = rsqrtf(wave_sum(sb) * (1.f / DM) + RMS_EPS);
        if (OUT_BF16) { u32x2* oa = (u32x2*)((bf16_t*)Ov + (size_t)m * DM) + lane; u32x2* ob = (u32x2*)((bf16_t*)Ov + (size_t)m2 * DM) + lane;
#pragma unroll
            for (int j = 0; j < 8; ++j) { const f32x4 g = gr[64 * j]; u32x2 w; w.x = pk2(va[j].x * ra * g.x, va[j].y * ra * g.y); w.y = pk2(va[j].z * ra * g.z, va[j].w * ra * g.w); oa[64 * j] = w;
                w.x = pk2(vb[j].x * rb * g.x, vb[j].y * rb * g.y); w.y = pk2(vb[j].z * rb * g.z, vb[j].w * rb * g.w); ob[64 * j] = w; } }
        else { f32x4* oa = (f32x4*)((float*)Ov + (size_t)m * DM) + lane; f32x4* ob = (f32x4*)((float*)Ov + (size_t)m2 * DM) + lane;
#pragma unroll
            for (int j = 0; j < 8; ++j) { const f32x4 g = gr[64 * j]; oa[64 * j] = va[j] * ra * g; ob[64 * j] = vb[j] * rb * g; } }
    }
}
template <bool OUT_BF16>
__device__ __forceinline__ void rows_rms_b(const bf16_t* X, const float* gain, void* Ov, const int tidv) {
    const int lane = tidv & 63, gw = blockIdx.x * 8 + (tidv >> 6), NGW = gridDim.x * 8;
    const f32x4* gr = (const f32x4*)gain + 2 * lane;
    for (int m = gw; m < T; m += 4 * NGW) {
        int mr[4]; u32x4 v[4][4]; float rr[4];
#pragma unroll
        for (int r = 0; r < 4; ++r) mr[r] = m + r * NGW < T ? m + r * NGW : m;
#pragma unroll
        for (int r = 0; r < 4; ++r)
#pragma unroll
            for (int j = 0; j < 4; ++j) v[r][j] = *((const u32x4*)(X + (size_t)mr[r] * DM) + lane + 64 * j);
#pragma unroll
        for (int r = 0; r < 4; ++r) { float s = 0.f;
#pragma unroll
            for (int j = 0; j < 4; ++j)
#pragma unroll
                for (int e = 0; e < 4; ++e) { const float lo = __uint_as_float(v[r][j][e] << 16), hi = __uint_as_float(v[r][j][e] & 0xffff0000u); s += lo * lo + hi * hi; }
            rr[r] = s; }
#pragma unroll
        for (int r = 0; r < 4; ++r) rr[r] = rsqrtf(wave_sum(rr[r]) * (1.f / DM) + RMS_EPS);
#pragma unroll
        for (int j = 0; j < 4; ++j) { const f32x4 g0 = gr[128 * j], g1 = gr[128 * j + 1];
#pragma unroll
            for (int r = 0; r < 4; ++r) { const u32x4 q = v[r][j]; const float k = rr[r];
                const f32x4 o0 = (f32x4){__uint_as_float(q.x << 16) * k * g0.x, __uint_as_float(q.x & 0xffff0000u) * k * g0.y, __uint_as_float(q.y << 16) * k * g0.z, __uint_as_float(q.y & 0xffff0000u) * k * g0.w};
                const f32x4 o1 = (f32x4){__uint_as_float(q.z << 16) * k * g1.x, __uint_as_float(q.z & 0xffff0000u) * k * g1.y, __uint_as_float(q.w << 16) * k * g1.z, __uint_as_float(q.w & 0xffff0000u) * k * g1.w};
                if (OUT_BF16) { u32x4 w; w.x = pk2(o0.x, o0.y); w.y = pk2(o0.z, o0.w); w.z = pk2(o1.x, o1.y); w.w = pk2(o1.z, o1.w); *((u32x4*)((bf16_t*)Ov + (size_t)mr[r] * DM) + lane + 64 * j) = w; }
                else { f32x4* o = (f32x4*)((float*)Ov + (size_t)mr[r] * DM) + 2 * lane + 128 * j; o[0] = o0; o[1] = o1; } } }
    }
}
__device__ __forceinline__ void rows_rms16(const float* X, const float* gain, bf16_t* O, const int tidv) {
    const int lane = tidv & 63, gw = blockIdx.x * 8 + (tidv >> 6), NGW = gridDim.x * 8;
    const f32x4* gr = (const f32x4*)gain + 2 * lane;
    for (int m = gw; m < T; m += 2 * NGW) {
        const int m2 = m + NGW < T ? m + NGW : m;
        const f32x4* xa = (const f32x4*)(X + (size_t)m * DM) + 2 * lane; const f32x4* xb = (const f32x4*)(X + (size_t)m2 * DM) + 2 * lane;
        f32x4 va[8], vb[8]; float sa = 0.f, sb = 0.f;
#pragma unroll
        for (int j = 0; j < 4; ++j) { va[2 * j] = xa[128 * j]; va[2 * j + 1] = xa[128 * j + 1]; }
#pragma unroll
        for (int j = 0; j < 4; ++j) { vb[2 * j] = xb[128 * j]; vb[2 * j + 1] = xb[128 * j + 1]; }
#pragma unroll
        for (int j = 0; j < 8; ++j) { sa += (va[j].x * va[j].x + va[j].y * va[j].y) + (va[j].z * va[j].z + va[j].w * va[j].w); sb += (vb[j].x * vb[j].x + vb[j].y * vb[j].y) + (vb[j].z * vb[j].z + vb[j].w * vb[j].w); }
        const float ra = rsqrtf(wave_sum(sa) * (1.f / DM) + RMS_EPS), rb = rsqrtf(wave_sum(sb) * (1.f / DM) + RMS_EPS);
        u32x4* oa = (u32x4*)(O + (size_t)m * DM) + lane; u32x4* ob = (u32x4*)(O + (size_t)m2 * DM) + lane;
#pragma unroll
        for (int j = 0; j < 4; ++j) { const f32x4 g0 = gr[128 * j], g1 = gr[128 * j + 1]; u32x4 w;
            w.x = pk2(va[2 * j].x * ra * g0.x, va[2 * j].y * ra * g0.y); w.y = pk2(va[2 * j].z * ra * g0.z, va[2 * j].w * ra * g0.w);
            w.z = pk2(va[2 * j + 1].x * ra * g1.x, va[2 * j + 1].y * ra * g1.y); w.w = pk2(va[2 * j + 1].z * ra * g1.z, va[2 * j + 1].w * ra * g1.w); oa[64 * j] = w;
            w.x = pk2(vb[2 * j].x * rb * g0.x, vb[2 * j].y * rb * g0.y); w.y = pk2(vb[2 * j].z * rb * g0.z, vb[2 * j].w * rb * g0.w);
            w.z = pk2(vb[2 * j + 1].x * rb * g1.x, vb[2 * j + 1].y * rb * g1.y); w.w = pk2(vb[2 * j + 1].z * rb * g1.z, vb[2 * j + 1].w * rb * g1.w); ob[64 * j] = w; }
    }
}
__device__ __forceinline__ void rows_rms_bf16(const float* X, const float* gain, bf16_t* O, const int tidv) { rows_rms2<true>(X, gain, O, tidv); }
__device__ __forceinline__ void rows_rms_f32(const float* X, const float* gain, float* O, const int tidv) { rows_rms2<false>(X, gain, O, tidv); }

__device__ __forceinline__ float gelu_tanh(float x) { const float u = 0.7978845608028654f * (x + 0.044715f * x * x * x); return 0.5f * x * (1.f + tanhf(u)); }
__device__ __forceinline__ void compress_naive(const Params& p, unsigned char* lds_g) {
    const int tid = threadIdx.x;
    const bf16_t* KV = (const bf16_t*)(p.ws + WS_E);
    const float* misc = (const float*)(p.ws + WS_MISC);
    float* xs = (float*)lds_g;
    float* red = xs + 144 * 128;
    float* hid = red + 4 * 8 * 128;
    const int n = tid & 127, part = tid >> 7;
    for (int unit = blockIdx.x; unit < 2 * 16 * 32; unit += gridDim.x) {
        const int which = unit / 512, bg = (unit % 512) / 32, i0 = (unit % 32) * 8, b = bg >> 2, g = bg & 3;
        const bf16_t* src = KV + (size_t)which * ((size_t)T * 512);
        const float* w1 = which ? p.pv_w1 : p.pk_w1; const float* w2 = which ? p.pv_w2 : p.pk_w2; const float* b1n = which ? p.pv_b1 : p.pk_b1; const float* cvp = misc + MISC_CVP / 4 + which * 8 * 128;
        bf16_t* dst = (bf16_t*)(p.ws + (which ? WS_VCMP : WS_KCMP)) + (size_t)bg * NCMPP * 128;
        __syncthreads();
        for (int e = tid; e < 144 * 128; e += 512) { const int tt = e >> 7, d = e & 127; const int tok = 16 * i0 + tt;
            xs[e] = tok < SEQ ? bf2f(src[(size_t)(b * SEQ + tok) * 512 + g * 128 + d]) : 0.f; }
        __syncthreads();
        float acc[8];
#pragma unroll
        for (int k = 0; k < 8; ++k) acc[k] = 0.f;
        for (int r = part * 1024; r < part * 1024 + 1024; ++r) {
            const float w = w1[(size_t)r * 128 + n]; const int j = r >> 7, d = r & 127;
#pragma unroll
            for (int k = 0; k < 8; ++k) acc[k] += xs[(16 * k + j) * 128 + d] * w;
        }
#pragma unroll
        for (int k = 0; k < 8; ++k) red[(part * 8 + k) * 128 + n] = acc[k];
        __syncthreads();
        for (int e = tid; e < 1024; e += 512) { const int k = e >> 7, nn = e & 127;
            float cvs = b1n[nn]; for (int sl = 0; sl < 8; ++sl) cvs += cvp[sl * 128 + nn];
            const float h = cvs + ((red[(0 * 8 + k) * 128 + nn] + red[(1 * 8 + k) * 128 + nn]) + (red[(2 * 8 + k) * 128 + nn] + red[(3 * 8 + k) * 128 + nn]));
            hid[e] = gelu_tanh(h); }
        __syncthreads();
        for (int e = tid; e < 1024; e += 512) { const int k = e >> 7, nn = e & 127; float s = 0.f;
            for (int m = 0; m < 128; ++m) s += hid[k * 128 + m] * w2[m * 128 + nn];
            const int i = i0 + k;
            dst[(size_t)i * 128 + nn] = (bf16_t)(i < NCMP ? f2bf(s) : 0u); }
    }
}

__device__ __forceinline__ void dot4(const bf16_t* krow, const float* qs, float (&a)[4]) {
    a[0] = a[1] = a[2] = a[3] = 0.f;
#pragma unroll 4
    for (int c = 0; c < 16; ++c) { const u32x4 kv = *(const u32x4*)(krow + 8 * c);
        float kf[8]; kf[0] = __uint_as_float(kv.x << 16); kf[1] = __uint_as_float(kv.x & 0xffff0000u); kf[2] = __uint_as_float(kv.y << 16); kf[3] = __uint_as_float(kv.y & 0xffff0000u);
        kf[4] = __uint_as_float(kv.z << 16); kf[5] = __uint_as_float(kv.z & 0xffff0000u); kf[6] = __uint_as_float(kv.w << 16); kf[7] = __uint_as_float(kv.w & 0xffff0000u);
#pragma unroll
        for (int h = 0; h < 4; ++h) { const f32x4 q0 = *(const f32x4*)(qs + h * 128 + 8 * c), q1 = *(const f32x4*)(qs + h * 128 + 8 * c + 4);
            a[h] += (kf[0] * q0.x + kf[1] * q0.y) + (kf[2] * q0.z + kf[3] * q0.w) + (kf[4] * q1.x + kf[5] * q1.y) + (kf[6] * q1.z + kf[7] * q1.w); } }
}
__device__ __forceinline__ void softmax4(f32x4* pl, int n, int lane) {
    const float NINF = -__builtin_inff();
    f32x4 m = {NINF, NINF, NINF, NINF};
    for (int i = lane; i < n; i += 64) { const f32x4 v = pl[i]; m.x = fmaxf(m.x, v.x); m.y = fmaxf(m.y, v.y); m.z = fmaxf(m.z, v.z); m.w = fmaxf(m.w, v.w); }
    m.x = wave_max(m.x); m.y = wave_max(m.y); m.z = wave_max(m.z); m.w = wave_max(m.w);
    f32x4 s = {0.f, 0.f, 0.f, 0.f};
    for (int i = lane; i < n; i += 64) { const f32x4 v = pl[i]; f32x4 e;
        e.x = m.x == NINF ? 0.f : __expf(v.x - m.x); e.y = m.y == NINF ? 0.f : __expf(v.y - m.y); e.z = m.z == NINF ? 0.f : __expf(v.z - m.z); e.w = m.w == NINF ? 0.f : __expf(v.w - m.w);
        pl[i] = e; s += e; }
    s.x = wave_sum(s.x); s.y = wave_sum(s.y); s.z = wave_sum(s.z); s.w = wave_sum(s.w);
    f32x4 inv; inv.x = s.x > 0.f ? 1.f / s.x : 0.f; inv.y = s.y > 0.f ? 1.f / s.y : 0.f; inv.z = s.z > 0.f ? 1.f / s.z : 0.f; inv.w = s.w > 0.f ? 1.f / s.w : 0.f;
    for (int i = lane; i < n; i += 64) pl[i] = pl[i] * inv;
}
__device__ __forceinline__ void pv_acc(const f32x4 pw, unsigned vv, float (&o)[4][2]) {
    const float v0 = __uint_as_float(vv << 16), v1 = __uint_as_float(vv & 0xffff0000u);
    o[0][0] += pw.x * v0; o[0][1] += pw.x * v1; o[1][0] += pw.y * v0; o[1][1] += pw.y * v1; o[2][0] += pw.z * v0; o[2][1] += pw.z * v1; o[3][0] += pw.w * v0; o[3][1] += pw.w * v1;
}
__device__ __forceinline__ void nsa_naive(const Params& p, unsigned char* lds_g, bf16_t* O1) {
    const int tid = threadIdx.x, lane = tid & 63, wave = tid >> 6;
    const bf16_t* Q1 = (const bf16_t*)(p.ws + WS_D); const bf16_t* KV = (const bf16_t*)(p.ws + WS_E); const bf16_t* Z1 = (const bf16_t*)(p.ws + WS_G);
    const float* GT = (const float*)(p.ws + WS_GATES); const bf16_t* KC = (const bf16_t*)(p.ws + WS_KCMP); const bf16_t* VC = (const bf16_t*)(p.ws + WS_VCMP);
    const float* biasp = (const float*)(p.ws + WS_MISC + MISC_BIASP);
    const size_t TS = (size_t)T * 512;
    const bf16_t* KS = KV + 2 * TS; const bf16_t* VS = KV + 3 * TS; const bf16_t* KW = KV + 4 * TS; const bf16_t* VW = KV + 5 * TS;
    float* qs = (float*)(lds_g + wave * 18432);
    f32x4* pl = (f32x4*)(lds_g + wave * 18432 + 2048);
    const float NINF = -__builtin_inff();
    const int gw = blockIdx.x * 8 + wave, NGW = gridDim.x * 8, NU = NB * NG * SEQ, niter = (NU + NGW - 1) / NGW;
    for (int it = 0; it < niter; ++it) {
        int unit = it * NGW + gw; const bool live = unit < NU; if (!live) unit = NU - 1;
        const int bg = unit / SEQ, t = unit % SEQ, b = bg >> 2, g = bg & 3;
        const size_t row = (size_t)b * SEQ + t;
        __syncthreads();
        { const bf16_t* qrow = Q1 + row * DM + g * 512;
          for (int e = lane; e < 512; e += 64) qs[e] = bf2f(qrow[e]); }
        __syncthreads();
        const float* bp = biasp + (g * 4) * 128;
        for (int c = 0; c < 4; ++c) { const int i = lane + 64 * c; float a[4]; dot4(KC + ((size_t)bg * NCMPP + i) * 128, qs, a);
            const int dist = t - (16 * i + 31); const bool valid = (i < NCMP) && dist >= 0;
            f32x4 l = {NINF, NINF, NINF, NINF};
            if (valid) { const bool nr = dist < 128; l.x = a[0] + (nr ? bp[dist] : 0.f); l.y = a[1] + (nr ? bp[128 + dist] : 0.f); l.z = a[2] + (nr ? bp[256 + dist] : 0.f); l.w = a[3] + (nr ? bp[384 + dist] : 0.f); }
            pl[i] = l; }
        __syncthreads();
        softmax4(pl, 256, lane);
        __syncthreads();
        float oc[4][2] = {};
        { const int imax = t >= 31 ? (t - 31) / 16 : -1;
          const unsigned* vb = (const unsigned*)(VC + (size_t)bg * NCMPP * 128) + lane;
#pragma unroll 8
          for (int i = 0; i <= imax; ++i) pv_acc(pl[i], vb[(size_t)i * 64], oc); }
        unsigned long long selmask;
        { const int j = lane; float imp = 0.f;
          for (int i = 4 * j - 1; i <= 4 * j + 3; ++i) if (i >= 0 && i < NCMP) { const f32x4 v = pl[i]; imp += (v.x + v.y) + (v.z + v.w); }
          const int cur = t >> 6; const bool forced = (j == 0) || (j == cur) || (j == cur - 1), visible = (j * 64 <= t);
          const float score = forced ? 1e9f : (visible ? imp : -1e30f);
          int rank = 0;
          for (int jj = 0; jj < 64; ++jj) { const float s2 = __shfl(score, jj); rank += (s2 > score || (s2 == score && jj < j)) ? 1 : 0; }
          selmask = __ballot(rank < 16); }
        __syncthreads();
        { int slot = 0;
          for (int jb = 0; jb < 64; ++jb) { if (!((selmask >> jb) & 1ull)) continue;
              const int pos = jb * 64 + lane; float a[4]; dot4(KS + ((size_t)b * SEQ + pos) * 512 + g * 128, qs, a);
              const int dist = t - pos; f32x4 l = {NINF, NINF, NINF, NINF};
              if (dist >= 0) { const bool nr = dist < 128; l.x = a[0] + (nr ? bp[dist] : 0.f); l.y = a[1] + (nr ? bp[128 + dist] : 0.f); l.z = a[2] + (nr ? bp[256 + dist] : 0.f); l.w = a[3] + (nr ? bp[384 + dist] : 0.f); }
              pl[slot * 64 + lane] = l; ++slot; } }
        __syncthreads();
        softmax4(pl, 1024, lane);
        __syncthreads();
        float os[4][2] = {};
        { int slot = 0;
          for (int jb = 0; jb < 64; ++jb) { if (!((selmask >> jb) & 1ull)) continue;
              if (jb * 64 <= t) { const unsigned* vb = (const unsigned*)(VS + ((size_t)b * SEQ + jb * 64) * 512 + g * 128) + lane;
#pragma unroll 8
                  for (int kk = 0; kk < 64; ++kk) pv_acc(pl[slot * 64 + kk], vb[(size_t)kk * 256], os); }
              ++slot; } }
        __syncthreads();
        for (int c = 0; c < 8; ++c) { const int m = lane + 64 * c, pos = t - 511 + m; const int pc = pos < 0 ? 0 : pos; float a[4]; dot4(KW + ((size_t)b * SEQ + pc) * 512 + g * 128, qs, a);
            const int dist = 511 - m; f32x4 l = {NINF, NINF, NINF, NINF};
            if (pos >= 0) { const bool nr = dist < 128; l.x = a[0] + (nr ? bp[dist] : 0.f); l.y = a[1] + (nr ? bp[128 + dist] : 0.f); l.z = a[2] + (nr ? bp[256 + dist] : 0.f); l.w = a[3] + (nr ? bp[384 + dist] : 0.f); }
            pl[m] = l; }
        __syncthreads();
        softmax4(pl, 512, lane);
        __syncthreads();
        float ow[4][2] = {};
        { const int m0 = t >= 511 ? 0 : 511 - t;
          const unsigned* vb = (const unsigned*)(VW + ((size_t)b * SEQ) * 512 + g * 128) + lane;
#pragma unroll 8
          for (int m = m0; m < 512; ++m) pv_acc(pl[m], vb[(size_t)(t - 511 + m) * 256], ow); }
        if (live) {
            const float* gt = GT + row * 48 + g * 12;
#pragma unroll
            for (int h = 0; h < 4; ++h) { const float gc = gate_of(gt + h * 3 + 0), gs = gate_of(gt + h * 3 + 1), gwn = gate_of(gt + h * 3 + 2);
                const unsigned zv = ((const unsigned*)(Z1 + row * DM + (g * 4 + h) * 128))[lane];
                const float z0 = __uint_as_float(zv << 16), z1 = __uint_as_float(zv & 0xffff0000u);
                const float r0 = (gc * oc[h][0] + gs * os[h][0] + gwn * ow[h][0]) * z0, r1 = (gc * oc[h][1] + gs * os[h][1] + gwn * ow[h][1]) * z1;
                ((unsigned*)(O1 + row * DM + (g * 4 + h) * 128))[lane] = pk2(r0, r1); }
        }
    }
}

__device__ __forceinline__ void compress_mfma(const Params& p, unsigned char* lds_g) {
    LAS unsigned char* L = (LAS unsigned char*)lds_g;
    const int tid = threadIdx.x, lane = tid & 63, wave = __builtin_amdgcn_readfirstlane(tid >> 6), r32 = lane & 31, hi = lane >> 5;
    const bf16_t* KV = (const bf16_t*)(p.ws + WS_E);
    const float* misc = (const float*)(p.ws + WS_MISC);
    constexpr int HRS = 272;
    const int nt = wave & 3, kh = wave >> 2;
    for (int unit = blockIdx.x; unit < 2 * 16 * 8; unit += gridDim.x) {
        const int which = unit >> 7, bg = (unit >> 3) & 15, i0 = (unit & 7) * 32, b = bg >> 2, g = bg & 3;
        const bf16_t* src = KV + (size_t)which * ((size_t)T * 512) + ((size_t)b * SEQ) * 512 + g * 128;
        const bf16_t* w1t = (const bf16_t*)(p.ws + (which ? WS_W1V : WS_W1K)); const bf16_t* w2t = (const bf16_t*)(p.ws + (which ? WS_W2V : WS_W2K));
        bf16_t* dst = (bf16_t*)(p.ws + (which ? WS_VCMP : WS_KCMP)) + (size_t)bg * NCMPP * 128;
        f32x16 acc;
#pragma unroll
        for (int i = 0; i < 16; ++i) acc[i] = 0.f;
        const bf16_t* arow = src + (size_t)(16 * (i0 + r32)) * 512 + 8 * hi;
        const bf16_t* brow = w1t + (size_t)(32 * nt + r32) * 4096 + 8 * hi;
        for (int sb_ = 128 * kh; sb_ < 128 * kh + 128; sb_ += 16) {
            bf16x8 fa[16], fb[16];
#pragma unroll
            for (int u = 0; u < 16; ++u) { const int s2 = sb_ + u, j = s2 >> 3, d0 = (s2 & 7) * 16; fa[u] = *(const bf16x8*)(arow + (size_t)j * 512 + d0); fb[u] = *(const bf16x8*)(brow + 16 * s2); }
            __builtin_amdgcn_sched_barrier(0);
#pragma unroll
            for (int u = 0; u < 16; ++u) acc = __builtin_amdgcn_mfma_f32_32x32x16_bf16(fa[u], fb[u], acc, 0, 0, 0);
            __builtin_amdgcn_sched_barrier(0);
        }
        __syncthreads();
        if (kh == 1) {
#pragma unroll
            for (int q = 0; q < 16; ++q) *(LAS float*)(L + 16384 + ((nt * 16 + q) * 64 + lane) * 4) = acc[q];
        }
        __syncthreads();
        if (kh == 0) {
            const float* b1 = which ? p.pv_b1 : p.pk_b1; const int n = 32 * nt + r32;
            float cv = b1[n];
#pragma unroll
            for (int sl = 0; sl < 8; ++sl) cv += misc[MISC_CVP / 4 + (which * 8 + sl) * 128 + n];
#pragma unroll
            for (int q = 0; q < 16; ++q) { const float h = acc[q] + *(const LAS float*)(L + 16384 + ((nt * 16 + q) * 64 + lane) * 4) + cv;
                *(LAS bf16_t*)(L + crow(q, hi) * HRS + n * 2) = (bf16_t)f2bf(gelu_tanh(h)); }
        }
        __syncthreads();
        if (kh == 0) {
            f32x16 o;
#pragma unroll
            for (int i = 0; i < 16; ++i) o[i] = 0.f;
#pragma unroll
            for (int s2 = 0; s2 < 8; ++s2) { const bf16x8 a = *(const LAS bf16x8*)(L + r32 * HRS + 32 * s2 + 16 * hi);
                const bf16x8 bb = *(const bf16x8*)(w2t + (size_t)(32 * nt + r32) * 128 + 16 * s2 + 8 * hi);
                o = __builtin_amdgcn_mfma_f32_32x32x16_bf16(a, bb, o, 0, 0, 0); }
#pragma unroll
            for (int q = 0; q < 16; ++q) { const int i = i0 + crow(q, hi); dst[(size_t)i * 128 + 32 * nt + r32] = (bf16_t)(i < NCMP ? f2bf(o[q]) : 0u); }
        }
    }
}

namespace at {
constexpr int SHM = 16384, BUF = 38912;
constexpr int L_V = 0, L_K = 16384, L_WS = 32768, L_BIAS = 34816, L_V1 = 38912, L_K1 = 55296, L_SEL = 71680, L_Q = 72192, L_IMP = L_Q + 65536, L_GT = L_IMP + 16384, L_END = L_GT + 8 * 64 * 4 * 4;
constexpr float LOG2E = 1.4426950408889634f;
constexpr float SM_THR = 8.f;
#define KSWZ(row, colB) ((row) * 256 + ((colB) ^ (((row) & 15) << 4)))
#define SBAR() __builtin_amdgcn_sched_barrier(0)
__device__ __forceinline__ int v_rd_base(int lane) { return ((lane & 3) << 3) | (((lane >> 2) & 3) << 6) | (((lane >> 4) & 1) << 5) | (((lane >> 5) & 1) << 8); }
constexpr int v_rd_off(int d0, int ks, int half) { return d0 * 512 + ks * 4096 + half * 2048; }
typedef short s16x4 __attribute__((ext_vector_type(4)));
__device__ __forceinline__ unsigned cvtpk(float lo, float hi) { unsigned r; asm volatile("v_cvt_pk_bf16_f32 %0, %1, %2" : "=v"(r) : "v"(lo), "v"(hi)); return r; }
struct DmaMap { int kr0, kc0, kr1, kc1, vr0, vc0, vr1, vc1; };
__device__ __forceinline__ DmaMap dma_map(int tid) {
    DmaMap m;
    { const int P = tid * 16, row = P >> 8; m.kr0 = row; m.kc0 = ((((P & 255) >> 4) ^ (row & 15))) * 8; m.kr1 = row + 32; m.kc1 = m.kc0; }
    { const int P = tid * 16, st = P >> 9, w = (P & 511) >> 1, kk = (st >> 2) * 8 + (w >> 5); m.vr0 = (kk & ~0xC) | ((kk & 4) << 1) | ((kk & 8) >> 1); m.vc0 = (st & 3) * 32 + (w & 31); }
    { const int P = tid * 16 + 8192, st = P >> 9, w = (P & 511) >> 1, kk = (st >> 2) * 8 + (w >> 5); m.vr1 = (kk & ~0xC) | ((kk & 4) << 1) | ((kk & 8) >> 1); m.vc1 = (st & 3) * 32 + (w & 31); }
    return m;
}
template <int VAR = 0>
__device__ __forceinline__ void dma_k(LAS unsigned char* Lb, const DmaMap& m, const bf16_t* Kp, int ld, int wave) {
    if constexpr ((VAR & 16) != 0) return;
    int o0 = m.kr0 * ld + m.kc0, o1 = m.kr1 * ld + m.kc1; asm volatile("" : "+v"(o0), "+v"(o1));
    __builtin_amdgcn_global_load_lds((const unsigned*)(Kp + o0), (LAS unsigned*)(Lb + L_K + wave * 1024), 16, 0, 0);
    __builtin_amdgcn_global_load_lds((const unsigned*)(Kp + o1), (LAS unsigned*)(Lb + L_K + wave * 1024 + 8192), 16, 0, 0);
}
template <int VAR = 0>
__device__ __forceinline__ void dma_v(LAS unsigned char* Lb, const DmaMap& m, const bf16_t* Vp, int ld, int wave) {
    if constexpr ((VAR & 16) != 0) return;
    int o0 = m.vr0 * ld + m.vc0, o1 = m.vr1 * ld + m.vc1; asm volatile("" : "+v"(o0), "+v"(o1));
    __builtin_amdgcn_global_load_lds((const unsigned*)(Vp + o0), (LAS unsigned*)(Lb + L_V + wave * 1024), 16, 0, 0);
    __builtin_amdgcn_global_load_lds((const unsigned*)(Vp + o1), (LAS unsigned*)(Lb + L_V + wave * 1024 + 8192), 16, 0, 0);
}
#define TILE_SYNC() do { asm volatile("s_waitcnt vmcnt(0) lgkmcnt(0)" ::: "memory"); if constexpr ((VAR & 8) == 0) __builtin_amdgcn_s_barrier(); asm volatile("" ::: "memory"); } while (0)
__device__ __forceinline__ int next_bit(unsigned long long m, int from) {
    const unsigned long long m2 = from >= 64 ? 0ull : (m & (~0ull << from));
    return m2 ? (int)__builtin_ctzll(m2) : -1;
}
template <int VAR, bool NEAR>
__device__ __forceinline__ void qkt_(f32x16& p0, f32x16& p1, int kaddr, int r32, int hi, const bf16x8* qr, const LAS float* bp) {
    if constexpr (NEAR) {
#pragma unroll
        for (int r = 0; r < 16; ++r) { const int c = (r & 3) + 8 * (r >> 2); p0[r] = bp[63 - c]; p1[r] = bp[31 - c]; }
    }
    int ka[4];
#pragma unroll
    for (int dd = 0; dd < 4; ++dd) ka[dd] = kaddr + KSWZ(r32, (dd * 16 + hi * 8) * 2);
    const int h1 = 128 - ((r32 & 8) << 5);
    bf16x8 kA[2][2], kB[2][2];
#define KRD(dst, a, off) asm volatile("ds_read_b128 %0, %1 offset:%2" : "=&v"(dst) : "v"(a), "i"(off) : "memory")
#define LOADG(G, K_) do { _Pragma("unroll") for (int e = 0; e < 2; ++e) { const int d0 = 2 * (G) + e; KRD(K_[e][0], ka[d0 & 3], 0); KRD(K_[e][1], ka[d0 & 3], 8192); } } while (0)
#define MMA1(G, e, K_, C0, C1) do { p0 = __builtin_amdgcn_mfma_f32_32x32x16_bf16(K_[e][0], qr[2 * (G) + e], C0, 0, 0, 0); p1 = __builtin_amdgcn_mfma_f32_32x32x16_bf16(K_[e][1], qr[2 * (G) + e], C1, 0, 0, 0); } while (0)
#define LGK(N) asm volatile("s_waitcnt lgkmcnt(" #N ")" ::: "memory")
    const f32x16 z16 = {0.f, 0.f, 0.f, 0.f, 0.f, 0.f, 0.f, 0.f, 0.f, 0.f, 0.f, 0.f, 0.f, 0.f, 0.f, 0.f};
    LOADG(0, kA); LOADG(1, kB);
#pragma unroll
    for (int dd = 0; dd < 4; ++dd) ka[dd] += h1;
    LGK(4); SBAR();
    if constexpr (NEAR) MMA1(0, 0, kA, p0, p1); else MMA1(0, 0, kA, z16, z16);
    MMA1(0, 1, kA, p0, p1); SBAR();
    LOADG(2, kA); LGK(4); SBAR();
    MMA1(1, 0, kB, p0, p1); MMA1(1, 1, kB, p0, p1); SBAR();
    LOADG(3, kB); LGK(4); SBAR();
    MMA1(2, 0, kA, p0, p1); MMA1(2, 1, kA, p0, p1); SBAR();
    LGK(0); SBAR();
    MMA1(3, 0, kB, p0, p1); MMA1(3, 1, kB, p0, p1);
#undef LGK
#undef MMA1
#undef LOADG
#undef KRD
}
template <int VAR = 0>
__device__ __forceinline__ void qkt(f32x16& p0, f32x16& p1, const LAS unsigned char* Kl, int r32, int hi, const bf16x8* qr, bool near = false, const LAS float* bp = nullptr) {
    const int kaddr = (int)(size_t)Kl;
    if (near) qkt_<VAR, true>(p0, p1, kaddr, r32, hi, qr, bp); else qkt_<VAR, false>(p0, p1, kaddr, r32, hi, qr, bp);
}
__device__ __forceinline__ void pv_tile(f32x16* o, int vb0, bf16x8 pa0, bf16x8 pa1, bf16x8 pa2, bf16x8 pa3) {
#define TRRD(dst, off) asm volatile("ds_read_b64_tr_b16 %0, %1 offset:%2" : "=&v"(dst) : "v"(vb0), "i"(off) : "memory")
#define PV_RD(d0, X) do { constexpr int b_ = v_rd_off(d0, 0, 0); \
        TRRD(X[0], b_); TRRD(X[1], b_ + 2048); TRRD(X[2], b_ + 4096); TRRD(X[3], b_ + 6144); TRRD(X[4], b_ + 8192); TRRD(X[5], b_ + 10240); TRRD(X[6], b_ + 12288); TRRD(X[7], b_ + 14336); } while (0)
#define PV_MM(d0, X) do { \
        o[d0] = __builtin_amdgcn_mfma_f32_32x32x16_bf16(pa0, (bf16x8){X[0][0], X[0][1], X[0][2], X[0][3], X[1][0], X[1][1], X[1][2], X[1][3]}, o[d0], 0, 0, 0); \
        o[d0] = __builtin_amdgcn_mfma_f32_32x32x16_bf16(pa1, (bf16x8){X[2][0], X[2][1], X[2][2], X[2][3], X[3][0], X[3][1], X[3][2], X[3][3]}, o[d0], 0, 0, 0); \
        o[d0] = __builtin_amdgcn_mfma_f32_32x32x16_bf16(pa2, (bf16x8){X[4][0], X[4][1], X[4][2], X[4][3], X[5][0], X[5][1], X[5][2], X[5][3]}, o[d0], 0, 0, 0); \
        o[d0] = __builtin_amdgcn_mfma_f32_32x32x16_bf16(pa3, (bf16x8){X[6][0], X[6][1], X[6][2], X[6][3], X[7][0], X[7][1], X[7][2], X[7][3]}, o[d0], 0, 0, 0); } while (0)
#define LGK(N) asm volatile("s_waitcnt lgkmcnt(" #N ")" ::: "memory")
    s16x4 xa[8], xb[8];
    PV_RD(0, xa); PV_RD(1, xb);
    LGK(8); SBAR(); PV_MM(0, xa); SBAR(); PV_RD(2, xa);
    LGK(8); SBAR(); PV_MM(1, xb); SBAR(); PV_RD(3, xb);
    LGK(8); SBAR(); PV_MM(2, xa); SBAR();
    LGK(0); SBAR(); PV_MM(3, xb);
#undef LGK
#undef PV_MM
#undef PV_RD
#undef TRRD
}
__device__ __forceinline__ void bias_mask(f32x16& p0, f32x16& p1, int dq, unsigned W, bool needmask, int hi) {
    const float NEG = -__builtin_inff();
    const int dq4 = dq - 4 * hi;
    if (needmask) {
#pragma unroll
        for (int r = 0; r < 16; ++r) { const int c = (r & 3) + 8 * (r >> 2);
            if ((unsigned)(dq4 - c) >= W) p0[r] = NEG;
            if ((unsigned)(dq4 - c - 32) >= W) p1[r] = NEG; }
    }
}
__device__ __forceinline__ void bias_mask_cmp(f32x16& p0, f32x16& p1, int dq, int dd, const LAS float* blx, int hi, bool needbias, bool needmask) {
    const float NEG = -__builtin_inff();
    const int dq4 = dq - 4 * hi, dd4 = dd - 64 * hi;
    if (needbias) {
        float bv[16];
#pragma unroll
        for (int r = 0; r < 16; ++r) { const int c = (r & 3) + 8 * (r >> 2); bv[r] = blx[64 + ((dd4 - 16 * c) & 127)]; }
        SBAR();
#pragma unroll
        for (int r = 0; r < 16; ++r) { const int c = (r & 3) + 8 * (r >> 2); p0[r] += ((unsigned)(dd4 - 16 * c) < 128u) ? bv[r] : 0.f; }
        SBAR();
#pragma unroll
        for (int r = 0; r < 16; ++r) { const int c = (r & 3) + 8 * (r >> 2); bv[r] = blx[64 + ((dd4 - 16 * c - 512) & 127)]; }
        SBAR();
#pragma unroll
        for (int r = 0; r < 16; ++r) { const int c = (r & 3) + 8 * (r >> 2); p1[r] += ((unsigned)(dd4 - 16 * c - 512) < 128u) ? bv[r] : 0.f; }
    }
    if (needmask) {
#pragma unroll
        for (int r = 0; r < 16; ++r) { const int c = (r & 3) + 8 * (r >> 2);
            if (c > dq4) p0[r] = NEG;
            if (c + 32 > dq4) p1[r] = NEG; }
    }
}
template <int CTRL> __device__ __forceinline__ float quad_perm(float v) { return __uint_as_float((unsigned)__builtin_amdgcn_update_dpp(0, (int)__float_as_uint(v), CTRL, 0xF, 0xF, true)); }
__device__ __forceinline__ float rowmax32(const f32x16& p0, const f32x16& p1) {
    float pmax = p0[0];
#pragma unroll
    for (int r = 1; r < 16; ++r) pmax = fmaxf(pmax, p0[r]);
#pragma unroll
    for (int r = 0; r < 16; ++r) pmax = fmaxf(pmax, p1[r]);
    auto rr = __builtin_amdgcn_permlane32_swap(__float_as_uint(pmax), __float_as_uint(pmax), false, false);
    return fmaxf(__uint_as_float(rr[0]), __uint_as_float(rr[1]));
}
__device__ __forceinline__ float halfswap_add(float ps) {
    auto rr = __builtin_amdgcn_permlane32_swap(__float_as_uint(ps), __float_as_uint(ps), false, false);
    return __uint_as_float(rr[0]) + __uint_as_float(rr[1]);
}
#define EXP_PK4(P, B_, OUT) do { _Pragma("unroll") for (int e_ = 0; e_ < 8; ++e_) { P[B_ + e_] = (VAR & 1) ? fmaf(P[B_ + e_], LOG2E, mnL) : __builtin_amdgcn_exp2f(fmaf(P[B_ + e_], LOG2E, mnL)); ps += P[B_ + e_]; } \
        unsigned a0 = cvtpk(P[B_ + 0], P[B_ + 1]), a1 = cvtpk(P[B_ + 2], P[B_ + 3]); \
        unsigned b0 = cvtpk(P[B_ + 4], P[B_ + 5]), b1 = cvtpk(P[B_ + 6], P[B_ + 7]); \
        auto r0 = __builtin_amdgcn_permlane32_swap(a0, b0, false, false); auto r1 = __builtin_amdgcn_permlane32_swap(a1, b1, false, false); \
        u32x4 w = {r0[0], r1[0], r0[1], r1[1]}; OUT = *reinterpret_cast<bf16x8*>(&w); } while (0)
template <int VAR = 0>
__device__ __forceinline__ void sm_pv(f32x16& p0, f32x16& p1, float& m_reg, float& l_reg, f32x16* o, int vb, LAS float* al, int r32, int hi, bool rowsel = true) {
    const float pmax = rowsel ? rowmax32(p0, p1) : -__builtin_inff();
    float alpha = 1.f;
    if (!__all(pmax - m_reg <= SM_THR)) {
        const float mn = fmaxf(m_reg, pmax);
        alpha = __builtin_amdgcn_exp2f((m_reg - mn) * LOG2E); m_reg = mn;
        if (hi == 0) al[r32] = alpha; asm volatile("s_waitcnt lgkmcnt(0)" ::: "memory");
        float av[16];
#pragma unroll
        for (int r = 0; r < 16; ++r) av[r] = al[crow(r, hi)];
        SBAR();
#pragma unroll
        for (int d_ = 0; d_ < 4; ++d_)
#pragma unroll
            for (int r = 0; r < 16; ++r) o[d_][r] *= av[r]; }
    const float mnL = rowsel ? -m_reg * LOG2E : -__builtin_inff();
    float ps = 0.f;
    bf16x8 pa0, pa1, pa2, pa3;
    EXP_PK4(p0, 0, pa0); EXP_PK4(p0, 8, pa1); EXP_PK4(p1, 0, pa2); EXP_PK4(p1, 8, pa3);
    l_reg = l_reg * alpha + halfswap_add(ps);
    SBAR();
    if constexpr ((VAR & 2) == 0) pv_tile(o, vb, pa0, pa1, pa2, pa3);
    else { asm volatile("" :: "v"(pa0), "v"(pa1), "v"(pa2), "v"(pa3)); }
}
}

template <int VAR = 0>
__device__ __forceinline__ void nsa_fused(const Params& p, unsigned char* lds_g, bf16_t* O1, const int tidv) {
    using namespace at;
    LAS unsigned char* L = (LAS unsigned char*)lds_g;
    const int tid = tidv, lane = tid & 63, wave = __builtin_amdgcn_readfirstlane(tid >> 6), r32 = lane & 31, hi = lane >> 5;
    const bf16_t* Q1 = (const bf16_t*)(p.ws + WS_D); const bf16_t* KV = (const bf16_t*)(p.ws + WS_E); const bf16_t* Z1 = (const bf16_t*)(p.ws + WS_G);
    const float* GT = (const float*)(p.ws + WS_GATES); const bf16_t* KC = (const bf16_t*)(p.ws + WS_KCMP); const bf16_t* VC = (const bf16_t*)(p.ws + WS_VCMP);
    const float* biasp = (const float*)(p.ws + WS_MISC + MISC_BIASP);
    const size_t TS = (size_t)T * 512;
    LAS float* wsf = (LAS float*)(L + L_WS) + wave * 64;
    LAS float* blw = (LAS float*)(L + L_BIAS);
    LAS float* impS = (LAS float*)(L + L_IMP);
    LAS unsigned* totL = (LAS unsigned*)(L + L_Q) + wave * 2048 + lane;
    LAS unsigned long long* selS = (LAS unsigned long long*)(L + L_SEL);
    const int vb0 = (int)(size_t)(L + L_V) + v_rd_base(lane);
    const int hh = r32 & 3, tl = r32 >> 2;
    const LAS float* bl = blw + hh * 256;
    const DmaMap dm = dma_map(tid);
    const int G = gridDim.x;
    if (wave >= 4) __builtin_amdgcn_s_setprio(1);
    for (int it = blockIdx.x; it < 16 * 32; it += G) {
        int bg, y;
        if (G == 256) { const int xcd = it & 7, q = it >> 3; bg = (xcd * 2 + (q / 32)) & 15; y = q % 32; } else { bg = it / 32; y = it % 32; }
        const int b = bg >> 2, g = bg & 3;
        __syncthreads();
        for (int e = tid; e < 1024; e += 512) { const int d_ = (e & 255) - 64; blw[e] = (d_ >= 0 && d_ < 128) ? biasp[(g * 4 + (e >> 8)) * 128 + d_] : 0.f; }
        for (int pass = 0; pass < 2; ++pass) {
            const int x = pass ? 63 - y : y;
            const int t0 = 64 * x, t = t0 + 8 * wave + tl;
            const size_t row = (size_t)b * SEQ + t;
            const bf16_t* Kb = KV + ((size_t)b * SEQ) * 512 + g * 128;
            const bf16_t* KCb = KC + (size_t)bg * NCMPP * 128; const bf16_t* VCb = VC + (size_t)bg * NCMPP * 128;
            __syncthreads();
            dma_k<VAR>(L, dm, KCb, 128, wave);
            bf16x8 qr[8];
            int qlo_ = lane; asm volatile("" : "+v"(qlo_)); qlo_ = (qlo_ & 3) * 128 + (qlo_ >> 5) * 8;
#pragma unroll
            for (int d0 = 0; d0 < 8; ++d0) qr[d0] = *(const bf16x8*)(Q1 + row * DM + (g * 4) * 128 + qlo_ + d0 * 16);
            LAS float* gtS = (LAS float*)(L + L_GT) + (wave * 64 + lane) * 4;
            { const float* gp_ = GT + row * 48 + (g * 4 + hh) * 3; float gq_[3][4];
#pragma unroll
              for (int c_ = 0; c_ < 3; ++c_)
#pragma unroll
                  for (int k_ = 0; k_ < 4; ++k_) gq_[c_][k_] = gp_[(size_t)k_ * T * 48 + c_];
#pragma unroll
              for (int c_ = 0; c_ < 3; ++c_) gtS[c_] = sigmoidf_((gq_[c_][0] + gq_[c_][1]) + (gq_[c_][2] + gq_[c_][3])); }
            __builtin_amdgcn_s_waitcnt(0x0F70);
            f32x16 o[4]; f32x16 p0, p1; float m_reg, l_reg;
#define BRANCH_INIT() do { m_reg = -1e30f; l_reg = 0.f; _Pragma("unroll") for (int d_ = 0; d_ < 4; ++d_) _Pragma("unroll") for (int r = 0; r < 16; ++r) o[d_][r] = 0.f; } while (0)
#define BRANCH_END(cidx, FIRST) do { \
            if (hi == 0) { wsf[r32] = l_reg > 0.f ? gtS[cidx] / l_reg : 0.f; } \
            asm volatile("s_waitcnt lgkmcnt(0)" ::: "memory"); \
            _Pragma("unroll") for (int r = 0; r < 8; ++r) { const float sc0_ = wsf[crow(2 * r, hi)], sc1_ = wsf[crow(2 * r + 1, hi)]; \
                _Pragma("unroll") for (int d_ = 0; d_ < 4; ++d_) { const unsigned tp_ = (FIRST) ? 0u : totL[(d_ * 8 + r) * 64]; \
                    totL[(d_ * 8 + r) * 64] = cvtpk(__uint_as_float(tp_ << 16) + o[d_][2 * r] * sc0_, __uint_as_float(tp_ & 0xffff0000u) + o[d_][2 * r + 1] * sc1_); } } \
            asm volatile("s_waitcnt lgkmcnt(0)" ::: "memory"); } while (0)
            const int ncmp_t = (VAR & 128) ? 0 : (4 * x + 2) / 64 + 1;
            const int ic = (t - 31) >> 4;
            int buf = 0;
            BRANCH_INIT();
            TILE_SYNC();
            for (int tt = 0; tt < ncmp_t; ++tt) {
                LAS unsigned char* Lb = L + buf * BUF; LAS unsigned char* Ln = L + (buf ^ 1) * BUF;
                if (tt + 1 < ncmp_t) dma_k<VAR>(Ln, dm, KCb + (size_t)(tt + 1) * 64 * 128, 128, wave);
                else { dma_k<VAR>(Ln, dm, KCb, 128, wave); dma_v<VAR>(Ln, dm, VCb, 128, wave); }
                qkt<VAR>(p0, p1, Lb + L_K, r32, hi, qr);
                bias_mask_cmp(p0, p1, ic - 64 * tt, t - 31 - 1024 * tt, bl, hi, (t0 + 8 * wave - 31) - 16 * (64 * tt + 63) < 128, 64 * tt + 63 > ((t0 + 8 * wave - 31) >> 4));
                const float pmax = rowmax32(p0, p1); const float mn = fmaxf(m_reg, pmax); const float alpha = __builtin_amdgcn_exp2f((m_reg - mn) * LOG2E); m_reg = mn;
                const float mnL = -mn * LOG2E; float ps = 0.f;
#pragma unroll
                for (int r = 0; r < 16; ++r) { ps += __builtin_amdgcn_exp2f(fmaf(p0[r], LOG2E, mnL)); ps += __builtin_amdgcn_exp2f(fmaf(p1[r], LOG2E, mnL)); }
                l_reg = l_reg * alpha + halfswap_add(ps);
                TILE_SYNC(); buf ^= 1;
            }
            const float m_c = m_reg, l_c = l_reg, il_c = l_c > 0.f ? 1.f / l_c : 0.f; float imp_carry = 0.f;
            for (int tt = 0; tt < ncmp_t; ++tt) {
                LAS unsigned char* Lb = L + buf * BUF; LAS unsigned char* Ln = L + (buf ^ 1) * BUF;
                if (tt + 1 < ncmp_t) { dma_k<VAR>(Ln, dm, KCb + (size_t)(tt + 1) * 64 * 128, 128, wave); dma_v<VAR>(Ln, dm, VCb + (size_t)(tt + 1) * 64 * 128, 128, wave); }
                qkt<VAR>(p0, p1, Lb + L_K, r32, hi, qr);
                bias_mask_cmp(p0, p1, ic - 64 * tt, t - 31 - 1024 * tt, bl, hi, (t0 + 8 * wave - 31) - 16 * (64 * tt + 63) < 128, 64 * tt + 63 > ((t0 + 8 * wave - 31) >> 4));
                const float mnL = -m_c * LOG2E;
#pragma unroll
                for (int r = 0; r < 16; ++r) { p0[r] = __builtin_amdgcn_exp2f(fmaf(p0[r], LOG2E, mnL)); p1[r] = __builtin_amdgcn_exp2f(fmaf(p1[r], LOG2E, mnL)); }
                { float qa[8], xo[8];
#pragma unroll
                  for (int gq = 0; gq < 8; ++gq) { const int rb = (gq & 3) * 4;
                      float qs_ = gq < 4 ? (p0[rb] + p0[rb + 1]) + (p0[rb + 2] + p0[rb + 3]) : (p1[rb] + p1[rb + 1]) + (p1[rb + 2] + p1[rb + 3]);
                      float ls_ = gq < 4 ? p0[rb + 3] : p1[rb + 3];
                      qs_ *= il_c; ls_ *= il_c;
                      qs_ += quad_perm<0xB1>(qs_); qs_ += quad_perm<0x4E>(qs_); ls_ += quad_perm<0xB1>(ls_); ls_ += quad_perm<0x4E>(ls_);
                      qa[gq] = qs_; { auto rr_ = __builtin_amdgcn_permlane32_swap(__float_as_uint(ls_), __float_as_uint(ls_), false, false); xo[gq] = __uint_as_float(hi ? rr_[0] : rr_[1]); } }
#pragma unroll
                  for (int gq = 0; gq < 8; ++gq) { const float prev = hi ? xo[gq] : (gq ? xo[gq - 1] : imp_carry);
                      if (hh == 0) impS[(8 * wave + tl) * 64 + 16 * tt + 2 * gq + hi] = qa[gq] + prev; }
                  imp_carry = xo[7]; }
                bf16x8 pa0, pa1, pa2, pa3;
#define PK4(P, B_, OUT) do { unsigned a0 = cvtpk(P[B_ + 0], P[B_ + 1]), a1 = cvtpk(P[B_ + 2], P[B_ + 3]); \
        unsigned b0 = cvtpk(P[B_ + 4], P[B_ + 5]), b1 = cvtpk(P[B_ + 6], P[B_ + 7]); \
        auto r0 = __builtin_amdgcn_permlane32_swap(a0, b0, false, false); auto r1 = __builtin_amdgcn_permlane32_swap(a1, b1, false, false); \
        u32x4 w = {r0[0], r1[0], r0[1], r1[1]}; OUT = *reinterpret_cast<bf16x8*>(&w); } while (0)
                PK4(p0, 0, pa0); PK4(p0, 8, pa1); PK4(p1, 0, pa2); PK4(p1, 8, pa3); SBAR();
#undef PK4
                pv_tile(o, vb0 + buf * BUF, pa0, pa1, pa2, pa3);
                TILE_SYNC(); buf ^= 1;
            }
            l_reg = l_c;
            { LAS unsigned char* Lb = L + buf * BUF; dma_k<VAR>(Lb, dm, Kb + 2 * TS, 512, wave); dma_v<VAR>(Lb, dm, Kb + 3 * TS, 512, wave); }
            if (x < 16) { if (lane == 0) { for (int i = 0; i < 8; ++i) selS[8 * wave + i] = ~0ull; } }
            else {
                int ia = (8 * wave * 64 + lane) * 4; asm volatile("" : "+v"(ia));
                const LAS float* ip = (const LAS float*)((LAS unsigned char*)impS + ia);
                const int j = lane;
                const bool forced = (j == 0) || (j == x) || (j == x - 1), visible = j <= x;
                unsigned key[8], thr[8];
#pragma unroll
                for (int i = 0; i < 8; ++i) { const float imp = ip[i * 64];
                    key[i] = forced ? 0xffffffffu : (visible ? __float_as_uint(imp) + 1u : 0u); thr[i] = 0u; }
#pragma unroll 1
                for (int bit = 31; bit >= 0; --bit) {
#pragma unroll
                    for (int i = 0; i < 8; ++i) { const unsigned c = thr[i] | (1u << bit); if (__popcll(__ballot(key[i] >= c)) >= 16) thr[i] = c; } }
#pragma unroll
                for (int i = 0; i < 8; ++i) {
                    const unsigned long long gt = __ballot(key[i] > thr[i]), eq = __ballot(key[i] == thr[i]);
                    const int need = 16 - __popcll(gt);
                    const bool pick = (key[i] > thr[i]) || ((key[i] == thr[i]) && (__popcll(eq & ((1ull << j) - 1ull)) < need));
                    const unsigned long long mk = __ballot(pick);
                    if (lane == 0) selS[8 * wave + i] = mk; }
            }
            TILE_SYNC();
            unsigned long long um = 0ull, wm = 0ull;
            for (int i = 0; i < 64; ++i) { const unsigned long long v = selS[i]; um |= v; if ((i >> 3) == wave) wm |= v; }
            const unsigned long long mym = selS[8 * wave + tl];
            um &= (x >= 63) ? ~0ull : ((1ull << (x + 1)) - 1ull);
            um = ((unsigned long long)__builtin_amdgcn_readfirstlane((unsigned)(um >> 32)) << 32) | (unsigned)__builtin_amdgcn_readfirstlane((unsigned)um);
            wm = ((unsigned long long)__builtin_amdgcn_readfirstlane((unsigned)(wm >> 32)) << 32) | (unsigned)__builtin_amdgcn_readfirstlane((unsigned)wm);
            int j = 0;
            if constexpr ((VAR & 256) != 0) j = -1;
            BRANCH_END(0, true);
            BRANCH_INIT();
            TILE_SYNC();
            while (j >= 0) {
                LAS unsigned char* Lb = L + buf * BUF; LAS unsigned char* Ln = L + (buf ^ 1) * BUF;
                const int jn = next_bit(um, j + 1);
                if (jn >= 0) { dma_k<VAR>(Ln, dm, Kb + 2 * TS + (size_t)(64 * jn) * 512, 512, wave); dma_v<VAR>(Ln, dm, Kb + 3 * TS + (size_t)(64 * jn) * 512, 512, wave); }
                else { const int jl = (x >= 8 ? x - 8 : 0); dma_k<VAR>(Ln, dm, Kb + 4 * TS + (size_t)(64 * jl) * 512, 512, wave); dma_v<VAR>(Ln, dm, Kb + 5 * TS + (size_t)(64 * jl) * 512, 512, wave); }
                if ((wm >> j) & 1ull) {
                    qkt<VAR>(p0, p1, Lb + L_K, r32, hi, qr, j + 2 >= x, bl + (t - 64 * j - 4 * hi + 1));
                    bias_mask(p0, p1, t - 64 * j, 0x7fffffffu, j == x, hi);
                    sm_pv<VAR>(p0, p1, m_reg, l_reg, o, vb0 + buf * BUF, wsf, r32, hi, (mym >> j) & 1ull); }
                TILE_SYNC(); buf ^= 1;
                j = jn;
            }
            BRANCH_END(1, false);
            BRANCH_INIT();
            for (int jw = (x >= 8 ? x - 8 : 0); jw <= x && !(VAR & 512); ++jw) {
                LAS unsigned char* Lb = L + buf * BUF; LAS unsigned char* Ln = L + (buf ^ 1) * BUF;
                if (jw < x) { dma_k<VAR>(Ln, dm, Kb + 4 * TS + (size_t)(64 * (jw + 1)) * 512, 512, wave); dma_v<VAR>(Ln, dm, Kb + 5 * TS + (size_t)(64 * (jw + 1)) * 512, 512, wave); }
                qkt<VAR>(p0, p1, Lb + L_K, r32, hi, qr, jw + 2 >= x, bl + (t - 64 * jw - 4 * hi + 1));
                bias_mask(p0, p1, t - 64 * jw, 512u, jw == x || jw + 8 == x, hi);
                sm_pv<VAR>(p0, p1, m_reg, l_reg, o, vb0 + buf * BUF, wsf, r32, hi);
                TILE_SYNC(); buf ^= 1;
            }
            BRANCH_END(2, false);
            { LAS unsigned char* Tt = L + (wave < 4 ? 0 : BUF) + (wave & 3) * 8192;
              int te_ = t0 + 8 * wave; asm volatile("" : "+s"(te_));
              u32x4 zz[8], tt8[8]; size_t eo[8]; int ln_e = lane; asm volatile("" : "+v"(ln_e));
#pragma unroll
              for (int i = 0; i < 8; ++i) { const int idx = ln_e + 64 * i, rw = idx >> 4, ch = idx & 15;
                  eo[i] = ((size_t)b * SEQ + te_ + (rw >> 2)) * DM + (g * 4 + (rw & 3)) * 128 + 8 * ch;
                  zz[i] = *(const u32x4*)(Z1 + eo[i]); }
              __builtin_amdgcn_sched_barrier(0);
#pragma unroll
              for (int r = 0; r < 8; ++r)
#pragma unroll
                  for (int d_ = 0; d_ < 4; ++d_) { const unsigned tp_ = totL[(d_ * 8 + r) * 64];
                      *(LAS bf16_t*)(Tt + crow(2 * r, hi) * 256 + (32 * d_ + r32) * 2) = (bf16_t)(tp_ & 0xffffu); *(LAS bf16_t*)(Tt + crow(2 * r + 1, hi) * 256 + (32 * d_ + r32) * 2) = (bf16_t)(tp_ >> 16); }
              asm volatile("s_waitcnt lgkmcnt(0)" ::: "memory");
#pragma unroll
              for (int i = 0; i < 8; ++i) { const int idx = ln_e + 64 * i, rw = idx >> 4, ch = idx & 15; tt8[i] = *(const LAS u32x4*)(Tt + rw * 256 + ch * 16); }
              __builtin_amdgcn_sched_barrier(0);
#pragma unroll
              for (int i = 0; i < 8; ++i) { u32x4 w;
#define MULPK(T_, Z_) cvtpk(__uint_as_float((T_) << 16) * __uint_as_float((Z_) << 16), __uint_as_float((T_) & 0xffff0000u) * __uint_as_float((Z_) & 0xffff0000u))
                  w.x = MULPK(tt8[i].x, zz[i].x); w.y = MULPK(tt8[i].y, zz[i].y); w.z = MULPK(tt8[i].z, zz[i].z); w.w = MULPK(tt8[i].w, zz[i].w);
#undef MULPK
                  *(u32x4*)(O1 + eo[i]) = w; }
              asm volatile("s_waitcnt lgkmcnt(0)" ::: "memory"); }
#undef BRANCH_INIT
#undef BRANCH_END
        }
    }
    __builtin_amdgcn_s_setprio(0);
}

#define XB_TMO      128
#define XB_XCNT(j)  (256  + 64 * (j))
#define XB_XSUB(j)  (1280 + 64 * (j))
#define XB_XGEN(j)  (2304 + 64 * (j))
#define XB_TOP      3328
#define XB_TOPGEN   3392
#define XCD_BAR_WORDS 3456
#define XB_SPIN_CAP (1u << 22)
__device__ __forceinline__ unsigned xb_ld(unsigned* p)              { return __hip_atomic_load(p, __ATOMIC_RELAXED, __HIP_MEMORY_SCOPE_AGENT); }
__device__ __forceinline__ unsigned xb_add(unsigned* p, unsigned v) { return __hip_atomic_fetch_add(p, v, __ATOMIC_RELAXED, __HIP_MEMORY_SCOPE_AGENT); }
__device__ __forceinline__ unsigned xb_xcc_id() { return (unsigned)__builtin_amdgcn_s_getreg((3 << 11) | 20) & 0xFu; }
#define XB_SPIN(cond, bar) do { unsigned _sp = 0; while (cond) { __builtin_amdgcn_s_sleep(1); \
    if ((++_sp & 255u) == 0u) { if (xb_ld(&(bar)[XB_TMO])) break; if (_sp > XB_SPIN_CAP) { atomicAdd(&(bar)[XB_TMO], 1u); break; } } } } while (0)
struct XcdBarrier { unsigned* bar; unsigned x; volatile LAS unsigned* st; };
__device__ __forceinline__ XcdBarrier xcd_barrier_post(unsigned* bar, volatile LAS unsigned* st) {
    XcdBarrier b; b.bar = bar; b.x = xb_xcc_id(); b.st = st;
    if (threadIdx.x == 0) (void)xb_add(&bar[XB_XCNT(b.x)], 1u);
    return b;
}
__device__ __forceinline__ void xcd_barrier_complete(unsigned* bar, unsigned x, unsigned& nloc, unsigned& nx) {
    const unsigned G = gridDim.x * gridDim.y * gridDim.z;
    unsigned sum, cnt, mine, sp = 0u;
    for (;;) {
        sum = 0u; cnt = 0u; mine = 0u;
#pragma unroll
        for (unsigned j = 0; j < 16; ++j) { const unsigned c = xb_ld(&bar[XB_XCNT(j)]); sum += c; cnt += (c > 0u) ? 1u : 0u; mine = (j == x) ? c : mine; }
        if (sum == G) break;
        __builtin_amdgcn_s_sleep(1);
        if ((++sp & 255u) == 0u) { if (xb_ld(&bar[XB_TMO])) break; if (sp > XB_SPIN_CAP) { atomicAdd(&bar[XB_TMO], 1u); break; } }
    }
    nloc = mine > 0u ? mine : 1u; nx = cnt > 0u ? cnt : 1u;
}
__device__ __forceinline__ void xcd_barrier(const XcdBarrier& b, const int tidv) {
    asm volatile("s_waitcnt vmcnt(0)" ::: "memory");
    __syncthreads();
    if (tidv == 0) {
        unsigned* bar = b.bar;
        __builtin_amdgcn_s_waitcnt(0);
        unsigned nloc = b.st[0], nx = b.st[1];
        if (nloc == 0u) { xcd_barrier_complete(bar, b.x, nloc, nx); b.st[0] = nloc; b.st[1] = nx; }
        const unsigned old = xb_add(&bar[XB_XSUB(b.x)], 1u);
        const unsigned gen = old / nloc;
        if (old + 1u == (gen + 1u) * nloc) {
            __builtin_amdgcn_fence(__ATOMIC_RELEASE, "agent");
            asm volatile("s_waitcnt vmcnt(0)" ::: "memory");
            const unsigned og = xb_add(&bar[XB_TOP], 1u);
            const unsigned tg = og / nx;
            if (og + 1u == (tg + 1u) * nx) xb_add(&bar[XB_TOPGEN], 1u);
            else XB_SPIN(xb_ld(&bar[XB_TOPGEN]) == tg, bar);
            __builtin_amdgcn_fence(__ATOMIC_ACQUIRE, "agent");
            xb_add(&bar[XB_XGEN(b.x)], 1u);
            asm volatile("s_waitcnt vmcnt(0)" ::: "memory");
        } else {
            XB_SPIN(xb_ld(&bar[XB_XGEN(b.x)]) == gen, bar);
            __builtin_amdgcn_fence(__ATOMIC_ACQUIRE, "agent");
            asm volatile("s_waitcnt vmcnt(0)" ::: "memory");
        }
    }
    __syncthreads();
}

constexpr int NPHASE = 11;
__global__ void __launch_bounds__(512, 2) mk_fwd(Params p) {
    extern __shared__ __attribute__((aligned(16))) unsigned char lds[];
    cg::grid_group grid = cg::this_grid();
    const int lo = p.ph_lo, hi = p.ph_hi;
    PG8_LAS unsigned char* ldsl = (PG8_LAS unsigned char*)lds;
    unsigned char* ws = p.ws;
    bf16_t* A = (bf16_t*)(ws + WS_A);
    if (threadIdx.x < 4) ((LAS unsigned*)((LAS unsigned char*)lds + LDS_BYTES - 16))[threadIdx.x] = 0u;
    __syncthreads();
    XcdBarrier xbar = xcd_barrier_post((unsigned*)(p.ws + WS_BAR), (volatile LAS unsigned*)((LAS unsigned char*)lds + LDS_BYTES - 16));
#define IN(k) (lo <= (k) && (k) < hi)
#define SEAM(k) do { if (IN(k) && IN((k) + 1)) xcd_barrier(xbar, tidv); } while (0)
    if (p.ws == nullptr) grid.sync();
#define RUN(k, BODY) do { if (IN(k)) { BODY; } if (PROBE_REP == (k)) { xcd_barrier(xbar, tidv); BODY; } SEAM(k); } while (0)
#define GEMM_PHASE(EPI, BT, N_, ...) do { pg8::Gemm g{A, (const bf16_t*)(ws + (BT)), T, (N_), DM}; pg8::StaticOrder S; S.init(T, (N_), gridDim.x, blockIdx.x); \
        pg8::EPI E{__VA_ARGS__}; pg8::gemm_phase<pg8::EPI, pg8::StaticOrder, true, true>(ldsl, g, S, E, tidv); } while (0)
    const int wv_s = __builtin_amdgcn_readfirstlane(threadIdx.x >> 6);
    int tidv = threadIdx.x;
    RUN(0, (p0_prep(p, lds), rows_rms16(p.x, p.norm_gains, A, tidv)));
#if !MK_SKEL
    RUN(1, GEMM_PHASE(EpiHgrnIn, WS_W0IN, N0IN, ws, p.out, (const float*)(ws + WS_MISC + MISC_LB)));
#if HGRN_NAIVE
    RUN(2, hgrn_naive(p, lds));
#else
    RUN(2, hgrn_chunk4(p, lds));
#if PROBE_REP == 21
    xcd_barrier(xbar, tidv); hgrn_chunk3<1>(p, lds);
#elif PROBE_REP == 22
    xcd_barrier(xbar, tidv); hgrn_chunk3<2>(p, lds);
#endif
#endif
    if (gridDim.x != 256) { RUN(3, hgrn_headnorm(p)); }
    RUN(4, ({ pg8::Gemm g{A, (const bf16_t*)(ws + WS_W0OUT), T, DM, DM}; pg8::StaticOrder S; S.init(T, DM, gridDim.x, blockIdx.x);
        pg8::EpiResidInit<true, true> E{p.x, (bf16_t*)(ws + WS_B), (float*)(ws + WS_SSQ)}; pg8::gemm_phase<pg8::EpiResidInit<true, true>, pg8::StaticOrder, true, true>(ldsl, g, S, E, tidv); }));
    RUN(6, ({ pg8::Gemm g{(const bf16_t*)(ws + WS_B), (const bf16_t*)(ws + WS_W1IN), T, N1PAD, DM}; pg8::SplitTailOrder S; S.init(T, N1PAD - 256, gridDim.x, blockIdx.x);
        pg8::EpiNsaIn E{ws, (float*)(ws + WS_GATES), ldsl, (const float*)(ws + WS_SSQ)}; pg8::gemm_phase<pg8::EpiNsaIn, pg8::SplitTailOrder, true, true>(ldsl, g, S, E, tidv); }));
#if NSA_NAIVE
    RUN(7, compress_naive(p, lds));
    RUN(8, nsa_naive(p, lds, A));
#else
    RUN(7, compress_mfma(p, lds));
#if NSA_DIFF
    if (IN(8)) { bf16_t* OA = (bf16_t*)(ws + WS_W0IN); nsa_naive(p, lds, OA); grid.sync(); nsa_fused(p, lds, A, tidv); grid.sync();
        for (size_t e = (size_t)blockIdx.x * 512 + threadIdx.x; e < (size_t)T * DM; e += (size_t)gridDim.x * 512) { const float a = bf2f(A[e]), r = bf2f(OA[e]); A[e] = (bf16_t)f2bf(a + NSA_AMP * (a - r)); } } SEAM(8);
#else
    tidv = wv_s * 64 + (int)__builtin_amdgcn_mbcnt_hi(~0u, __builtin_amdgcn_mbcnt_lo(~0u, 0u));
    RUN(8, nsa_fused(p, lds, A, tidv));
#ifdef PROBE_VAR
    if (IN(9)) { tidv = wv_s * 64 + (int)__builtin_amdgcn_mbcnt_hi(~0u, __builtin_amdgcn_mbcnt_lo(~0u, 0u)); nsa_fused<PROBE_VAR>(p, lds, (bf16_t*)(ws + WS_W0IN), tidv);
        tidv = wv_s * 64 + (int)__builtin_amdgcn_mbcnt_hi(~0u, __builtin_amdgcn_mbcnt_lo(~0u, 0u)); xcd_barrier(xbar, tidv); }
#endif
#endif
#endif
    RUN(9, GEMM_PHASE(EpiResidInit<false>, WS_W1OUT, DM, (const bf16_t*)(ws + WS_B), (bf16_t*)(ws + WS_B)));
    RUN(10, rows_rms_b<false>((const bf16_t*)(ws + WS_B), p.final_gain, p.out, tidv));
#else
    for (int k = 1; k < 10; ++k) { SEAM(k); }
    if (IN(10)) { rows_rms_f32(p.x, p.final_gain, p.out, tidv); }
#endif
#undef IN
#undef SEAM
#undef RUN
#undef GEMM_PHASE
}

extern "C" void kernel_launch(void* const* d_in, const int* in_sizes, int n_in, void* d_out, int out_size, void* d_ws, size_t ws_size, hipStream_t stream) {
    static int grid = 0;
    if (grid == 0) {
        if (n_in != 18 || in_sizes[0] != T * DM || out_size != T * DM || ws_size < WS_END) {
            fprintf(stderr, "kernel_launch: unexpected shapes (n_in %d, in0 %d, out %d, ws %zu)\n", n_in, n_in > 0 ? in_sizes[0] : -1, out_size, ws_size); grid = -1; return; }
        int dev = 0, cus = 0, per_cu = 0;
        if (hipGetDevice(&dev) != hipSuccess || hipDeviceGetAttribute(&cus, hipDeviceAttributeMultiprocessorCount, dev) != hipSuccess) { grid = -1; return; }
        if (hipFuncSetAttribute((const void*)mk_fwd, hipFuncAttributeMaxDynamicSharedMemorySize, LDS_BYTES) != hipSuccess) { fprintf(stderr, "kernel_launch: hipFuncSetAttribute failed\n"); grid = -1; return; }
        if (hipOccupancyMaxActiveBlocksPerMultiprocessor(&per_cu, (const void*)mk_fwd, 512, LDS_BYTES) != hipSuccess || per_cu < 1) { fprintf(stderr, "kernel_launch: occupancy query says %d\n", per_cu); per_cu = 1; }
        (void)hipGetLastError();
        grid = cus;
    }
    if (grid < 0) return;
    Params p{};
    p.x = (const float*)d_in[0]; p.norm_gains = (const float*)d_in[1]; p.final_gain = (const float*)d_in[2]; p.rel_bias = (const float*)d_in[3]; p.hgrn_lb = (const float*)d_in[4];
    p.hgrn_w_in = (const float*)d_in[5]; p.hgrn_head_gain = (const float*)d_in[6]; p.hgrn_w_out = (const float*)d_in[7]; p.nsa_w_in = (const float*)d_in[8];
    p.pe_k = (const float*)d_in[9]; p.pe_v = (const float*)d_in[10]; p.pk_w1 = (const float*)d_in[11]; p.pk_b1 = (const float*)d_in[12]; p.pk_w2 = (const float*)d_in[13];
    p.pv_w1 = (const float*)d_in[14]; p.pv_b1 = (const float*)d_in[15]; p.pv_w2 = (const float*)d_in[16]; p.nsa_w_out = (const float*)d_in[17];
    p.out = (float*)d_out; p.ws = (unsigned char*)d_ws;
#if MK_MULTI
    for (int k = 0; k < NPHASE; ++k) { p.ph_lo = k; p.ph_hi = k + 1; hipLaunchKernelGGL(mk_fwd, dim3(grid), dim3(512), LDS_BYTES, stream, p); }
#else
    p.ph_lo = 0; p.ph_hi = NPHASE;
    if (hipMemsetAsync((unsigned char*)d_ws + WS_BAR, 0, BAR_BYTES, stream) != hipSuccess) { fprintf(stderr, "kernel_launch: memset of the barrier words failed\n"); return; }
    void* args[] = {&p};
    hipError_t e = hipLaunchCooperativeKernel((const void*)mk_fwd, dim3(grid), dim3(512), args, LDS_BYTES, stream);
    if (e != hipSuccess) fprintf(stderr, "kernel_launch: cooperative launch failed: %s (grid %d)\n", hipGetErrorString(e), grid);
#endif
}
```

```cpp
#include <hip/hip_runtime.h>
#include <hip/hip_cooperative_groups.h>
#include <cstdio>
#include <cstdint>
namespace cg = cooperative_groups;

#ifndef MK_SKEL
#define MK_SKEL 0
#endif
#ifndef HGRN_NAIVE
#define HGRN_NAIVE 0
#endif
#ifndef NSA_NAIVE
#define NSA_NAIVE 0
#endif
#ifndef NSA_DIFF
#define NSA_DIFF 0
#endif
#define NSA_AMP 64.f
#ifndef PROBE_REP
#define PROBE_REP -1
#endif
#ifndef MK_MULTI
constexpr bool LOGF_L2 = true;
#define MK_MULTI 0
#endif

#define LAS __attribute__((address_space(3)))
typedef unsigned short bf16_t;
typedef short bf16x8 __attribute__((ext_vector_type(8)));
typedef float f32x4 __attribute__((ext_vector_type(4)));
typedef float f32x2 __attribute__((ext_vector_type(2)));
typedef unsigned u32x4 __attribute__((ext_vector_type(4)));
typedef unsigned u32x2 __attribute__((ext_vector_type(2)));
typedef _Float16 f16x8 __attribute__((ext_vector_type(8)));
typedef _Float16 f16x4 __attribute__((ext_vector_type(4)));

constexpr int NB = 4, SEQ = 4096, T = NB * SEQ, DM = 2048;
constexpr int NH = 16, HD = 128, NG = 4;
constexpr int N0IN = 8192;
constexpr int N1IN = 7216, N1PAD = 7424;
constexpr int NCMP = 255, NCMPP = 256;
constexpr float RMS_EPS = 1e-6f;
constexpr float QSCALE = 0.08838834764831845f;

constexpr size_t MiB = 1u << 20;
constexpr size_t WS_A = 0;
constexpr size_t WS_B = 64 * MiB;
constexpr size_t WS_D = 192 * MiB;
constexpr size_t WS_E = 256 * MiB;
constexpr size_t WS_G = 352 * MiB;
constexpr size_t WS_SSQ = 160 * MiB;
constexpr size_t WS_W0IN = 416 * MiB;
constexpr size_t WS_W0OUT = 448 * MiB;
constexpr size_t WS_W1IN = 456 * MiB;
constexpr size_t WS_W1OUT = 486 * MiB;
constexpr size_t WS_GATES = 128 * MiB;
constexpr size_t WS_KCMP = 497 * MiB;
constexpr size_t WS_VCMP = 498 * MiB;
constexpr size_t WS_MISC = 499 * MiB;
constexpr size_t WS_W1K = 500 * MiB;
constexpr size_t WS_W1V = 501 * MiB;
constexpr size_t WS_W2K = 502 * MiB;
constexpr size_t WS_W2V = 502 * MiB + 65536;
constexpr size_t WS_BAR = 503 * MiB;
constexpr size_t BAR_BYTES = 16384;
constexpr size_t WS_END = 504 * MiB;
constexpr size_t MISC_LB = 0, MISC_BIASP = 8192, MISC_CVP = 16384;

constexpr int LDS_BYTES = 160 * 1024;

struct Params {
    const float* x; const float* norm_gains; const float* final_gain; const float* rel_bias; const float* hgrn_lb;
    const float* hgrn_w_in; const float* hgrn_head_gain; const float* hgrn_w_out; const float* nsa_w_in;
    const float* pe_k; const float* pe_v; const float* pk_w1; const float* pk_b1; const float* pk_w2;
    const float* pv_w1; const float* pv_b1; const float* pv_w2; const float* nsa_w_out;
    float* out; unsigned char* ws;
    int ph_lo, ph_hi;
};

__device__ __forceinline__ float bf2f(bf16_t b) { return __uint_as_float(((unsigned)b) << 16); }
__device__ __forceinline__ unsigned f2bf(float f) { unsigned u = __float_as_uint(f); return (u + 0x7fffu + ((u >> 16) & 1u)) >> 16; }
__device__ __forceinline__ unsigned pk2(float lo, float hi) { return f2bf(lo) | (f2bf(hi) << 16); }
__device__ __forceinline__ float wave_sum(float v) {
#pragma unroll
    for (int o = 1; o < 64; o <<= 1) v += __shfl_xor(v, o);
    return v;
}
__device__ __forceinline__ float wave_max(float v) {
#pragma unroll
    for (int o = 1; o < 64; o <<= 1) v = fmaxf(v, __shfl_xor(v, o));
    return v;
}
__device__ __forceinline__ float sigmoidf_(float x) { return __builtin_amdgcn_rcpf(1.f + __expf(-x)); }
__device__ __forceinline__ float gate_of(const float* g) { return sigmoidf_((g[0] + g[(size_t)T * 48]) + (g[(size_t)2 * T * 48] + g[(size_t)3 * T * 48])); }
#define LDS_WAIT() asm volatile("s_waitcnt lgkmcnt(0)" ::: "memory")
#define LDS_BARRIER() do { asm volatile("s_waitcnt lgkmcnt(0)" ::: "memory"); __builtin_amdgcn_s_barrier(); asm volatile("" ::: "memory"); } while (0)

template <int CTRL> __device__ __forceinline__ float quad_x(float v) { return __uint_as_float((unsigned)__builtin_amdgcn_update_dpp(0, (int)__float_as_uint(v), CTRL, 0xF, 0xF, true)); }
__device__ __forceinline__ float lane_x16(float v, int sel) { auto r = __builtin_amdgcn_permlane16_swap(__float_as_uint(v), __float_as_uint(v), false, false); return __uint_as_float((sel & 1) ? r[0] : r[1]); }
__device__ __forceinline__ float lane_x32(float v, int sel) { auto r = __builtin_amdgcn_permlane32_swap(__float_as_uint(v), __float_as_uint(v), false, false); return __uint_as_float((sel & 2) ? r[0] : r[1]); }
namespace pg8 {
#define PG8_LAS __attribute__((address_space(3)))
constexpr int BM = 256, BK = 64, HALF = 128, HTB = HALF * BK * 2, STAGE_BYTES = 8 * HTB, NXCD = 8, WGM = 8;
__host__ __device__ __forceinline__ int lds_byte(int r, int c) { const int st = (r >> 4) * 2 + (c >> 5), rr = r & 15, cc = c & 31, ob = rr * 64 + cc * 2; return st * 1024 + (ob ^ (((ob >> 9) & 1) << 5)); }
__host__ __device__ __forceinline__ void stage_rc(int b, int& R, int& C) { const int st = b / 1024, sb = b % 1024, swz = sb ^ (((sb >> 9) & 1) << 5); R = (st >> 1) * 16 + swz / 64; C = (st & 1) * 32 + (swz % 64) / 2; }
__host__ __device__ __forceinline__ int perm32(int rho) { const int n = rho >> 4, i = rho & 15; return 8 * (i >> 2) + 4 * n + (i & 3); }
struct Unit { int pm, pn, ks; };
struct Gemm { const bf16_t* A; const bf16_t* Bt; int M, N, K; };
struct StaticOrder {
    int nM, nN, nwg, G, c;
    __host__ __device__ void init(int M, int N, int G_, int c_) { nM = M / BM; nN = N / BM; nwg = nM * nN; G = G_; c = c_; }
    __host__ __device__ bool next(int i, Unit& u) const {
        const long L = (long)i * G + c; if (L >= nwg) return false;
        int wgid = (int)L; { const int q = nwg / NXCD, r = nwg % NXCD, xcd = wgid % NXCD, off = wgid / NXCD; wgid = (xcd < r ? xcd * (q + 1) : r * (q + 1) + (xcd - r) * q) + off; }
        const int nig = WGM * nN, gid = wgid / nig, fm = gid * WGM, gsz = (nM - fm) < WGM ? (nM - fm) : WGM;
        u.pm = fm + ((wgid % nig) % gsz); u.pn = (wgid % nig) / gsz; u.ks = 0; return true;
    }
    __device__ __forceinline__ int nt(const Unit&, int ntf) const { return ntf; }
    __device__ __forceinline__ size_t kbytes(const Unit&, int) const { return 0; }
    __device__ __forceinline__ void a_ready(const Unit&) const {}
    __device__ __forceinline__ void done(const Unit&) const {}
};
struct SplitTailOrder {
    StaticOrder so;
    __host__ __device__ void init(int M, int Nfull, int G_, int c_) { so.init(M, Nfull, G_, c_); }
    __host__ __device__ bool next(int i, Unit& u) const {
        const long L = (long)i * so.G + so.c;
        if (L < so.nwg) return so.next(i, u);
        const int idx = (int)(L - so.nwg); if (idx >= so.nM * 4) return false;
        u.pm = idx >> 2; u.pn = so.nN; u.ks = idx & 3; return true;
    }
    __device__ __forceinline__ int nt(const Unit& u, int ntf) const { return u.pn == so.nN ? (ntf >> 2) : ntf; }
    __device__ __forceinline__ size_t kbytes(const Unit& u, int K) const { return u.pn == so.nN ? (size_t)u.ks * (size_t)(K >> 2) * 2 : 0; }
    __device__ __forceinline__ void a_ready(const Unit&) const {}
    __device__ __forceinline__ void done(const Unit&) const {}
};
__device__ __forceinline__ unsigned cvt_pk_bf16(float lo, float hi) { unsigned r; asm volatile("v_cvt_pk_bf16_f32 %0, %1, %2" : "=v"(r) : "v"(lo), "v"(hi)); return r; }


struct EpiHgrnIn {
    static constexpr bool PERM = true, AFTER_DRAIN = false, INIT = false, ROWSCALE = false;
    unsigned char* ws; float* LOGF; const float* lb;
    __device__ __forceinline__ void operator()(const f32x4 (&acc)[2][2][4][2], const Unit& u, int wr, int wc, int fr, int fq) const {
        const int row0 = u.pm * BM + wr * 64 + fr, sect = u.pn >> 3, col0 = (u.pn & 7) * BM + wc * 32 + 8 * fq;
        if (sect == 1) {
            f32x4 lbv[2][2];
#pragma unroll
            for (int bj = 0; bj < 2; ++bj)
#pragma unroll
                for (int n = 0; n < 2; ++n) lbv[bj][n] = *(const f32x4*)(lb + col0 + bj * HALF + 4 * n);
#pragma unroll
            for (int ai = 0; ai < 2; ++ai)
#pragma unroll
                for (int m = 0; m < 4; ++m) { _Float16* rowp = (_Float16*)LOGF + (size_t)(row0 + ai * HALF + m * 16) * DM + col0;
#pragma unroll
                    for (int bj = 0; bj < 2; ++bj) { f16x8 o;
#pragma unroll
                        for (int n = 0; n < 2; ++n) { const f32x4 x = acc[ai][bj][m][n], l = lbv[bj][n];
#pragma unroll
                            for (int e = 0; e < 4; ++e) { const float sg = sigmoidf_(x[e]); o[4 * n + e] = (_Float16)(LOGF_L2 ? __log2f(l[e] + (1.f - l[e]) * sg) : __logf(l[e] + (1.f - l[e]) * sg)); } }
                        *(f16x8*)(rowp + bj * HALF) = o; } }
        } else {
            const size_t boff = sect == 0 ? WS_B : (sect == 2 ? WS_B + 64 * MiB : WS_D);
            bf16_t* base = (bf16_t*)(ws + boff);
#pragma unroll
            for (int ai = 0; ai < 2; ++ai)
#pragma unroll
                for (int m = 0; m < 4; ++m) { bf16_t* rowp = base + (size_t)(row0 + ai * HALF + m * 16) * DM + col0;
#pragma unroll
                    for (int bj = 0; bj < 2; ++bj) { f32x4 v0 = acc[ai][bj][m][0], v1 = acc[ai][bj][m][1];
                        if (sect == 0) { v0 = v0 * QSCALE; v1 = v1 * QSCALE; }
                        u32x4 w; w.x = cvt_pk_bf16(v0[0], v0[1]); w.y = cvt_pk_bf16(v0[2], v0[3]); w.z = cvt_pk_bf16(v1[0], v1[1]); w.w = cvt_pk_bf16(v1[2], v1[3]);
                        *(u32x4*)(rowp + bj * HALF) = w; } }
        }
    }
};
template <bool RF32>
struct EpiResidT {
    static constexpr bool PERM = true, AFTER_DRAIN = false, INIT = false, ROWSCALE = false;
    const void* R; bf16_t* O;
    __device__ __forceinline__ void operator()(const f32x4 (&acc)[2][2][4][2], const Unit& u, int wr, int wc, int fr, int fq) const {
        const int row0 = u.pm * BM + wr * 64 + fr, col0 = u.pn * BM + wc * 32 + 8 * fq;
#pragma unroll
        for (int ai = 0; ai < 2; ++ai) { f32x4 rv[4][2][RF32 ? 2 : 1];
#pragma unroll
            for (int m = 0; m < 4; ++m) { const size_t off = (size_t)(row0 + ai * HALF + m * 16) * DM + col0;
#pragma unroll
                for (int bj = 0; bj < 2; ++bj) {
                    if constexpr (RF32) { rv[m][bj][0] = *(const f32x4*)((const float*)R + off + bj * HALF); rv[m][bj][1] = *(const f32x4*)((const float*)R + off + bj * HALF + 4); }
                    else rv[m][bj][0] = *(const f32x4*)((const bf16_t*)R + off + bj * HALF); } }
            __builtin_amdgcn_sched_barrier(0);
#pragma unroll
            for (int m = 0; m < 4; ++m) { const size_t off = (size_t)(row0 + ai * HALF + m * 16) * DM + col0;
#pragma unroll
                for (int bj = 0; bj < 2; ++bj) { f32x4 r0, r1;
                    if constexpr (RF32) { r0 = rv[m][bj][0]; r1 = rv[m][bj][1]; }
                    else { const f32x4 q = rv[m][bj][0]; const unsigned a = __float_as_uint(q.x), b = __float_as_uint(q.y), c = __float_as_uint(q.z), d = __float_as_uint(q.w);
                        r0 = (f32x4){__uint_as_float(a << 16), __uint_as_float(a & 0xffff0000u), __uint_as_float(b << 16), __uint_as_float(b & 0xffff0000u)};
                        r1 = (f32x4){__uint_as_float(c << 16), __uint_as_float(c & 0xffff0000u), __uint_as_float(d << 16), __uint_as_float(d & 0xffff0000u)}; }
                    const f32x4 v0 = r0 + acc[ai][bj][m][0], v1 = r1 + acc[ai][bj][m][1];
                    u32x4 w; w.x = cvt_pk_bf16(v0[0], v0[1]); w.y = cvt_pk_bf16(v0[2], v0[3]); w.z = cvt_pk_bf16(v1[0], v1[1]); w.w = cvt_pk_bf16(v1[2], v1[3]);
                    *(u32x4*)(O + off + bj * HALF) = w; } }
            __builtin_amdgcn_sched_barrier(0); }
    }
};
template <bool RF32, bool SSQ = false>
struct EpiResidInit {
    static constexpr bool PERM = true, AFTER_DRAIN = false, INIT = true, ROWSCALE = false;
    const void* R; bf16_t* O; float* SS = nullptr;
    __device__ __forceinline__ void init(f32x4 (&acc)[2][2][4][2], const Unit& u, int wr, int wc, int fr, int fq) const {
        const int row0 = u.pm * BM + wr * 64 + fr, col0 = u.pn * BM + wc * 32 + 8 * fq;
#pragma unroll
        for (int ai = 0; ai < 2; ++ai)
#pragma unroll
            for (int m = 0; m < 4; ++m) { const size_t off = (size_t)(row0 + ai * HALF + m * 16) * DM + col0;
#pragma unroll
                for (int bj = 0; bj < 2; ++bj) {
                    if constexpr (RF32) { acc[ai][bj][m][0] = *(const f32x4*)((const float*)R + off + bj * HALF); acc[ai][bj][m][1] = *(const f32x4*)((const float*)R + off + bj * HALF + 4); }
                    else { const f32x4 q = *(const f32x4*)((const bf16_t*)R + off + bj * HALF); const unsigned a = __float_as_uint(q.x), b = __float_as_uint(q.y), c = __float_as_uint(q.z), d = __float_as_uint(q.w);
                        acc[ai][bj][m][0] = (f32x4){__uint_as_float(a << 16), __uint_as_float(a & 0xffff0000u), __uint_as_float(b << 16), __uint_as_float(b & 0xffff0000u)};
                        acc[ai][bj][m][1] = (f32x4){__uint_as_float(c << 16), __uint_as_float(c & 0xffff0000u), __uint_as_float(d << 16), __uint_as_float(d & 0xffff0000u)}; } } }
    }
    __device__ __forceinline__ void operator()(const f32x4 (&acc)[2][2][4][2], const Unit& u, int wr, int wc, int fr, int fq) const {
        const int row0 = u.pm * BM + wr * 64 + fr, col0 = u.pn * BM + wc * 32 + 8 * fq;
#pragma unroll
        for (int ai = 0; ai < 2; ++ai)
#pragma unroll
            for (int m = 0; m < 4; ++m) { const size_t off = (size_t)(row0 + ai * HALF + m * 16) * DM + col0; float ss = 0.f;
#pragma unroll
                for (int bj = 0; bj < 2; ++bj) { const f32x4 v0 = acc[ai][bj][m][0], v1 = acc[ai][bj][m][1];
                    if constexpr (SSQ) ss += ((v0[0] * v0[0] + v0[1] * v0[1]) + (v0[2] * v0[2] + v0[3] * v0[3])) + ((v1[0] * v1[0] + v1[1] * v1[1]) + (v1[2] * v1[2] + v1[3] * v1[3]));
                    u32x4 w; w.x = cvt_pk_bf16(v0[0], v0[1]); w.y = cvt_pk_bf16(v0[2], v0[3]); w.z = cvt_pk_bf16(v1[0], v1[1]); w.w = cvt_pk_bf16(v1[2], v1[3]);
                    *(u32x4*)(O + off + bj * HALF) = w; }
                if constexpr (SSQ) { ss += lane_x16(ss, fq); ss += lane_x32(ss, fq);
                    if (fq == 0) SS[(size_t)(row0 + ai * HALF + m * 16) * 32 + u.pn * 4 + wc] = ss; } }
    }
};
struct EpiNsaIn {
    static constexpr bool PERM = true, AFTER_DRAIN = false, INIT = false, ROWSCALE = true;
    unsigned char* ws; float* GT; PG8_LAS unsigned char* ldsb; const float* SS;
    static constexpr int RS_OFF = STAGE_BYTES;
    __device__ __forceinline__ void load_rowscale(int pm, int tid) const {
        asm volatile("s_waitcnt lgkmcnt(0)" ::: "memory"); __builtin_amdgcn_s_barrier();
        if (tid < BM) { const f32x4* pp = (const f32x4*)(SS + (size_t)(pm * BM + tid) * 32); f32x4 a = pp[0];
#pragma unroll
            for (int i = 1; i < 8; ++i) a += pp[i];
            ((PG8_LAS float*)(ldsb + RS_OFF))[tid] = rsqrtf(((a.x + a.y) + (a.z + a.w)) * (1.f / DM) + RMS_EPS); }
        asm volatile("s_waitcnt lgkmcnt(0)" ::: "memory"); __builtin_amdgcn_s_barrier();
    }
    __device__ __forceinline__ void operator()(const f32x4 (&acc)[2][2][4][2], const Unit& u, int wr, int wc, int fr, int fq) const {
        const int row0 = u.pm * BM + wr * 64 + fr, pn = u.pn, cl = wc * 32 + 8 * fq;
        if (pn == 28) {
#pragma unroll
            for (int ai = 0; ai < 2; ++ai)
#pragma unroll
                for (int m = 0; m < 4; ++m) { float* rowp = GT + ((size_t)u.ks * T + (size_t)(row0 + ai * HALF + m * 16)) * 48;
                    const float r_ = ((const PG8_LAS float*)(ldsb + RS_OFF))[wr * 64 + fr + ai * HALF + m * 16];
                    if (cl < 48) {
#pragma unroll
                        for (int n = 0; n < 2; ++n) *(f32x4*)(rowp + cl + 4 * n) = acc[ai][0][m][n] * r_; } }
            return;
        }
        size_t boff; int ld, colb; int mode = 0;
        if (pn < 8) { boff = WS_D; ld = DM; colb = pn * BM; mode = 1; }
        else if (pn < 20) { const int idx = pn - 8; boff = WS_E + (size_t)(idx >> 1) * ((size_t)T * 512 * 2); ld = 512; colb = (idx & 1) * BM; }
        else { boff = WS_G; ld = DM; colb = (pn - 20) * BM; mode = 2; }
        bf16_t* base = (bf16_t*)(ws + boff);
#pragma unroll
        for (int ai = 0; ai < 2; ++ai)
#pragma unroll
            for (int m = 0; m < 4; ++m) { bf16_t* rowp = base + (size_t)(row0 + ai * HALF + m * 16) * ld + colb + cl;
                const float r0_ = ((const PG8_LAS float*)(ldsb + RS_OFF))[wr * 64 + fr + ai * HALF + m * 16], r_ = mode == 1 ? r0_ * QSCALE : r0_;
#pragma unroll
                for (int bj = 0; bj < 2; ++bj) { f32x4 v0 = acc[ai][bj][m][0] * r_, v1 = acc[ai][bj][m][1] * r_;
                    if (mode == 2) {
#pragma unroll
                        for (int e = 0; e < 4; ++e) { v0[e] = v0[e] * sigmoidf_(v0[e]); v1[e] = v1[e] * sigmoidf_(v1[e]); } }
                    u32x4 w; w.x = cvt_pk_bf16(v0[0], v0[1]); w.y = cvt_pk_bf16(v0[2], v0[3]); w.z = cvt_pk_bf16(v1[0], v1[1]); w.w = cvt_pk_bf16(v1[2], v1[3]);
                    *(u32x4*)(rowp + bj * HALF) = w; } }
    }
};

template <class Epi, class Sched, bool ALIGN_EPI = false, bool SP2 = false>
__device__ __forceinline__ void gemm_phase(PG8_LAS unsigned char* lds, const Gemm g, const Sched& S, const Epi& E, const int tidv) {
    const int tid = tidv, wid = __builtin_amdgcn_readfirstlane(tid >> 6), lane = tid & 63, wr = wid >> 2, wc = wid & 3, fr = lane & 15, fq = lane >> 4;
    const int K = g.K, nt = K / BK;
    unsigned voffA[2], voffB[2];
#pragma unroll
    for (int i = 0; i < 2; ++i) { int R, C; stage_rc(tid * 16 + i * 8192, R, C); const int Rb = Epi::PERM ? ((R & ~31) + perm32(R & 31)) : R;
        voffA[i] = (unsigned)(R * K + C) * 2u; voffB[i] = (unsigned)(Rb * K + C) * 2u; }
    const size_t kstep = (size_t)(BK * 2);
    const size_t hstep = (size_t)HALF * K * 2;
    const size_t tstep = 2 * hstep;
    const unsigned ldsw = (unsigned)wid * 1024u;
    const int aoff = lds_byte(wr * 64 + fr, fq * 8), boff = lds_byte(wc * 32 + fr, fq * 8);
#define PG8_SA(b, h) (((b) * 2 + (h)) * HTB)
#define PG8_SB(b, h) ((4 + (b) * 2 + (h)) * HTB)
#define PG8_STAGE(bufoff, gbase, voff) do { _Pragma("unroll") for (int _i = 0; _i < 2; ++_i) \
        __builtin_amdgcn_global_load_lds((const unsigned*)((const char*)(gbase) + (voff)[_i]), (PG8_LAS unsigned*)(lds + (bufoff) + ldsw + _i * 8192), 16, 0, 0); } while (0)
#define PG8_LDA(dst, b, h) do { _Pragma("unroll") for (int m = 0; m < 4; ++m) _Pragma("unroll") for (int k = 0; k < 2; ++k) dst[m][k] = *(const PG8_LAS bf16x8*)(lds + PG8_SA(b, h) + aoff + m * 2048 + k * 1024); } while (0)
#define PG8_LDB(dst, b, h) do { _Pragma("unroll") for (int n = 0; n < 2; ++n) _Pragma("unroll") for (int k = 0; k < 2; ++k) dst[n][k] = *(const PG8_LAS bf16x8*)(lds + PG8_SB(b, h) + boff + n * 2048 + k * 1024); } while (0)
#define PG8_MMA(ai, bj, At, Bt) do { __builtin_amdgcn_s_setprio(1); _Pragma("unroll") for (int m = 0; m < 4; ++m) _Pragma("unroll") for (int n = 0; n < 2; ++n) _Pragma("unroll") for (int k = 0; k < 2; ++k) \
        acc[ai][bj][m][n] = __builtin_amdgcn_mfma_f32_16x16x32_bf16(Bt[n][k], At[m][k], acc[ai][bj][m][n], 0, 0, 0); __builtin_amdgcn_s_setprio(0); } while (0)
#define PG8_WAIT_V(n) asm volatile("s_waitcnt vmcnt(" #n ")" ::: "memory")
#define PG8_WAIT_L(n) asm volatile("s_waitcnt lgkmcnt(" #n ")" ::: "memory")
#define PG8_BAR __builtin_amdgcn_s_barrier()
#define PG8_SCHED __builtin_amdgcn_sched_barrier(0)
    Unit cur, nxt; int ui = 0;
    if (!S.next(0, cur)) return;
    f32x4 acc[2][2][4][2];
    if constexpr (Epi::ROWSCALE) E.load_rowscale(cur.pm, tid);
    if constexpr (Epi::INIT) E.init(acc, cur, wr, wc, fr, fq);
    else {
#pragma unroll
    for (int a = 0; a < 2; ++a)
#pragma unroll
        for (int b = 0; b < 2; ++b)
#pragma unroll
            for (int m = 0; m < 4; ++m)
#pragma unroll
                for (int n = 0; n < 2; ++n) acc[a][b][m][n] = (f32x4){0.f, 0.f, 0.f, 0.f};
    }
    bf16x8 At[4][2], B0[2][2], B1[2][2];
    const char* cA = (const char*)g.A + (size_t)cur.pm * tstep + S.kbytes(cur, K); const char* cB = (const char*)g.Bt + (size_t)cur.pn * tstep + S.kbytes(cur, K);
    S.a_ready(cur);
    if constexpr (SP2) {
        PG8_STAGE(PG8_SB(0, 0), cB, voffB); PG8_STAGE(PG8_SB(0, 1), cB + hstep, voffB); PG8_STAGE(PG8_SA(0, 0), cA, voffA); PG8_STAGE(PG8_SA(0, 1), cA + hstep, voffA);
        if (wr == 1) PG8_BAR;
        PG8_WAIT_V(2); PG8_BAR;
        PG8_STAGE(PG8_SB(1, 0), cB + kstep, voffB); PG8_STAGE(PG8_SA(1, 0), cA + kstep, voffA); PG8_STAGE(PG8_SB(1, 1), cB + hstep + kstep, voffB);
        PG8_WAIT_V(6); PG8_BAR;
    } else {
        PG8_STAGE(PG8_SB(0, 0), cB, voffB); PG8_STAGE(PG8_SA(0, 0), cA, voffA); PG8_STAGE(PG8_SB(0, 1), cB + hstep, voffB); PG8_STAGE(PG8_SA(0, 1), cA + hstep, voffA);
        if (wr == 1) PG8_BAR;
        PG8_WAIT_V(4); PG8_BAR;
        PG8_STAGE(PG8_SB(1, 0), cB + kstep, voffB); PG8_STAGE(PG8_SA(1, 0), cA + kstep, voffA); PG8_STAGE(PG8_SB(1, 1), cB + hstep + kstep, voffB);
        PG8_WAIT_V(6); PG8_BAR;
    }
    for (;;) {
        const bool has_next = S.next(ui + 1, nxt);
        const char* nA = has_next ? (const char*)g.A + (size_t)nxt.pm * tstep + S.kbytes(nxt, K) : cA; const char* nB = has_next ? (const char*)g.Bt + (size_t)nxt.pn * tstep + S.kbytes(nxt, K) : cB;
        const int ntc = S.nt(cur, nt);
        for (int t = 0; t < ntc; t += 2) {
            const bool last = (t == ntc - 2);
            const char* a1 = cA + (size_t)(t + 1) * kstep;
            const char* a2 = last ? nA : cA + (size_t)(t + 2) * kstep; const char* b2 = last ? nB : cB + (size_t)(t + 2) * kstep;
            const char* a3 = a2 + kstep; const char* b3 = b2 + kstep;
            if (last && has_next) S.a_ready(nxt);
            if constexpr (SP2) {
            PG8_LDB(B0, 0, 0); PG8_LDB(B1, 0, 1); PG8_SCHED; PG8_LDA(At, 0, 0); PG8_STAGE(PG8_SA(1, 1), a1 + hstep, voffA);
            PG8_WAIT_V(8); PG8_WAIT_L(0); PG8_BAR; PG8_MMA(0, 0, At, B0); PG8_MMA(0, 1, At, B1); PG8_BAR; PG8_SCHED;
            PG8_LDA(At, 0, 1); PG8_STAGE(PG8_SB(0, 0), b2, voffB); PG8_STAGE(PG8_SB(0, 1), b2 + hstep, voffB); PG8_STAGE(PG8_SA(0, 0), a2, voffA);
            PG8_WAIT_V(8); PG8_WAIT_L(0); PG8_BAR; PG8_MMA(1, 0, At, B0); PG8_MMA(1, 1, At, B1); PG8_BAR; PG8_SCHED;
            PG8_LDB(B0, 1, 0); PG8_LDB(B1, 1, 1); PG8_SCHED; PG8_LDA(At, 1, 0); PG8_STAGE(PG8_SA(0, 1), a2 + hstep, voffA);
            PG8_WAIT_V(8); PG8_WAIT_L(0); PG8_BAR; PG8_MMA(0, 0, At, B0); PG8_MMA(0, 1, At, B1); PG8_BAR; PG8_SCHED;
            PG8_LDA(At, 1, 1); PG8_STAGE(PG8_SB(1, 0), b3, voffB); PG8_STAGE(PG8_SB(1, 1), b3 + hstep, voffB); PG8_STAGE(PG8_SA(1, 0), a3, voffA);
            PG8_WAIT_V(8); PG8_WAIT_L(0); PG8_BAR; PG8_MMA(1, 0, At, B0); PG8_MMA(1, 1, At, B1); PG8_BAR; PG8_SCHED;
            } else {
            PG8_LDB(B0, 0, 0); PG8_SCHED; PG8_LDA(At, 0, 0); PG8_STAGE(PG8_SA(1, 1), a1 + hstep, voffA);
            PG8_WAIT_L(8); PG8_BAR; PG8_WAIT_L(0); PG8_MMA(0, 0, At, B0); PG8_BAR; PG8_SCHED;
            PG8_LDB(B1, 0, 1); PG8_STAGE(PG8_SB(0, 0), b2, voffB);
            PG8_BAR; PG8_WAIT_L(0); PG8_MMA(0, 1, At, B1); PG8_BAR;
            PG8_LDA(At, 0, 1); PG8_STAGE(PG8_SA(0, 0), a2, voffA);
            PG8_BAR; PG8_WAIT_L(0); PG8_MMA(1, 0, At, B0); PG8_BAR; PG8_SCHED;
            PG8_STAGE(PG8_SB(0, 1), b2 + hstep, voffB);
            PG8_WAIT_V(6); PG8_BAR; PG8_MMA(1, 1, At, B1); PG8_BAR;
            PG8_LDB(B0, 1, 0); PG8_SCHED; PG8_LDA(At, 1, 0); PG8_STAGE(PG8_SA(0, 1), a2 + hstep, voffA);
            PG8_WAIT_L(8); PG8_BAR; PG8_WAIT_L(0); PG8_MMA(0, 0, At, B0); PG8_BAR; PG8_SCHED;
            PG8_LDB(B1, 1, 1); PG8_STAGE(PG8_SB(1, 0), b3, voffB);
            PG8_BAR; PG8_WAIT_L(0); PG8_MMA(0, 1, At, B1); PG8_BAR;
            PG8_LDA(At, 1, 1); PG8_STAGE(PG8_SA(1, 0), a3, voffA);
            PG8_BAR; PG8_WAIT_L(0); PG8_MMA(1, 0, At, B0); PG8_BAR; PG8_SCHED;
            PG8_STAGE(PG8_SB(1, 1), b3 + hstep, voffB);
            PG8_WAIT_V(6); PG8_BAR; PG8_MMA(1, 1, At, B1); PG8_BAR;
            }
        }
        if constexpr (ALIGN_EPI) { if (wr == 0) PG8_BAR; }
        if constexpr (!Epi::AFTER_DRAIN) { E(acc, cur, wr, wc, fr, fq); S.done(cur); }
        if (!has_next) break;
        if constexpr (Epi::ROWSCALE) { if (nxt.pm != cur.pm) E.load_rowscale(nxt.pm, tid); }
        if constexpr (Epi::INIT) E.init(acc, nxt, wr, wc, fr, fq);
        else {
#pragma unroll
        for (int a = 0; a < 2; ++a)
#pragma unroll
            for (int b = 0; b < 2; ++b)
#pragma unroll
                for (int m = 0; m < 4; ++m)
#pragma unroll
                    for (int n = 0; n < 2; ++n) acc[a][b][m][n] = (f32x4){0.f, 0.f, 0.f, 0.f};
        }
        cur = nxt; cA = nA; cB = nB; ++ui;
        if constexpr (ALIGN_EPI) { if (wr == 1) PG8_BAR; }
    }
    PG8_WAIT_V(0);
    if constexpr (!ALIGN_EPI) { if (wr == 0) PG8_BAR; }
    PG8_BAR;
#undef PG8_SA
#undef PG8_SB
#undef PG8_STAGE
#undef PG8_LDA
#undef PG8_LDB
#undef PG8_MMA
#undef PG8_WAIT_V
#undef PG8_WAIT_L
#undef PG8_BAR
#undef PG8_SCHED
}
}

__device__ __forceinline__ int t5_bucket(int n) {
    if (n < 16) return n;
    const int large = 16 + (int)(logf((float)n / 16.f) / 2.0794415416798357f * 16.f);
    return large < 31 ? large : 31;
}
template <class ColMap>
__device__ __forceinline__ void transpose_item(const float* W, int Nsrc, int K, bf16_t* WT, LAS float* scr, int kb, int nb, int lane, ColMap cm, const float* kgain = nullptr, int kmask = -1) {
    const int k0 = 64 * kb, n0 = 32 * nb;
    const int kq = lane >> 3, n4 = 4 * (lane & 7);
    const int nsrc = cm(n0 + n4);
    f32x4 wv[8];
#pragma unroll
    for (int i = 0; i < 8; ++i) wv[i] = nsrc >= 0 ? *(const f32x4*)(W + (size_t)(k0 + 8 * i + kq) * Nsrc + nsrc) : (f32x4){0.f, 0.f, 0.f, 0.f};
    if (kgain != nullptr) {
#pragma unroll
        for (int i = 0; i < 8; ++i) wv[i] = wv[i] * kgain[(k0 + 8 * i + kq) & kmask]; }
#pragma unroll
    for (int i = 0; i < 8; ++i) { LAS float* d = scr + (8 * i + kq) * 33 + n4; d[0] = wv[i].x; d[1] = wv[i].y; d[2] = wv[i].z; d[3] = wv[i].w; }
    LDS_WAIT(); asm volatile("" ::: "memory");
    const int c = lane & 7;
#pragma unroll
    for (int j = 0; j < 4; ++j) { const int n = (lane >> 3) + 8 * j; const LAS float* s = scr + (8 * c) * 33 + n;
        u32x4 o; o.x = pk2(s[0 * 33], s[1 * 33]); o.y = pk2(s[2 * 33], s[3 * 33]); o.z = pk2(s[4 * 33], s[5 * 33]); o.w = pk2(s[6 * 33], s[7 * 33]);
        *(u32x4*)(WT + (size_t)(n0 + n) * K + k0 + 8 * c) = o; }
    LDS_WAIT(); asm volatile("" ::: "memory");
}
struct CmIdent { __device__ __forceinline__ int operator()(int n) const { return n; } };
struct CmNsaIn { __device__ __forceinline__ int operator()(int n) const { return n < 5120 ? n : (n < 7168 ? n + 48 : (n < N1IN ? n - 2048 : -1)); } };

__device__ __forceinline__ void rms_row_bf16(const float* xrow, const float* gain, bf16_t* orow, int lane) {
    const f32x4* xr = (const f32x4*)xrow + lane; const f32x4* gr = (const f32x4*)gain + lane;
    f32x4 v[8]; float s = 0.f;
#pragma unroll
    for (int j = 0; j < 8; ++j) { v[j] = xr[64 * j]; s += (v[j].x * v[j].x + v[j].y * v[j].y) + (v[j].z * v[j].z + v[j].w * v[j].w); }
    const float r = rsqrtf(wave_sum(s) * (1.f / DM) + RMS_EPS);
    u32x2* o8 = (u32x2*)orow + lane;
#pragma unroll
    for (int j = 0; j < 8; ++j) { const f32x4 g = gr[64 * j]; u32x2 w; w.x = pk2(v[j].x * r * g.x, v[j].y * r * g.y); w.y = pk2(v[j].z * r * g.z, v[j].w * r * g.w); o8[64 * j] = w; }
}
__device__ __forceinline__ void rms_row_f32(const float* xrow, const float* gain, float* orow, int lane) {
    const f32x4* xr = (const f32x4*)xrow + lane; const f32x4* gr = (const f32x4*)gain + lane;
    f32x4 v[8]; float s = 0.f;
#pragma unroll
    for (int j = 0; j < 8; ++j) { v[j] = xr[64 * j]; s += (v[j].x * v[j].x + v[j].y * v[j].y) + (v[j].z * v[j].z + v[j].w * v[j].w); }
    const float r = rsqrtf(wave_sum(s) * (1.f / DM) + RMS_EPS);
    f32x4* o = (f32x4*)orow + lane;
#pragma unroll
    for (int j = 0; j < 8; ++j) { const f32x4 g = gr[64 * j]; o[64 * j] = v[j] * r * g; }
}

__device__ __forceinline__ void p0_prep(const Params& p, unsigned char* lds_g) {
    const int tid = threadIdx.x, lane = tid & 63, wave = tid >> 6, G = gridDim.x, bx = blockIdx.x;
    const int gw = bx * 8 + wave, NGW = G * 8;
    float* misc = (float*)(p.ws + WS_MISC);
    if (bx == 0) {
        for (int c = tid; c < DM; c += 512) { const float a = p.hgrn_lb[c], b = p.hgrn_lb[DM + c], d = p.hgrn_lb[2 * DM + c]; const float m = fmaxf(a, fmaxf(b, d));
            const float ea = expf(a - m), eb = expf(b - m), ed = expf(d - m); misc[MISC_LB / 4 + c] = ea / (ea + eb + ed); }
    }
    if (bx == 1 % G) {
        for (int e = tid; e < NH * 128; e += 512) { const int head = e >> 7, dist = e & 127; misc[MISC_BIASP / 4 + e] = p.rel_bias[t5_bucket(dist) * NH + head] - p.rel_bias[31 * NH + head]; }
    }
    if (bx >= 2 && bx < 18 && G >= 18) {
        const int which = (bx - 2) >> 3, slice = (bx - 2) & 7;
        const float* pe = which ? p.pe_v : p.pe_k; const float* w1 = which ? p.pv_w1 : p.pk_w1;
        float* red = (float*)lds_g;
        const int n = tid & 127, part = tid >> 7; float s = 0.f;
        const int r0 = slice * 512 + part * 128;
#pragma unroll 16
        for (int r = r0; r < r0 + 128; ++r) s += pe[r] * w1[(size_t)r * 128 + n];
        __syncthreads(); red[part * 128 + n] = s; __syncthreads();
        if (tid < 128) misc[MISC_CVP / 4 + (which * 8 + slice) * 128 + tid] = (red[tid] + red[128 + tid]) + (red[256 + tid] + red[384 + tid]);
        __syncthreads();
    }
    LAS float* scr = (LAS float*)((LAS unsigned char*)lds_g + 4096 + wave * 8704);
    constexpr int I0IN = 32 * (N0IN / 32), IOUT = 32 * (DM / 32), I1IN = 32 * (N1PAD / 32);
    constexpr int IW1 = (4096 / 64) * (128 / 32), IW2 = (128 / 64) * (128 / 32);
    constexpr int NITEMS = I0IN + IOUT + I1IN + IOUT + 2 * IW1 + 2 * IW2;
    for (int it = gw; it < NITEMS; it += NGW) {
        int r = it;
        if (r < I0IN) { transpose_item(p.hgrn_w_in, N0IN, DM, (bf16_t*)(p.ws + WS_W0IN), scr, r / (N0IN / 32), r % (N0IN / 32), lane, CmIdent()); continue; } r -= I0IN;
        if (r < IOUT) { transpose_item(p.hgrn_w_out, DM, DM, (bf16_t*)(p.ws + WS_W0OUT), scr, r / (DM / 32), r % (DM / 32), lane, CmIdent(), p.hgrn_head_gain, HD - 1); continue; } r -= IOUT;
        if (r < I1IN) { transpose_item(p.nsa_w_in, N1IN, DM, (bf16_t*)(p.ws + WS_W1IN), scr, r / (N1PAD / 32), r % (N1PAD / 32), lane, CmNsaIn(), p.norm_gains + DM); continue; } r -= I1IN;
        if (r < IOUT) { transpose_item(p.nsa_w_out, DM, DM, (bf16_t*)(p.ws + WS_W1OUT), scr, r / (DM / 32), r % (DM / 32), lane, CmIdent()); continue; } r -= IOUT;
        if (r < IW1) { transpose_item(p.pk_w1, 128, 4096, (bf16_t*)(p.ws + WS_W1K), scr, r / 4, r % 4, lane, CmIdent()); continue; } r -= IW1;
        if (r < IW1) { transpose_item(p.pv_w1, 128, 4096, (bf16_t*)(p.ws + WS_W1V), scr, r / 4, r % 4, lane, CmIdent()); continue; } r -= IW1;
        if (r < IW2) { transpose_item(p.pk_w2, 128, 128, (bf16_t*)(p.ws + WS_W2K), scr, r / 4, r % 4, lane, CmIdent()); continue; } r -= IW2;
        transpose_item(p.pv_w2, 128, 128, (bf16_t*)(p.ws + WS_W2V), scr, r / 4, r % 4, lane, CmIdent());
    }
}

__device__ __forceinline__ void hgrn_naive(const Params& p, unsigned char* lds_g) {
    const int tid = threadIdx.x;
    const bf16_t* Q0 = (const bf16_t*)(p.ws + WS_B); const bf16_t* V0 = (const bf16_t*)(p.ws + WS_B + 64 * MiB);
    const float* LOGF = p.out; bf16_t* O0 = (bf16_t*)(p.ws + WS_E);
    float* qs = (float*)lds_g; float* fs = qs + 16 * 128; float* part = fs + 16 * 128;
    const int v = tid & 127, kq = tid >> 7;
    for (int unit = blockIdx.x; unit < NB * NH; unit += gridDim.x) {
        const int b = unit / NH, h = unit % NH;
        float S[32];
#pragma unroll
        for (int i = 0; i < 32; ++i) S[i] = 0.f;
        for (int t0 = 0; t0 < SEQ; t0 += 16) {
            __syncthreads();
            for (int e = tid; e < 2048; e += 512) { const int tt = e >> 7, k = e & 127; const size_t idx = (size_t)(b * SEQ + t0 + tt) * DM + h * HD + k;
                qs[e] = bf2f(Q0[idx]); fs[e] = __expf(LOGF[idx]); }
            __syncthreads();
            for (int tt = 0; tt < 16; ++tt) {
                const float vv = bf2f(V0[(size_t)(b * SEQ + t0 + tt) * DM + h * HD + v]);
                float o = 0.f;
#pragma unroll
                for (int kk = 0; kk < 32; ++kk) { const float f = fs[tt * 128 + kq * 32 + kk]; S[kk] = f * S[kk] + (1.f - f) * vv; o += S[kk] * qs[tt * 128 + kq * 32 + kk]; }
                part[(tt * 4 + kq) * 128 + v] = o;
            }
            __syncthreads();
            for (int e = tid; e < 2048; e += 512) { const int tt = e >> 7, vx = e & 127;
                const float o = (part[(tt * 4 + 0) * 128 + vx] + part[(tt * 4 + 1) * 128 + vx]) + (part[(tt * 4 + 2) * 128 + vx] + part[(tt * 4 + 3) * 128 + vx]);
                O0[(size_t)(b * SEQ + t0 + tt) * DM + h * HD + vx] = (bf16_t)f2bf(o); }
        }
    }
}
typedef float f32x16 __attribute__((ext_vector_type(16)));
__device__ __forceinline__ int crow(int r, int hi) { return (r & 3) + 8 * (r >> 2) + 4 * hi; }
namespace hg {
constexpr int RS = 272, RS2 = 144;
constexpr int QS = 0, QD = 17408, KS = 34816, KST = 52224, VT = 70656, PP = 75264, SOP0 = 84480, SOP1 = 93184, SEGT = 101888, VEC = 105984;
}
__device__ __forceinline__ u32x2 pack4bf(float a, float b, float c, float d) { u32x2 w; w.x = pg8::cvt_pk_bf16(a, b); w.y = pg8::cvt_pk_bf16(c, d); return w; }
__device__ __forceinline__ void hgrn_chunk(const Params& p, unsigned char* lds_g) {
    using namespace hg;
    LAS unsigned char* L = (LAS unsigned char*)lds_g;
    const int tid = threadIdx.x, lane = tid & 63, wave = __builtin_amdgcn_readfirstlane(tid >> 6), r32 = lane & 31, hi = lane >> 5;
    const bf16_t* Q0 = (const bf16_t*)(p.ws + WS_B); const bf16_t* V0 = (const bf16_t*)(p.ws + WS_B + 64 * MiB);
    const float* LOGF = p.out; bf16_t* O0 = (bf16_t*)(p.ws + WS_E);
    const int vs = tid >> 3, vv4 = (tid & 7) * 4;
    for (int unit = blockIdx.x; unit < 256; unit += gridDim.x) {
        const int bh = unit & 63, c4 = unit >> 6, b = bh >> 4, h = bh & 15;
        const size_t rowb = (size_t)b * SEQ; const int colb = h * HD;
        f32x16 S;
#pragma unroll
        for (int i = 0; i < 16; ++i) S[i] = 0.f;
        __syncthreads();
        for (int e = tid; e < (SOP1 - SOP0) / 4; e += 512) ((LAS unsigned*)(L + SOP0))[e] = 0u;
        int cur = 0;
        f32x2 lf[8]; unsigned qv[8]; u32x2 vraw;
#pragma unroll
        for (int i = 0; i < 8; ++i) { const size_t idx = (rowb + 8 * wave + i) * DM + colb + 2 * lane; lf[i] = *(const f32x2*)(LOGF + idx); qv[i] = *(const unsigned*)(Q0 + idx); }
        vraw = *(const u32x2*)(V0 + (rowb + vs) * DM + colb + c4 * 32 + vv4);
        for (int c = 0; c < 64; ++c) {
            float c0[8], c1[8]; float s0 = 0.f, s1 = 0.f;
#pragma unroll
            for (int i = 0; i < 8; ++i) { s0 += lf[i].x; c0[i] = s0; s1 += lf[i].y; c1[i] = s1; }
            *(LAS f32x2*)(L + SEGT + (wave * 128 + 2 * lane) * 4) = (f32x2){s0, s1};
            LDS_BARRIER();
            float pre0 = 0.f, pre1 = 0.f, br0 = 0.f, br1 = 0.f, bl0 = 0.f, bl1 = 0.f;
#pragma unroll
            for (int w = 0; w < 8; ++w) { const f32x2 v = *(const LAS f32x2*)(L + SEGT + (w * 128 + 2 * lane) * 4);
                if (w < wave) { pre0 += v.x; pre1 += v.y; } if (w < 4) { br0 += v.x; br1 += v.y; } bl0 += v.x; bl1 += v.y; }
            const float er0 = __expf(br0), er1 = __expf(br1);
            if (wave == 0) { *(LAS f32x2*)(L + VEC + (2 * lane) * 4) = (f32x2){__expf(bl0 - br0), __expf(bl1 - br1)}; *(LAS f32x2*)(L + VEC + 512 + (2 * lane) * 4) = (f32x2){__expf(bl0), __expf(bl1)}; }
            float kt0[8], kt1[8];
#pragma unroll
            for (int i = 0; i < 8; ++i) { const int t = 8 * wave + i;
                const float q0 = __uint_as_float(qv[i] << 16), q1 = __uint_as_float(qv[i] & 0xffff0000u);
                const float d0 = fminf(fmaxf(pre0 + c0[i] - br0, -80.f), 80.f), d1 = fminf(fmaxf(pre1 + c1[i] - br1, -80.f), 80.f);
                const float k0 = 1.f - __expf(lf[i].x), k1 = 1.f - __expf(lf[i].y);
                const float qs0 = q0 * __expf(d0), qs1 = q1 * __expf(d1), ks0 = k0 * __expf(-d0), ks1 = k1 * __expf(-d1);
                *(LAS unsigned*)(L + QS + t * RS + 4 * lane) = pg8::cvt_pk_bf16(qs0, qs1);
                *(LAS unsigned*)(L + QD + t * RS + 4 * lane) = pg8::cvt_pk_bf16(qs0 * er0, qs1 * er1);
                *(LAS unsigned*)(L + KS + t * RS + 4 * lane) = pg8::cvt_pk_bf16(ks0, ks1);
                kt0[i] = ks0; kt1[i] = ks1; }
            { u32x4 w0, w1;
              w0.x = pg8::cvt_pk_bf16(kt0[0], kt0[1]); w0.y = pg8::cvt_pk_bf16(kt0[2], kt0[3]); w0.z = pg8::cvt_pk_bf16(kt0[4], kt0[5]); w0.w = pg8::cvt_pk_bf16(kt0[6], kt0[7]);
              w1.x = pg8::cvt_pk_bf16(kt1[0], kt1[1]); w1.y = pg8::cvt_pk_bf16(kt1[2], kt1[3]); w1.z = pg8::cvt_pk_bf16(kt1[4], kt1[5]); w1.w = pg8::cvt_pk_bf16(kt1[6], kt1[7]);
              *(LAS u32x4*)(L + KST + (2 * lane) * RS2 + 16 * wave) = w0; *(LAS u32x4*)(L + KST + (2 * lane + 1) * RS2 + 16 * wave) = w1; }
            { LAS bf16_t* vt = (LAS bf16_t*)(L + VT);
              vt[(vv4 + 0) * (RS2 / 2) + vs] = (bf16_t)(vraw.x & 0xffff); vt[(vv4 + 1) * (RS2 / 2) + vs] = (bf16_t)(vraw.x >> 16);
              vt[(vv4 + 2) * (RS2 / 2) + vs] = (bf16_t)(vraw.y & 0xffff); vt[(vv4 + 3) * (RS2 / 2) + vs] = (bf16_t)(vraw.y >> 16); }
            if (c + 1 < 64) {
#pragma unroll
                for (int i = 0; i < 8; ++i) { const size_t idx = (rowb + 64 * (c + 1) + 8 * wave + i) * DM + colb + 2 * lane; lf[i] = *(const f32x2*)(LOGF + idx); qv[i] = *(const unsigned*)(Q0 + idx); }
                vraw = *(const u32x2*)(V0 + (rowb + 64 * (c + 1) + vs) * DM + colb + c4 * 32 + vv4);
            }
            LDS_BARRIER();
            const int sopc = cur ? SOP1 : SOP0, sopn = cur ? SOP0 : SOP1;
            if (wave < 3) {
                const int si = wave >> 1, ti = (wave + 1) >> 1;
                f32x16 acc;
#pragma unroll
                for (int i = 0; i < 16; ++i) acc[i] = 0.f;
#pragma unroll
                for (int ks = 0; ks < 8; ++ks) { const bf16x8 a = *(const LAS bf16x8*)(L + KS + (32 * si + r32) * RS + 32 * ks + 16 * hi);
                    const bf16x8 bq = *(const LAS bf16x8*)(L + QS + (32 * ti + r32) * RS + 32 * ks + 16 * hi);
                    acc = __builtin_amdgcn_mfma_f32_32x32x16_bf16(a, bq, acc, 0, 0, 0); }
                const int t = 32 * ti + r32;
#pragma unroll
                for (int q = 0; q < 16; ++q) { const int sidx = 32 * si + crow(q, hi); if (sidx > t) acc[q] = 0.f; }
#pragma unroll
                for (int g = 0; g < 4; ++g) *(LAS u32x2*)(L + PP + t * RS2 + (32 * si + 8 * g + 4 * hi) * 2) = pack4bf(acc[4 * g], acc[4 * g + 1], acc[4 * g + 2], acc[4 * g + 3]);
            } else if (wave >= 4) {
                const int kt = wave - 4;
                f32x16 U;
#pragma unroll
                for (int i = 0; i < 16; ++i) U[i] = 0.f;
#pragma unroll
                for (int ss = 0; ss < 4; ++ss) { const bf16x8 a = *(const LAS bf16x8*)(L + KST + (32 * kt + r32) * RS2 + 32 * ss + 16 * hi);
                    const bf16x8 bv = *(const LAS bf16x8*)(L + VT + r32 * RS2 + 32 * ss + 16 * hi);
                    U = __builtin_amdgcn_mfma_f32_32x32x16_bf16(a, bv, U, 0, 0, 0); }
#pragma unroll
                for (int g = 0; g < 4; ++g) { const int k0 = 32 * kt + 8 * g + 4 * hi;
                    const f32x4 el = *(const LAS f32x4*)(L + VEC + k0 * 4), dl = *(const LAS f32x4*)(L + VEC + 512 + k0 * 4);
#pragma unroll
                    for (int e = 0; e < 4; ++e) S[4 * g + e] = dl[e] * S[4 * g + e] + el[e] * U[4 * g + e];
                    *(LAS u32x2*)(L + sopn + r32 * RS + k0 * 2) = pack4bf(S[4 * g], S[4 * g + 1], S[4 * g + 2], S[4 * g + 3]); }
            }
            LDS_BARRIER();
            if (wave < 2) {
                const int ti = wave;
                f32x16 o;
#pragma unroll
                for (int i = 0; i < 16; ++i) o[i] = 0.f;
#pragma unroll
                for (int ks = 0; ks < 8; ++ks) { const bf16x8 a = *(const LAS bf16x8*)(L + QD + (32 * ti + r32) * RS + 32 * ks + 16 * hi);
                    const bf16x8 bs = *(const LAS bf16x8*)(L + sopc + r32 * RS + 32 * ks + 16 * hi);
                    o = __builtin_amdgcn_mfma_f32_32x32x16_bf16(a, bs, o, 0, 0, 0); }
#pragma unroll
                for (int ss = 0; ss < 4; ++ss) { if (ss < 2 || ti == 1) {
                    const bf16x8 a = *(const LAS bf16x8*)(L + PP + (32 * ti + r32) * RS2 + 32 * ss + 16 * hi);
                    const bf16x8 bv = *(const LAS bf16x8*)(L + VT + r32 * RS2 + 32 * ss + 16 * hi);
                    o = __builtin_amdgcn_mfma_f32_32x32x16_bf16(a, bv, o, 0, 0, 0); } }
                bf16_t* orow = O0 + (rowb + 64 * c + 32 * ti) * DM + colb + c4 * 32 + r32;
#pragma unroll
                for (int q = 0; q < 16; ++q) orow[(size_t)crow(q, hi) * DM] = (bf16_t)f2bf(o[q]);
            }
            cur ^= 1;
        }
    }
}
namespace hg2 {
constexpr int RS = 272, RS2 = 144;
constexpr int QS = 0, KS = 17408, KST = 34816, VT = 53248, VEC = 57856, SETSZ = 59392;
constexpr int PP = 2 * SETSZ, SOP0 = PP + 9216, SOP1 = SOP0 + 8704, SEGT = SOP1 + 8704;
}
__device__ __forceinline__ void hgrn_chunk2(const Params& p, unsigned char* lds_g) {
    using namespace hg2;
    LAS unsigned char* L = (LAS unsigned char*)lds_g;
    const int tid = threadIdx.x, lane = tid & 63, wave = __builtin_amdgcn_readfirstlane(tid >> 6), r32 = lane & 31, hi = lane >> 5;
    const bf16_t* Q0 = (const bf16_t*)(p.ws + WS_B); const bf16_t* V0 = (const bf16_t*)(p.ws + WS_B + 64 * MiB);
    const float* LOGF = p.out; bf16_t* O0 = (bf16_t*)(p.ws + WS_E);
    const bool isP = wave < 4;
    const int vs = (tid & 255) >> 2, v8 = (tid & 3) * 8;
    for (int unit = blockIdx.x; unit < 256; unit += gridDim.x) {
        const int bh = unit & 63, c4 = unit >> 6, b = bh >> 4, h = bh & 15;
        const size_t rowb = (size_t)b * SEQ; const int colb = h * HD;
        __syncthreads();
        f32x16 S;
#pragma unroll
        for (int i = 0; i < 16; ++i) S[i] = 0.f;
        f32x2 lf[16], lfn[16]; unsigned qv[16], qvn[16]; u32x4 vraw, vrawn;
#define HG_LOAD_RAW(cn_, lf, qv, vraw) do { _Pragma("unroll") for (int i = 0; i < 16; ++i) { const size_t ro_ = (rowb + 64 * (cn_) + 16 * wave + i) * DM + colb;     \
            lf[i] = *(const f32x2*)((LOGF + ro_) + 2 * lane); qv[i] = *(const unsigned*)((Q0 + ro_) + 2 * lane); } \
            vraw = *(const u32x4*)((V0 + (rowb + 64 * (cn_)) * DM + colb + c4 * 32) + vs * DM + v8); } while (0)
        if (isP) HG_LOAD_RAW(0, lf, qv, vraw);
        for (int it = -1; it < 64; ++it) {
            const int cn = it + 1;
            LAS unsigned char* Sc = L + (it & 1) * SETSZ;
            LAS unsigned char* Sn = L + (cn & 1) * SETSZ;
            const int sopc = (it & 1) ? SOP1 : SOP0, sopn = (it & 1) ? SOP0 : SOP1;
            if (isP) {
                if (cn < 64) {
                    float s0 = 0.f, s1 = 0.f;
#pragma unroll
                    for (int i = 0; i < 16; ++i) { s0 += lf[i].x; s1 += lf[i].y; }
                    *(LAS f32x2*)(L + SEGT + (wave * 128 + 2 * lane) * 4) = (f32x2){s0, s1};
                }
            } else {
                const int mw = wave - 4;
                if (it < 0) { for (int e = lane + 64 * mw; e < 8704 / 4; e += 256) ((LAS unsigned*)(L + SOP0))[e] = 0u; }
                else {
                    f32x16 U;
#pragma unroll
                    for (int i = 0; i < 16; ++i) U[i] = 0.f;
#pragma unroll
                    for (int ss = 0; ss < 4; ++ss) { const bf16x8 a = *(const LAS bf16x8*)(Sc + KST + (32 * mw + r32) * RS2 + 32 * ss + 16 * hi);
                        const bf16x8 bv = *(const LAS bf16x8*)(Sc + VT + r32 * RS2 + 32 * ss + 16 * hi);
                        U = __builtin_amdgcn_mfma_f32_32x32x16_bf16(a, bv, U, 0, 0, 0); }
#pragma unroll
                    for (int g = 0; g < 4; ++g) { const int k0 = 32 * mw + 8 * g + 4 * hi;
                        const f32x4 el = *(const LAS f32x4*)(Sc + VEC + k0 * 4), dl = *(const LAS f32x4*)(Sc + VEC + 512 + k0 * 4);
#pragma unroll
                        for (int e = 0; e < 4; ++e) S[4 * g + e] = dl[e] * S[4 * g + e] + el[e] * U[4 * g + e]; }
                    if (mw < 3) {
                        const int si = mw >> 1, ti = (mw + 1) >> 1;
                        f32x16 acc;
#pragma unroll
                        for (int i = 0; i < 16; ++i) acc[i] = 0.f;
#pragma unroll
                        for (int ks = 0; ks < 8; ++ks) { const bf16x8 a = *(const LAS bf16x8*)(Sc + KS + (32 * si + r32) * RS + 32 * ks + 16 * hi);
                            const bf16x8 bq = *(const LAS bf16x8*)(Sc + QS + (32 * ti + r32) * RS + 32 * ks + 16 * hi);
                            acc = __builtin_amdgcn_mfma_f32_32x32x16_bf16(a, bq, acc, 0, 0, 0); }
                        const int t = 32 * ti + r32;
#pragma unroll
                        for (int q = 0; q < 16; ++q) { const int sidx = 32 * si + crow(q, hi); if (sidx > t) acc[q] = 0.f; }
#pragma unroll
                        for (int g = 0; g < 4; ++g) *(LAS u32x2*)(L + PP + t * RS2 + (32 * si + 8 * g + 4 * hi) * 2) = pack4bf(acc[4 * g], acc[4 * g + 1], acc[4 * g + 2], acc[4 * g + 3]);
                    }
                }
            }
            LDS_BARRIER();
            if (isP) {
                if (cn < 64) {
                    if (cn + 1 < 64) HG_LOAD_RAW(cn + 1, lfn, qvn, vrawn);
                    float pre0 = 0.f, pre1 = 0.f, br0 = 0.f, br1 = 0.f, bl0 = 0.f, bl1 = 0.f;
#pragma unroll
                    for (int w = 0; w < 4; ++w) { const f32x2 v = *(const LAS f32x2*)(L + SEGT + (w * 128 + 2 * lane) * 4);
                        if (w < wave) { pre0 += v.x; pre1 += v.y; } if (w < 2) { br0 += v.x; br1 += v.y; } bl0 += v.x; bl1 += v.y; }
                    if (wave == 0) { *(LAS f32x2*)(Sn + VEC + (2 * lane) * 4) = (f32x2){__expf(bl0 - br0), __expf(bl1 - br1)}; *(LAS f32x2*)(Sn + VEC + 512 + (2 * lane) * 4) = (f32x2){__expf(bl0), __expf(bl1)}; }
                    unsigned kt0[8], kt1[8]; float kp0 = 0.f, kp1 = 0.f;
                    float b0 = pre0 - br0, b1 = pre1 - br1;
#pragma unroll
                    for (int i = 0; i < 16; ++i) { const int t = 16 * wave + i;
                        const float q0 = __uint_as_float(qv[i] << 16), q1 = __uint_as_float(qv[i] & 0xffff0000u);
                        b0 += lf[i].x; b1 += lf[i].y;
                        const float d0 = fminf(fmaxf(b0, -80.f), 80.f), d1 = fminf(fmaxf(b1, -80.f), 80.f);
                        const float ks0 = (1.f - __expf(lf[i].x)) * __expf(-d0), ks1 = (1.f - __expf(lf[i].y)) * __expf(-d1);
                        *(LAS unsigned*)(Sn + QS + t * RS + 4 * lane) = pg8::cvt_pk_bf16(q0 * __expf(d0), q1 * __expf(d1));
                        *(LAS unsigned*)(Sn + KS + t * RS + 4 * lane) = pg8::cvt_pk_bf16(ks0, ks1);
                        if (i & 1) { kt0[i >> 1] = pg8::cvt_pk_bf16(kp0, ks0); kt1[i >> 1] = pg8::cvt_pk_bf16(kp1, ks1); }
                        else { kp0 = ks0; kp1 = ks1; } }
                    *(LAS u32x4*)(Sn + KST + (2 * lane) * RS2 + 32 * wave) = (u32x4){kt0[0], kt0[1], kt0[2], kt0[3]}; *(LAS u32x4*)(Sn + KST + (2 * lane) * RS2 + 32 * wave + 16) = (u32x4){kt0[4], kt0[5], kt0[6], kt0[7]};
                    *(LAS u32x4*)(Sn + KST + (2 * lane + 1) * RS2 + 32 * wave) = (u32x4){kt1[0], kt1[1], kt1[2], kt1[3]}; *(LAS u32x4*)(Sn + KST + (2 * lane + 1) * RS2 + 32 * wave + 16) = (u32x4){kt1[4], kt1[5], kt1[6], kt1[7]};
                    { LAS bf16_t* vt = (LAS bf16_t*)(Sn + VT);
                      vt[(v8 + 0) * (RS2 / 2) + vs] = (bf16_t)(vraw.x & 0xffff); vt[(v8 + 1) * (RS2 / 2) + vs] = (bf16_t)(vraw.x >> 16);
                      vt[(v8 + 2) * (RS2 / 2) + vs] = (bf16_t)(vraw.y & 0xffff); vt[(v8 + 3) * (RS2 / 2) + vs] = (bf16_t)(vraw.y >> 16);
                      vt[(v8 + 4) * (RS2 / 2) + vs] = (bf16_t)(vraw.z & 0xffff); vt[(v8 + 5) * (RS2 / 2) + vs] = (bf16_t)(vraw.z >> 16);
                      vt[(v8 + 6) * (RS2 / 2) + vs] = (bf16_t)(vraw.w & 0xffff); vt[(v8 + 7) * (RS2 / 2) + vs] = (bf16_t)(vraw.w >> 16); }
#pragma unroll
                    for (int i = 0; i < 16; ++i) { lf[i] = lfn[i]; qv[i] = qvn[i]; }
                    vraw = vrawn;
                }
            } else if (it >= 0) {
                const int mw = wave - 4;
                if (cn < 64) {
#pragma unroll
                    for (int g = 0; g < 4; ++g) { const int k0 = 32 * mw + 8 * g + 4 * hi;
                        const f32x4 s0 = *(const LAS f32x4*)(L + SEGT + k0 * 4), s1 = *(const LAS f32x4*)(L + SEGT + (128 + k0) * 4);
                        *(LAS u32x2*)(L + sopn + r32 * RS + k0 * 2) = pack4bf(S[4 * g] * __expf(s0[0] + s1[0]), S[4 * g + 1] * __expf(s0[1] + s1[1]), S[4 * g + 2] * __expf(s0[2] + s1[2]), S[4 * g + 3] * __expf(s0[3] + s1[3])); }
                }
                if (mw < 2) {
                    const int ti = mw;
                    f32x16 o;
#pragma unroll
                    for (int i = 0; i < 16; ++i) o[i] = 0.f;
#pragma unroll
                    for (int ks = 0; ks < 8; ++ks) { const bf16x8 a = *(const LAS bf16x8*)(Sc + QS + (32 * ti + r32) * RS + 32 * ks + 16 * hi);
                        const bf16x8 bs = *(const LAS bf16x8*)(L + sopc + r32 * RS + 32 * ks + 16 * hi);
                        o = __builtin_amdgcn_mfma_f32_32x32x16_bf16(a, bs, o, 0, 0, 0); }
#pragma unroll
                    for (int ss = 0; ss < 4; ++ss) { if (ss < 2 || ti == 1) {
                        const bf16x8 a = *(const LAS bf16x8*)(L + PP + (32 * ti + r32) * RS2 + 32 * ss + 16 * hi);
                        const bf16x8 bv = *(const LAS bf16x8*)(Sc + VT + r32 * RS2 + 32 * ss + 16 * hi);
                        o = __builtin_amdgcn_mfma_f32_32x32x16_bf16(a, bv, o, 0, 0, 0); } }
                    bf16_t* orow = O0 + (rowb + 64 * it + 32 * ti) * DM + colb + c4 * 32 + r32;
#pragma unroll
                    for (int q = 0; q < 16; ++q) orow[(size_t)crow(q, hi) * DM] = (bf16_t)f2bf(o[q]);
                }
            }
            LDS_BARRIER();
        }
#undef HG_LOAD_RAW
    }
}
namespace hg3 {
constexpr int RS = 272, RS2 = 144;
constexpr int QS = 0, KS = 17408, VT = 33792, VEC = 37888, SETSZ = 38912;
constexpr int PP = 2 * SETSZ, SOP0 = PP + 9216, SOP1 = SOP0 + 8704, SEGT = SOP1 + 8704;
struct Raw { f16x4 lf[8]; u32x2 q[8]; u32x4 v; };
typedef short v4i16_t __attribute__((ext_vector_type(4)));
__device__ __forceinline__ int offb(int row, int ch) { return 256 * row + 16 * (ch ^ (((row & 3) << 2) | ((row >> 2) & 3))); }
__device__ __forceinline__ v4i16_t trrd(const LAS unsigned char* p) { return __builtin_amdgcn_ds_read_tr16_b64_v4i16((LAS v4i16_t*)p); }
__device__ __forceinline__ bf16x8 tr_frag_ks(const LAS unsigned char* Kb, int lane, int c, int ks) {
    const int h = lane >> 5, blk = (lane >> 4) & 1, q = (lane & 15) >> 2, pp = lane & 3, r0 = 16 * ks + 8 * h + q, ch = 4 * c + 2 * blk + (pp >> 1);
    const v4i16_t lo = trrd(Kb + offb(r0, ch) + 8 * (pp & 1)), hi4 = trrd(Kb + offb(r0 + 4, ch) + 8 * (pp & 1));
    return (bf16x8){lo[0], lo[1], lo[2], lo[3], hi4[0], hi4[1], hi4[2], hi4[3]};
}
__device__ __forceinline__ bf16x8 tr_frag_v(const LAS unsigned char* Vb, int lane, int ks) {
    const int h = lane >> 5, blk = (lane >> 4) & 1, q = (lane & 15) >> 2, pp = lane & 3;
    const LAS unsigned char* a = Vb + (16 * ks + 8 * h + q) * 64 + (2 * blk + (pp >> 1)) * 16 + 8 * (pp & 1);
    const v4i16_t lo = trrd(a), hi4 = trrd(a + 4 * 64);
    return (bf16x8){lo[0], lo[1], lo[2], lo[3], hi4[0], hi4[1], hi4[2], hi4[3]};
}
}
__device__ __forceinline__ void hg3_a1(LAS unsigned char* L, const hg3::Raw& R, int sg, int k4, int sb, int segt = hg3::SEGT) {
    f32x4 s = __builtin_convertvector(R.lf[0], f32x4);
#pragma unroll
    for (int i = 1; i < 8; ++i) s += __builtin_convertvector(R.lf[i], f32x4);
    *(LAS f32x4*)(L + segt + sb * 4096 + (sg * 128 + k4) * 4) = s;
}
struct HgA2 { f32x4 bb; };
template <int HALF>
__device__ __forceinline__ void hg3_a2h(LAS unsigned char* L, LAS unsigned char* Sn, const hg3::Raw& R, int sg, int k4, int sb, int vs, int v8, HgA2& st, int segt = hg3::SEGT, bool wr_br = false) {
    using namespace hg3;
    if (HALF == 0) {
        f32x4 pre = {0.f, 0.f, 0.f, 0.f}, br = pre, bl = pre;
#pragma unroll
        for (int w = 0; w < 8; ++w) { const f32x4 v = *(const LAS f32x4*)(L + segt + sb * 4096 + (w * 128 + k4) * 4); if (w < sg) pre += v; if (w < 4) br += v; bl += v; }
        if (sg == 0) { f32x4 el, dl;
#pragma unroll
            for (int e = 0; e < 4; ++e) { el[e] = __expf(bl[e] - br[e]); dl[e] = __expf(bl[e]); }
            *(LAS f32x4*)(Sn + VEC + k4 * 4) = el; *(LAS f32x4*)(Sn + VEC + 512 + k4 * 4) = dl; if (wr_br) *(LAS f32x4*)(Sn + VEC + 1024 + k4 * 4) = br; }
        st.bb = pre - br;
    }
#pragma unroll
    for (int i = 4 * HALF; i < 4 * HALF + 4; ++i) { const int t = 8 * sg + i;
        float q[4]; q[0] = __uint_as_float(R.q[i].x << 16); q[1] = __uint_as_float(R.q[i].x & 0xffff0000u); q[2] = __uint_as_float(R.q[i].y << 16); q[3] = __uint_as_float(R.q[i].y & 0xffff0000u);
        const f32x4 lfi = __builtin_convertvector(R.lf[i], f32x4);
        st.bb += lfi;
        float qs[4], ks[4];
#pragma unroll
        for (int e = 0; e < 4; ++e) { const float d = fminf(fmaxf(st.bb[e], -80.f), 80.f); qs[e] = q[e] * __expf(d); ks[e] = (1.f - __expf(lfi[e])) * __expf(-d); }
        *(LAS u32x2*)(Sn + QS + t * RS + k4 * 2) = pack4bf(qs[0], qs[1], qs[2], qs[3]);
        *(LAS u32x2*)(Sn + KS + offb(t, k4 >> 3) + (k4 & 4) * 2) = pack4bf(ks[0], ks[1], ks[2], ks[3]); }
    if (HALF == 1) *(LAS u32x4*)(Sn + VT + vs * 64 + v8 * 2) = R.v;
}
struct HgA2p { f32x4 tt; };
template <int HALF>
__device__ __forceinline__ void hg3_a2p(LAS unsigned char* L, LAS unsigned char* Sn, const hg3::Raw& R, int sg, int k4, int sb, int vs, int v8, HgA2p& st, int segt) {
    using namespace hg3;
    if (HALF == 0) {
        f32x4 pre = {0.f, 0.f, 0.f, 0.f}, br = pre, bl = pre;
#pragma unroll
        for (int w = 0; w < 8; ++w) { const f32x4 v = *(const LAS f32x4*)(L + segt + sb * 4096 + (w * 128 + k4) * 4); if (w < sg) pre += v; if (w < 4) br += v; bl += v; }
        if (sg == 0) { f32x4 el, dl;
#pragma unroll
            for (int e = 0; e < 4; ++e) { el[e] = __builtin_amdgcn_exp2f(bl[e] - br[e]); dl[e] = __builtin_amdgcn_exp2f(bl[e]); }
            *(LAS f32x4*)(Sn + VEC + k4 * 4) = el; *(LAS f32x4*)(Sn + VEC + 512 + k4 * 4) = dl; *(LAS f32x4*)(Sn + VEC + 1024 + k4 * 4) = br; }
#pragma unroll
        for (int e = 0; e < 4; ++e) st.tt[e] = __builtin_amdgcn_exp2f(fminf(fmaxf(pre[e] - br[e], -115.f), 115.f));
    }
#pragma unroll
    for (int i = 4 * HALF; i < 4 * HALF + 4; ++i) { const int t = 8 * sg + i;
        float q[4]; q[0] = __uint_as_float(R.q[i].x << 16); q[1] = __uint_as_float(R.q[i].x & 0xffff0000u); q[2] = __uint_as_float(R.q[i].y << 16); q[3] = __uint_as_float(R.q[i].y & 0xffff0000u);
        const f32x4 lfi = __builtin_convertvector(R.lf[i], f32x4);
        float qs[4], ks[4];
#pragma unroll
        for (int e = 0; e < 4; ++e) { const float f = __builtin_amdgcn_exp2f(lfi[e]); const float tn = fminf(fmaxf(st.tt[e] * f, 1.8e-35f), 5.5e34f); st.tt[e] = tn;
            qs[e] = q[e] * tn; ks[e] = (1.f - f) * __builtin_amdgcn_rcpf(tn); }
        *(LAS u32x2*)(Sn + QS + t * RS + k4 * 2) = pack4bf(qs[0], qs[1], qs[2], qs[3]);
        *(LAS u32x2*)(Sn + KS + offb(t, k4 >> 3) + (k4 & 4) * 2) = pack4bf(ks[0], ks[1], ks[2], ks[3]); }
    if (HALF == 1) *(LAS u32x4*)(Sn + VT + vs * 64 + v8 * 2) = R.v;
}
__device__ __forceinline__ void hg3_m1(LAS unsigned char* L, LAS unsigned char* Sc, int it, int mw, int r32, int hi, f32x16& S, int pp = hg3::PP, int sop0 = hg3::SOP0) {
    using namespace hg3;
    const int lane = hi * 32 + r32;
    if (it < 0) { for (int e = lane + 64 * mw; e < 8704 / 4; e += 256) ((LAS unsigned*)(L + sop0))[e] = 0u; return; }
    bf16x8 ua[4], ub[4];
#pragma unroll
    for (int ss = 0; ss < 4; ++ss) { ua[ss] = tr_frag_ks(Sc + KS, lane, mw, ss); ub[ss] = tr_frag_v(Sc + VT, lane, ss); }
    f32x4 el[4], dl[4];
#pragma unroll
    for (int g = 0; g < 4; ++g) { const int k0 = 32 * mw + 8 * g + 4 * hi; el[g] = *(const LAS f32x4*)(Sc + VEC + k0 * 4); dl[g] = *(const LAS f32x4*)(Sc + VEC + 512 + k0 * 4); }
    const int si = mw >> 1, ti = (mw + 1) >> 1;
    bf16x8 sa[8], sq[8];
    if (mw < 3) {
#pragma unroll
        for (int ks = 0; ks < 8; ++ks) { sa[ks] = *(const LAS bf16x8*)(Sc + KS + offb(32 * si + r32, 2 * ks + hi)); sq[ks] = *(const LAS bf16x8*)(Sc + QS + (32 * ti + r32) * RS + 32 * ks + 16 * hi); }
    }
    __builtin_amdgcn_sched_barrier(0);
    f32x16 U;
#pragma unroll
    for (int i = 0; i < 16; ++i) U[i] = 0.f;
#pragma unroll
    for (int ss = 0; ss < 4; ++ss) U = __builtin_amdgcn_mfma_f32_32x32x16_bf16(ua[ss], ub[ss], U, 0, 0, 0);
    if (mw < 3) {
        f32x16 acc;
#pragma unroll
        for (int i = 0; i < 16; ++i) acc[i] = 0.f;
#pragma unroll
        for (int ks = 0; ks < 8; ++ks) acc = __builtin_amdgcn_mfma_f32_32x32x16_bf16(sa[ks], sq[ks], acc, 0, 0, 0);
        const int t = 32 * ti + r32;
#pragma unroll
        for (int q = 0; q < 16; ++q) { const int sidx = 32 * si + crow(q, hi); if (sidx > t) acc[q] = 0.f; }
#pragma unroll
        for (int g = 0; g < 4; ++g) *(LAS u32x2*)(L + pp + t * RS2 + (32 * si + 8 * g + 4 * hi) * 2) = pack4bf(acc[4 * g], acc[4 * g + 1], acc[4 * g + 2], acc[4 * g + 3]);
    }
#pragma unroll
    for (int g = 0; g < 4; ++g)
#pragma unroll
        for (int e = 0; e < 4; ++e) S[4 * g + e] = dl[g][e] * S[4 * g + e] + el[g][e] * U[4 * g + e];
}
__device__ __forceinline__ void hg4_m1(LAS unsigned char* L, LAS unsigned char* Sc, int it, int mw, int r32, int hi, f32x16& S, int pp, int sop0) {
    using namespace hg3;
    const int lane = hi * 32 + r32;
    if (it < 0) { for (int e = lane + 64 * mw; e < 8704 / 4; e += 256) ((LAS unsigned*)(L + sop0))[e] = 0u; return; }
    bf16x8 ua[4], ub[4];
#pragma unroll
    for (int ss = 0; ss < 4; ++ss) { ua[ss] = tr_frag_ks(Sc + KS, lane, mw, ss); ub[ss] = tr_frag_v(Sc + VT, lane, ss); }
    f32x4 el[4], dl[4];
#pragma unroll
    for (int g = 0; g < 4; ++g) { const int k0 = 32 * mw + 8 * g + 4 * hi; el[g] = *(const LAS f32x4*)(Sc + VEC + k0 * 4); dl[g] = *(const LAS f32x4*)(Sc + VEC + 512 + k0 * 4); }
    const int si = mw, ti0 = mw;
    bf16x8 sa[8], sq[8];
    if (mw < 2) {
#pragma unroll
        for (int ks = 0; ks < 8; ++ks) { sa[ks] = *(const LAS bf16x8*)(Sc + KS + offb(32 * si + r32, 2 * ks + hi)); sq[ks] = *(const LAS bf16x8*)(Sc + QS + (32 * ti0 + r32) * RS + 32 * ks + 16 * hi); }
    }
    __builtin_amdgcn_sched_barrier(0);
    f32x16 U;
#pragma unroll
    for (int i = 0; i < 16; ++i) U[i] = 0.f;
#pragma unroll
    for (int ss = 0; ss < 4; ++ss) U = __builtin_amdgcn_mfma_f32_32x32x16_bf16(ua[ss], ub[ss], U, 0, 0, 0);
    if (mw < 2) {
        f32x16 acc;
#pragma unroll
        for (int i = 0; i < 16; ++i) acc[i] = 0.f;
#pragma unroll
        for (int ks = 0; ks < 8; ++ks) acc = __builtin_amdgcn_mfma_f32_32x32x16_bf16(sa[ks], sq[ks], acc, 0, 0, 0);
        if (mw == 0) {
#pragma unroll
            for (int ks = 0; ks < 8; ++ks) sq[ks] = *(const LAS bf16x8*)(Sc + QS + (32 + r32) * RS + 32 * ks + 16 * hi);
        }
        { const int t = 32 * ti0 + r32;
#pragma unroll
          for (int q = 0; q < 16; ++q) { const int sidx = 32 * si + crow(q, hi); if (sidx > t) acc[q] = 0.f; }
#pragma unroll
          for (int g = 0; g < 4; ++g) *(LAS u32x2*)(L + pp + t * RS2 + (32 * si + 8 * g + 4 * hi) * 2) = pack4bf(acc[4 * g], acc[4 * g + 1], acc[4 * g + 2], acc[4 * g + 3]); }
        if (mw == 0) {
            __builtin_amdgcn_sched_barrier(0);
            f32x16 ac2;
#pragma unroll
            for (int i = 0; i < 16; ++i) ac2[i] = 0.f;
#pragma unroll
            for (int ks = 0; ks < 8; ++ks) ac2 = __builtin_amdgcn_mfma_f32_32x32x16_bf16(sa[ks], sq[ks], ac2, 0, 0, 0);
            const int t = 32 + r32;
#pragma unroll
            for (int g = 0; g < 4; ++g) *(LAS u32x2*)(L + pp + t * RS2 + (8 * g + 4 * hi) * 2) = pack4bf(ac2[4 * g], ac2[4 * g + 1], ac2[4 * g + 2], ac2[4 * g + 3]);
        }
    }
#pragma unroll
    for (int g = 0; g < 4; ++g)
#pragma unroll
        for (int e = 0; e < 4; ++e) S[4 * g + e] = dl[g][e] * S[4 * g + e] + el[g][e] * U[4 * g + e];
}
__device__ __forceinline__ void hg3_m2(LAS unsigned char* L, LAS unsigned char* Sc, int sopc, int sopn, int it, int mw, int r32, int hi, const f32x16& S, bf16_t* Ob, int pp = hg3::PP, const LAS unsigned char* brp = nullptr, bool out_hi = false, bool wide = false, bool do_keep = false, u32x4* keep = nullptr) {
    using namespace hg3;
    const int lane = hi * 32 + r32;
    const int sbn = ((it + 1) & 1) * 4096;
    const int ti = out_hi ? mw - 2 : mw;
    const bool outw = out_hi ? (mw >= 2) : (mw < 2);
    bf16x8 oa[8], ob[8], pa[4], pv[4];
    if (outw) {
#pragma unroll
        for (int ks = 0; ks < 8; ++ks) { oa[ks] = *(const LAS bf16x8*)(Sc + QS + (32 * ti + r32) * RS + 32 * ks + 16 * hi); ob[ks] = *(const LAS bf16x8*)(L + sopc + r32 * RS + 32 * ks + 16 * hi); }
#pragma unroll
        for (int ss = 0; ss < 4; ++ss) { pa[ss] = *(const LAS bf16x8*)(L + pp + (32 * ti + r32) * RS2 + 32 * ss + 16 * hi); pv[ss] = tr_frag_v(Sc + VT, lane, ss); }
    }
    f32x4 sb[4];
    if (it + 1 < 64) {
#pragma unroll
        for (int g = 0; g < 4; ++g) { const int k0 = 32 * mw + 8 * g + 4 * hi;
            if (brp != nullptr) sb[g] = *(const LAS f32x4*)(brp + k0 * 4);
            else sb[g] = (*(const LAS f32x4*)(L + SEGT + sbn + k0 * 4) + *(const LAS f32x4*)(L + SEGT + sbn + (128 + k0) * 4)) + (*(const LAS f32x4*)(L + SEGT + sbn + (256 + k0) * 4) + *(const LAS f32x4*)(L + SEGT + sbn + (384 + k0) * 4)); }
    }
    __builtin_amdgcn_sched_barrier(0);
    if (outw) {
        f32x16 o;
#pragma unroll
        for (int i = 0; i < 16; ++i) o[i] = 0.f;
#pragma unroll
        for (int ks = 0; ks < 8; ++ks) o = __builtin_amdgcn_mfma_f32_32x32x16_bf16(oa[ks], ob[ks], o, 0, 0, 0);
#pragma unroll
        for (int ss = 0; ss < 4; ++ss) { if (ss < 2 || ti == 1) o = __builtin_amdgcn_mfma_f32_32x32x16_bf16(pa[ss], pv[ss], o, 0, 0, 0); }
        if (wide) {
            LAS unsigned char* Tp = L + pp + (32 * ti) * RS2;
            asm volatile("s_nop 15\n\ts_nop 7" : "+v"(o));
#pragma unroll
            for (int qq = 0; qq < 8; ++qq) { const unsigned w = pg8::cvt_pk_bf16(o[2 * qq], o[2 * qq + 1]);
                *(LAS bf16_t*)(Tp + crow(2 * qq, hi) * RS2 + r32 * 2) = (bf16_t)(w & 0xffffu); *(LAS bf16_t*)(Tp + crow(2 * qq + 1, hi) * RS2 + r32 * 2) = (bf16_t)(w >> 16); }
            asm volatile("s_waitcnt lgkmcnt(0)" ::: "memory");
#pragma unroll
            for (int i = 0; i < 2; ++i) { const int row = (lane >> 2) + 16 * i, ch = lane & 3;
                const u32x4 v = *(const LAS u32x4*)(Tp + row * RS2 + ch * 16);
                if (do_keep) keep[i] = v; else *(u32x4*)(Ob + (size_t)(32 * ti + row) * DM + ch * 8) = v; }
        } else {
        bf16_t* orow = Ob + (size_t)(32 * ti) * DM + r32;
#pragma unroll
        for (int q = 0; q < 16; ++q) orow[(size_t)crow(q, hi) * DM] = (bf16_t)f2bf(o[q]);
        }
    }
    if (it + 1 < 64) {
#pragma unroll
        for (int g = 0; g < 4; ++g) { const int k0 = 32 * mw + 8 * g + 4 * hi;
            *(LAS u32x2*)(L + sopn + r32 * RS + k0 * 2) = (brp != nullptr) ? pack4bf(S[4 * g] * __builtin_amdgcn_exp2f(sb[g][0]), S[4 * g + 1] * __builtin_amdgcn_exp2f(sb[g][1]), S[4 * g + 2] * __builtin_amdgcn_exp2f(sb[g][2]), S[4 * g + 3] * __builtin_amdgcn_exp2f(sb[g][3]))
                                                                              : pack4bf(S[4 * g] * __expf(sb[g][0]), S[4 * g + 1] * __expf(sb[g][1]), S[4 * g + 2] * __expf(sb[g][2]), S[4 * g + 3] * __expf(sb[g][3])); }
    }
}
template <int MODE>
__device__ __forceinline__ void hgrn_chunk3(const Params& p, unsigned char* lds_g) {
    using namespace hg3;
    LAS unsigned char* L = (LAS unsigned char*)lds_g;
    const int tid = threadIdx.x, lane = tid & 63, wave = __builtin_amdgcn_readfirstlane(tid >> 6), r32 = lane & 31, hi = lane >> 5;
    const bf16_t* Q0 = (const bf16_t*)(p.ws + WS_B); const bf16_t* V0 = (const bf16_t*)(p.ws + WS_B + 64 * MiB);
    const _Float16* LOGF16 = (const _Float16*)p.out; bf16_t* O0 = MODE == 2 ? (bf16_t*)((unsigned char*)p.out + 64 * MiB) : (bf16_t*)(p.ws + WS_E);
    const bool isP = wave < 4;
    const int sg = 2 * (wave & 3) + hi, k4 = 4 * r32;
    const int vs = (tid & 255) >> 2, v8 = (tid & 3) * 8;
    for (int unit = blockIdx.x; unit < 256; unit += gridDim.x) {
        const int bh = unit & 63, c4 = unit >> 6, b = bh >> 4, h = bh & 15;
        const size_t rowb = (size_t)b * SEQ; const int colb = h * HD;
        __syncthreads();
        f32x16 S;
#pragma unroll
        for (int i = 0; i < 16; ++i) S[i] = 0.f;
        Raw R0, R1, R2;
#define HG_LOAD(cn_, R_) do { int lo_ = hi * 8 * DM + k4, vo_ = vs * DM + v8; asm volatile("" : "+v"(lo_), "+v"(vo_));     \
            _Pragma("unroll") for (int i = 0; i < 8; ++i) { const size_t ro_ = (rowb + 64 * (cn_) + 8 * (2 * (wave & 3)) + i) * DM + colb;     \
            R_.lf[i] = *(const f16x4*)((LOGF16 + ro_) + lo_); R_.q[i] = *(const u32x2*)((Q0 + ro_) + lo_); } \
            R_.v = *(const u32x4*)((V0 + (rowb + 64 * (cn_)) * DM + colb + c4 * 32) + vo_); } while (0)
        if (isP) {
            __builtin_amdgcn_s_setprio(1);
            HgA2 st;
            if (MODE != 2) { HG_LOAD(0, R0); HG_LOAD(1, R1); hg3_a1(L, R0, sg, k4, 0); }
            LDS_BARRIER();
#define HG_PITER(it_, RC_, RN_, RF_) do { const int cn = (it_) + 1; LAS unsigned char* Sn = L + (cn & 1) * SETSZ; const int cf = cn + 2 < 63 ? cn + 2 : 63; \
            if (MODE != 2) { HG_LOAD(cf, RF_); hg3_a2h<0>(L, Sn, RC_, sg, k4, cn & 1, vs, v8, st); } LDS_BARRIER(); \
            if (MODE != 2) { hg3_a2h<1>(L, Sn, RC_, sg, k4, cn & 1, vs, v8, st); hg3_a1(L, RN_, sg, k4, (cn + 1) & 1); } LDS_BARRIER(); } while (0)
            for (int base = -1; base < 65; base += 3) { HG_PITER(base, R0, R1, R2); HG_PITER(base + 1, R1, R2, R0); HG_PITER(base + 2, R2, R0, R1); }
#undef HG_PITER
            __builtin_amdgcn_s_setprio(0);
        } else {
            LDS_BARRIER();
            for (int it = -1; it < 65; ++it) {
                LAS unsigned char* Sc = L + (it & 1) * SETSZ; const int sopc = (it & 1) ? SOP1 : SOP0, sopn = (it & 1) ? SOP0 : SOP1;
                if (MODE != 1 && it < 64) hg3_m1(L, Sc, it, wave - 4, r32, hi, S);
                LDS_BARRIER();
                if (MODE != 1 && it >= 0 && it < 64) hg3_m2(L, Sc, sopc, sopn, it, wave - 4, r32, hi, S, O0 + (rowb + 64 * it) * DM + colb + c4 * 32);
                LDS_BARRIER();
            }
        }
#undef HG_LOAD
    }
}
__device__ __forceinline__ void hn_unpack(const u32x4 v, float (&o)[8]) {
    o[0] = __uint_as_float(v.x << 16); o[1] = __uint_as_float(v.x & 0xffff0000u); o[2] = __uint_as_float(v.y << 16); o[3] = __uint_as_float(v.y & 0xffff0000u);
    o[4] = __uint_as_float(v.z << 16); o[5] = __uint_as_float(v.z & 0xffff0000u); o[6] = __uint_as_float(v.w << 16); o[7] = __uint_as_float(v.w & 0xffff0000u);
}
namespace hg4 {
constexpr int SETSZ = hg3::SETSZ + 512;
constexpr int PP0 = 3 * SETSZ, PP1 = PP0 + 9216, SOP0 = PP1 + 9216, SOP1 = SOP0 + 8704, SEGT = SOP1 + 8704, END = SEGT + 8192;
static_assert(END <= LDS_BYTES - 16, "hgrn_chunk4 LDS map");
}
__device__ __forceinline__ void hgrn_chunk4(const Params& p, unsigned char* lds_g) {
    using namespace hg3;
    LAS unsigned char* L = (LAS unsigned char*)lds_g;
    const int tid = threadIdx.x, lane = tid & 63, wave = __builtin_amdgcn_readfirstlane(tid >> 6), r32 = lane & 31, hi = lane >> 5;
    const bf16_t* Q0 = (const bf16_t*)(p.ws + WS_B); const bf16_t* V0 = (const bf16_t*)(p.ws + WS_B + 64 * MiB);
    const _Float16* LOGF16 = (const _Float16*)p.out; bf16_t* O0 = (bf16_t*)(p.ws + WS_E);
    const bool isP = wave < 4;
    const int sg = 2 * (wave & 3) + hi, k4 = 4 * r32;
    const int vs = (tid & 255) >> 2, v8 = (tid & 3) * 8;
    for (int unit = blockIdx.x; unit < 256; unit += gridDim.x) {
        const int bh = unit & 63, c4 = unit >> 6, b = bh >> 4, h = bh & 15;
        const size_t rowb = (size_t)b * SEQ; const int colb = h * HD;
        __syncthreads();
        f32x16 S;
#pragma unroll
        for (int i = 0; i < 16; ++i) S[i] = 0.f;
        Raw R0, R1, R2;
#define HG_LOAD(cn_, R_) do { int lo_ = hi * 8 * DM + k4, vo_ = vs * DM + v8; asm volatile("" : "+v"(lo_), "+v"(vo_));     \
            _Pragma("unroll") for (int i = 0; i < 8; ++i) { const size_t ro_ = (rowb + 64 * (cn_) + 8 * (2 * (wave & 3)) + i) * DM + colb;     \
            R_.lf[i] = *(const f16x4*)((LOGF16 + ro_) + lo_); R_.q[i] = *(const u32x2*)((Q0 + ro_) + lo_); } \
            R_.v = *(const u32x4*)((V0 + (rowb + 64 * (cn_)) * DM + colb + c4 * 32) + vo_); } while (0)
        if (isP) {
            __builtin_amdgcn_s_setprio(1);
            HgA2p st;
            HG_LOAD(0, R0); HG_LOAD(1, R1); hg3_a1(L, R0, sg, k4, 0, hg4::SEGT);
            LDS_BARRIER();
#define HG_PSTEP(s_, RC_, RN_, RF_) do { const int cn = (s_) + 1; LAS unsigned char* Sn = L + (cn % 3) * hg4::SETSZ; const int cf = cn + 2 < 63 ? cn + 2 : 63; \
            HG_LOAD(cf, RF_); hg3_a2p<0>(L, Sn, RC_, sg, k4, cn & 1, vs, v8, st, hg4::SEGT); hg3_a2p<1>(L, Sn, RC_, sg, k4, cn & 1, vs, v8, st, hg4::SEGT); \
            hg3_a1(L, RN_, sg, k4, (cn + 1) & 1, hg4::SEGT); LDS_BARRIER(); } while (0)
            for (int base = -1; base < 65; base += 3) { HG_PSTEP(base, R0, R1, R2); HG_PSTEP(base + 1, R1, R2, R0); HG_PSTEP(base + 2, R2, R0, R1); }
#undef HG_PSTEP
            __builtin_amdgcn_s_setprio(0);
        } else {
            LDS_BARRIER();
            const bool fused = gridDim.x == 256;
            const int mw = wave - 4, tio = mw - 2;
            unsigned* FL = (unsigned*)(p.ws + WS_BAR) + 3584;
            float* SSP = (float*)(p.ws + WS_G);
            const bf16_t* Z0 = (const bf16_t*)(p.ws + WS_D); bf16_t* ONp = (bf16_t*)(p.ws + WS_A);
            u32x4 qa[2], qb[2], qc[2], qd[2];
            u32x4 zz[2]; unsigned fl = 0u; float pt[2];
#pragma unroll
            for (int i = 0; i < 2; ++i) { qa[i] = (u32x4){0u, 0u, 0u, 0u}; qb[i] = qa[i]; qc[i] = qa[i]; qd[i] = qa[i]; zz[i] = qa[i]; pt[i] = 0.f; }
            const bool fo = fused && mw >= 2;
            for (int s = -1; s < 69; ++s) {
                int ln_ = lane; asm volatile("" : "+v"(ln_)); const int r32_ = ln_ & 31, hi_ = ln_ >> 5;
                const int c2 = s - 1;
                const int cf = c2 - 2, cl = c2 - 3, cz = c2 - 4;
                u32x4 kp[2];
                if (fo && cl >= 0 && cl < 64) {
                    if (!__all(fl >= (unsigned)(cl + 1))) {
                        const unsigned* fp = FL + (bh + 64 * (ln_ & 3)) * 2 + tio;
                        for (int spin = 0; spin < (1 << 22); ++spin) { __builtin_amdgcn_s_sleep(2); fl = __hip_atomic_load(fp, __ATOMIC_RELAXED, __HIP_MEMORY_SCOPE_AGENT); if (__all(fl >= (unsigned)(cl + 1))) break; } }
                    asm volatile("" ::: "memory");
                }
                if (fo && cz >= 0 && cz < 64) {
#pragma unroll
                    for (int i = 0; i < 2; ++i) { const int row = (ln_ >> 2) + 16 * i, ch = ln_ & 3;
                        float tot = pt[i]; tot += quad_x<0xB1>(tot); tot += quad_x<0x4E>(tot);
                        const float rr = rsqrtf(tot * (1.f / HD) + RMS_EPS);
                        float o8[8], z8[8]; hn_unpack(qd[i], o8); hn_unpack(zz[i], z8);
#pragma unroll
                        for (int e = 0; e < 8; ++e) z8[e] = o8[e] * rr * (z8[e] * sigmoidf_(z8[e]));
                        u32x4 w; w.x = pk2(z8[0], z8[1]); w.y = pk2(z8[2], z8[3]); w.z = pk2(z8[4], z8[5]); w.w = pk2(z8[6], z8[7]);
                        *(u32x4*)(ONp + (rowb + 64 * cz + 32 * tio + row) * DM + colb + c4 * 32 + ch * 8) = w; }
                }
                if (fo && cl >= 0 && cl < 64) {
#pragma unroll
                    for (int i = 0; i < 2; ++i) { const int row = (ln_ >> 2) + 16 * i, ch = ln_ & 3;
                        pt[i] = __hip_atomic_load(SSP + ((size_t)(bh * 64 + cl) * 4 + ch) * 64 + 32 * tio + row, __ATOMIC_RELAXED, __HIP_MEMORY_SCOPE_AGENT);
                        zz[i] = *(const u32x4*)(Z0 + (rowb + 64 * cl + 32 * tio + row) * DM + colb + c4 * 32 + ch * 8); }
                }
                if (fo && cf >= 0 && cf < 64) fl = __hip_atomic_load(FL + (bh + 64 * (ln_ & 3)) * 2 + tio, __ATOMIC_RELAXED, __HIP_MEMORY_SCOPE_AGENT);
                if (c2 >= 0 && c2 < 64) hg3_m2(L, L + (c2 % 3) * hg4::SETSZ, (c2 & 1) ? hg4::SOP1 : hg4::SOP0, (c2 & 1) ? hg4::SOP0 : hg4::SOP1, c2, mw, r32_, hi_, S,
                                               O0 + (rowb + 64 * c2) * DM + colb + c4 * 32, (c2 & 1) ? hg4::PP1 : hg4::PP0, L + ((c2 + 1) % 3) * hg4::SETSZ + VEC + 1024, true, true, fused, kp);
                if (s < 64) hg3_m1(L, L + ((s + 3) % 3) * hg4::SETSZ, s, mw, r32_, hi_, S, (s & 1) ? hg4::PP1 : hg4::PP0, hg4::SOP0);
                if (fo && c2 - 1 >= 0 && c2 - 1 < 64) {
                    if (cz >= 0 && cf < 64) asm volatile("s_waitcnt vmcnt(5)" ::: "memory"); else asm volatile("s_waitcnt vmcnt(0)" ::: "memory");
                    if (ln_ == 0) __hip_atomic_store(FL + unit * 2 + tio, (unsigned)c2, __ATOMIC_RELAXED, __HIP_MEMORY_SCOPE_AGENT); }
                if (fo && c2 >= 0 && c2 < 64) {
#pragma unroll
                    for (int i = 0; i < 2; ++i) { float o8[8]; hn_unpack(kp[i], o8); float ss = 0.f;
#pragma unroll
                        for (int e = 0; e < 8; ++e) ss += o8[e] * o8[e];
                        ss += quad_x<0xB1>(ss); ss += quad_x<0x4E>(ss);
                        if ((ln_ & 3) == 0) __hip_atomic_store(SSP + ((size_t)(bh * 64 + c2) * 4 + c4) * 64 + 32 * tio + (ln_ >> 2) + 16 * i, ss, __ATOMIC_RELAXED, __HIP_MEMORY_SCOPE_AGENT); }
                }
                if (fo) {
#pragma unroll
                    for (int i = 0; i < 2; ++i) { qd[i] = qc[i]; qc[i] = qb[i]; qb[i] = qa[i]; qa[i] = kp[i]; } }
                if (s < 65) LDS_BARRIER();
            }
        }
#undef HG_LOAD
    }
}
__device__ __forceinline__ void hgrn_headnorm(const Params& p) {
    const int tid = threadIdx.x, lane = tid & 63, wave = tid >> 6, gw = blockIdx.x * 8 + wave, NGW = gridDim.x * 8;
    const bf16_t* O0 = (const bf16_t*)(p.ws + WS_E); const bf16_t* Z0 = (const bf16_t*)(p.ws + WS_D); bf16_t* ON = (bf16_t*)(p.ws + WS_A);
    const int sub = lane & 15;
    constexpr int NR4 = T * NH / 4;
    for (int r4 = gw; r4 < NR4; r4 += 4 * NGW) {
        size_t off[4]; u32x4 ov[4], zv[4];
#pragma unroll
        for (int u = 0; u < 4; ++u) { const int rr = r4 + u * NGW < NR4 ? r4 + u * NGW : r4; off[u] = ((size_t)rr * 4 + (lane >> 4)) * 128 + 8 * sub; ov[u] = *(const u32x4*)(O0 + off[u]); zv[u] = *(const u32x4*)(Z0 + off[u]); }
#pragma unroll
        for (int u = 0; u < 4; ++u) { float o[8], z[8]; hn_unpack(ov[u], o); hn_unpack(zv[u], z);
#pragma unroll
            for (int e = 0; e < 8; ++e) z[e] = z[e] * sigmoidf_(z[e]);
            float ss = 0.f;
#pragma unroll
            for (int e = 0; e < 8; ++e) ss += o[e] * o[e];
            ss += __shfl_xor(ss, 1); ss += __shfl_xor(ss, 2); ss += __shfl_xor(ss, 4); ss += __shfl_xor(ss, 8);
            const float rr = rsqrtf(ss * (1.f / HD) + RMS_EPS);
            u32x4 w; w.x = pk2(o[0] * rr * z[0], o[1] * rr * z[1]); w.y = pk2(o[2] * rr * z[2], o[3] * rr * z[3]);
            w.z = pk2(o[4] * rr * z[4], o[5] * rr * z[5]); w.w = pk2(o[6] * rr * z[6], o[7] * rr * z[7]);
            *(u32x4*)(ON + off[u]) = w; }
    }
}
template <bool OUT_BF16>
__device__ __forceinline__ void rows_rms2(const float* X, const float* gain, void* Ov, const int tidv) {
    const int lane = tidv & 63, gw = blockIdx.x * 8 + (tidv >> 6), NGW = gridDim.x * 8;
    const f32x4* gr = (const f32x4*)gain + lane;
    for (int m = gw; m < T; m += 2 * NGW) {
        const int m2 = m + NGW < T ? m + NGW : m;
        const f32x4* xa = (const f32x4*)(X + (size_t)m * DM) + lane; const f32x4* xb = (const f32x4*)(X + (size_t)m2 * DM) + lane;
        f32x4 va[8], vb[8]; float sa = 0.f, sb = 0.f;
#pragma unroll
        for (int j = 0; j < 8; ++j) va[j] = xa[64 * j];
#pragma unroll
        for (int j = 0; j < 8; ++j) vb[j] = xb[64 * j];
#pragma unroll
        for (int j = 0; j < 8; ++j) { sa += (va[j].x * va[j].x + va[j].y * va[j].y) + (va[j].z * va[j].z + va[j].w * va[j].w); sb += (vb[j].x * vb[j].x + vb[j].y * vb[j].y) + (vb[j].z * vb[j].z + vb[j].w * vb[j].w); }
        const float ra = rsqrtf(wave_sum(sa) * (1.f / DM) + RMS_EPS), rb = rsqrtf(wave_sum(sb) * (1.f / DM) + RMS_EPS);
        if (OUT_BF16) { u32x2* oa = (u32x2*)((bf16_t*)Ov + (size_t)m * DM) + lane; u32x2* ob = (u32x2*)((bf16_t*)Ov + (size_t)m2 * DM) + lane;
#pragma unroll
            for (int j = 0; j < 8; ++j) { const f32x4 g = gr[64 * j]; u32x2 w; w.x = pk2(va[j].x * ra * g.x, va[j].y * ra * g.y); w.y = pk2(va[j].z * ra * g.z, va[j].w * ra * g.w); oa[64 * j] = w;
                w.x = pk2(vb[j].x * rb * g.x, vb[j].y * rb * g.y); w.y = pk2(vb[j].z * rb * g.z, vb[j].w * rb * g.w); ob[64 * j] = w; } }
        else { f32x4* oa = (f32x4*)((float*)Ov + (size_t)m * DM) + lane; f32x4* ob = (f32x4*)((float*)Ov + (size_t)m2 * DM) + lane;
#pragma unroll
            for (int j = 0; j < 8; ++j) { const f32x4 g = gr[64 * j]; oa[64 * j] = va[j] * ra * g; ob[64 * j] = vb[j] * rb * g; } }
    }
}
template <bool OUT_BF16>
__device__ __forceinline__ void rows_rms_b(const bf16_t* X, const float* gain, void* Ov, const int tidv) {
    const int lane = tidv & 63, gw = blockIdx.x * 8 + (tidv >> 6), NGW = gridDim.x * 8;
    const f32x4* gr = (const f32x4*)gain + 2 * lane;
    for (int m = gw; m < T; m += 4 * NGW) {
        int mr[4]; u32x4 v[4][4]; float rr[4];
#pragma unroll
        for (int r = 0; r < 4; ++r) mr[r] = m + r * NGW < T ? m + r * NGW : m;
#pragma unroll
        for (int r = 0; r < 4; ++r)
#pragma unroll
            for (int j = 0; j < 4; ++j) v[r][j] = *((const u32x4*)(X + (size_t)mr[r] * DM) + lane + 64 * j);
#pragma unroll
        for (int r = 0; r < 4; ++r) { float s = 0.f;
#pragma unroll
            for (int j = 0; j < 4; ++j)
#pragma unroll
                for (int e = 0; e < 4; ++e) { const float lo = __uint_as_float(v[r][j][e] << 16), hi = __uint_as_float(v[r][j][e] & 0xffff0000u); s += lo * lo + hi * hi; }
            rr[r] = s; }
#pragma unroll
        for (int r = 0; r < 4; ++r) rr[r] = rsqrtf(wave_sum(rr[r]) * (1.f / DM) + RMS_EPS);
#pragma unroll
        for (int j = 0; j < 4; ++j) { const f32x4 g0 = gr[128 * j], g1 = gr[128 * j + 1];
#pragma unroll
            for (int r = 0; r < 4; ++r) { const u32x4 q = v[r][j]; const float k = rr[r];
                const f32x4 o0 = (f32x4){__uint_as_float(q.x << 16) * k * g0.x, __uint_as_float(q.x & 0xffff0000u) * k * g0.y, __uint_as_float(q.y << 16) * k * g0.z, __uint_as_float(q.y & 0xffff0000u) * k * g0.w};
                const f32x4 o1 = (f32x4){__uint_as_float(q.z << 16) * k * g1.x, __uint_as_float(q.z & 0xffff0000u) * k * g1.y, __uint_as_float(q.w << 16) * k * g1.z, __uint_as_float(q.w & 0xffff0000u) * k * g1.w};
                if (OUT_BF16) { u32x4 w; w.x = pk2(o0.x, o0.y); w.y = pk2(o0.z, o0.w); w.z = pk2(o1.x, o1.y); w.w = pk2(o1.z, o1.w); *((u32x4*)((bf16_t*)Ov + (size_t)mr[r] * DM) + lane + 64 * j) = w; }
                else { f32x4* o = (f32x4*)((float*)Ov + (size_t)mr[r] * DM) + 2 * lane + 128 * j; o[0] = o0; o[1] = o1; } } }
    }
}
__device__ __forceinline__ void rows_rms16(const float* X, const float* gain, bf16_t* O, const int tidv) {
    const int lane = tidv & 63, gw = blockIdx.x * 8 + (tidv >> 6), NGW = gridDim.x * 8;
    const f32x4* gr = (const f32x4*)gain + 2 * lane;
    for (int m = gw; m < T; m += 2 * NGW) {
        const int m2 = m + NGW < T ? m + NGW : m;
        const f32x4* xa = (const f32x4*)(X + (size_t)m * DM) + 2 * lane; const f32x4* xb = (const f32x4*)(X + (size_t)m2 * DM) + 2 * lane;
        f32x4 va[8], vb[8]; float sa = 0.f, sb = 0.f;
#pragma unroll
        for (int j = 0; j < 4; ++j) { va[2 * j] = xa[128 * j]; va[2 * j + 1] = xa[128 * j + 1]; }
#pragma unroll
        for (int j = 0; j < 4; ++j) { vb[2 * j] = xb[128 * j]; vb[2 * j + 1] = xb[128 * j + 1]; }
#pragma unroll
        for (int j = 0; j < 8; ++j) { sa += (va[j].x * va[j].x + va[j].y * va[j].y) + (va[j].z * va[j].z + va[j].w * va[j].w); sb += (vb[j].x * vb[j].x + vb[j].y * vb[j].y) + (vb[j].z * vb[j].z + vb[j].w * vb[j].w); }
        const float ra = rsqrtf(wave_sum(sa) * (1.f / DM) + RMS_EPS), rb = rsqrtf(wave_sum(sb) * (1.f / DM) + RMS_EPS);
        u32x4* oa = (u32x4*)(O + (size_t)m * DM) + lane; u32x4* ob = (u32x4*)(O + (size_t)m2 * DM) + lane;
#pragma unroll
        for (int j = 0; j < 4; ++j) { const f32x4 g0 = gr[128 * j], g1 = gr[128 * j + 1]; u32x4 w;
            w.x = pk2(va[2 * j].x * ra * g0.x, va[2 * j].y * ra * g0.y); w.y = pk2(va[2 * j].z * ra * g0.z, va[2 * j].w * ra * g0.w);
            w.z = pk2(va[2 * j + 1].x * ra * g1.x, va[2 * j + 1].y * ra * g1.y); w.w = pk2(va[2 * j + 1].z * ra * g1.z, va[2 * j + 1].w * ra * g1.w); oa[64 * j] = w;
            w.x = pk2(vb[2 * j].x * rb * g0.x, vb[2 * j].y * rb * g0.y); w.y = pk2(vb[2 * j].z * rb * g0.z, vb[2 * j].w * rb * g0.w);
            w.z = pk2(vb[2 * j + 1].x * rb * g1.x, vb[2 * j + 1].y * rb * g1.y); w.w = pk2(vb[2 * j + 1].z * rb * g1.z, vb[2 * j + 1].w * rb * g1.w); ob[64 * j] = w; }
    }
}
__device__ __forceinline__ void rows_rms_bf16(const float* X, const float* gain, bf16_t* O, const int tidv) { rows_rms2<true>(X, gain, O, tidv); }
__device__ __forceinline__ void rows_rms_f32(const float* X, const float* gain, float* O, const int tidv) { rows_rms2<false>(X, gain, O, tidv); }

__device__ __forceinline__ float gelu_tanh(float x) { const float u = 0.7978845608028654f * (x + 0.044715f * x * x * x); return 0.5f * x * (1.f + tanhf(u)); }
__device__ __forceinline__ void compress_naive(const Params& p, unsigned char* lds_g) {
    const int tid = threadIdx.x;
    const bf16_t* KV = (const bf16_t*)(p.ws + WS_E);
    const float* misc = (const float*)(p.ws + WS_MISC);
    float* xs = (float*)lds_g;
    float* red = xs + 144 * 128;
    float* hid = red + 4 * 8 * 128;
    const int n = tid & 127, part = tid >> 7;
    for (int unit = blockIdx.x; unit < 2 * 16 * 32; unit += gridDim.x) {
        const int which = unit / 512, bg = (unit % 512) / 32, i0 = (unit % 32) * 8, b = bg >> 2, g = bg & 3;
        const bf16_t* src = KV + (size_t)which * ((size_t)T * 512);
        const float* w1 = which ? p.pv_w1 : p.pk_w1; const float* w2 = which ? p.pv_w2 : p.pk_w2; const float* b1n = which ? p.pv_b1 : p.pk_b1; const float* cvp = misc + MISC_CVP / 4 + which * 8 * 128;
        bf16_t* dst = (bf16_t*)(p.ws + (which ? WS_VCMP : WS_KCMP)) + (size_t)bg * NCMPP * 128;
        __syncthreads();
        for (int e = tid; e < 144 * 128; e += 512) { const int tt = e >> 7, d = e & 127; const int tok = 16 * i0 + tt;
            xs[e] = tok < SEQ ? bf2f(src[(size_t)(b * SEQ + tok) * 512 + g * 128 + d]) : 0.f; }
        __syncthreads();
        float acc[8];
#pragma unroll
        for (int k = 0; k < 8; ++k) acc[k] = 0.f;
        for (int r = part * 1024; r < part * 1024 + 1024; ++r) {
            const float w = w1[(size_t)r * 128 + n]; const int j = r >> 7, d = r & 127;
#pragma unroll
            for (int k = 0; k < 8; ++k) acc[k] += xs[(16 * k + j) * 128 + d] * w;
        }
#pragma unroll
        for (int k = 0; k < 8; ++k) red[(part * 8 + k) * 128 + n] = acc[k];
        __syncthreads();
        for (int e = tid; e < 1024; e += 512) { const int k = e >> 7, nn = e & 127;
            float cvs = b1n[nn]; for (int sl = 0; sl < 8; ++sl) cvs += cvp[sl * 128 + nn];
            const float h = cvs + ((red[(0 * 8 + k) * 128 + nn] + red[(1 * 8 + k) * 128 + nn]) + (red[(2 * 8 + k) * 128 + nn] + red[(3 * 8 + k) * 128 + nn]));
            hid[e] = gelu_tanh(h); }
        __syncthreads();
        for (int e = tid; e < 1024; e += 512) { const int k = e >> 7, nn = e & 127; float s = 0.f;
            for (int m = 0; m < 128; ++m) s += hid[k * 128 + m] * w2[m * 128 + nn];
            const int i = i0 + k;
            dst[(size_t)i * 128 + nn] = (bf16_t)(i < NCMP ? f2bf(s) : 0u); }
    }
}

__device__ __forceinline__ void dot4(const bf16_t* krow, const float* qs, float (&a)[4]) {
    a[0] = a[1] = a[2] = a[3] = 0.f;
#pragma unroll 4
    for (int c = 0; c < 16; ++c) { const u32x4 kv = *(const u32x4*)(krow + 8 * c);
        float kf[8]; kf[0] = __uint_as_float(kv.x << 16); kf[1] = __uint_as_float(kv.x & 0xffff0000u); kf[2] = __uint_as_float(kv.y << 16); kf[3] = __uint_as_float(kv.y & 0xffff0000u);
        kf[4] = __uint_as_float(kv.z << 16); kf[5] = __uint_as_float(kv.z & 0xffff0000u); kf[6] = __uint_as_float(kv.w << 16); kf[7] = __uint_as_float(kv.w & 0xffff0000u);
#pragma unroll
        for (int h = 0; h < 4; ++h) { const f32x4 q0 = *(const f32x4*)(qs + h * 128 + 8 * c), q1 = *(const f32x4*)(qs + h * 128 + 8 * c + 4);
            a[h] += (kf[0] * q0.x + kf[1] * q0.y) + (kf[2] * q0.z + kf[3] * q0.w) + (kf[4] * q1.x + kf[5] * q1.y) + (kf[6] * q1.z + kf[7] * q1.w); } }
}
__device__ __forceinline__ void softmax4(f32x4* pl, int n, int lane) {
    const float NINF = -__builtin_inff();
    f32x4 m = {NINF, NINF, NINF, NINF};
    for (int i = lane; i < n; i += 64) { const f32x4 v = pl[i]; m.x = fmaxf(m.x, v.x); m.y = fmaxf(m.y, v.y); m.z = fmaxf(m.z, v.z); m.w = fmaxf(m.w, v.w); }
    m.x = wave_max(m.x); m.y = wave_max(m.y); m.z = wave_max(m.z); m.w = wave_max(m.w);
    f32x4 s = {0.f, 0.f, 0.f, 0.f};
    for (int i = lane; i < n; i += 64) { const f32x4 v = pl[i]; f32x4 e;
        e.x = m.x == NINF ? 0.f : __expf(v.x - m.x); e.y = m.y == NINF ? 0.f : __expf(v.y - m.y); e.z = m.z == NINF ? 0.f : __expf(v.z - m.z); e.w = m.w == NINF ? 0.f : __expf(v.w - m.w);
        pl[i] = e; s += e; }
    s.x = wave_sum(s.x); s.y = wave_sum(s.y); s.z = wave_sum(s.z); s.w = wave_sum(s.w);
    f32x4 inv; inv.x = s.x > 0.f ? 1.f / s.x : 0.f; inv.y = s.y > 0.f ? 1.f / s.y : 0.f; inv.z = s.z > 0.f ? 1.f / s.z : 0.f; inv.w = s.w > 0.f ? 1.f / s.w : 0.f;
    for (int i = lane; i < n; i += 64) pl[i] = pl[i] * inv;
}
__device__ __forceinline__ void pv_acc(const f32x4 pw, unsigned vv, float (&o)[4][2]) {
    const float v0 = __uint_as_float(vv << 16), v1 = __uint_as_float(vv & 0xffff0000u);
    o[0][0] += pw.x * v0; o[0][1] += pw.x * v1; o[1][0] += pw.y * v0; o[1][1] += pw.y * v1; o[2][0] += pw.z * v0; o[2][1] += pw.z * v1; o[3][0] += pw.w * v0; o[3][1] += pw.w * v1;
}
__device__ __forceinline__ void nsa_naive(const Params& p, unsigned char* lds_g, bf16_t* O1) {
    const int tid = threadIdx.x, lane = tid & 63, wave = tid >> 6;
    const bf16_t* Q1 = (const bf16_t*)(p.ws + WS_D); const bf16_t* KV = (const bf16_t*)(p.ws + WS_E); const bf16_t* Z1 = (const bf16_t*)(p.ws + WS_G);
    const float* GT = (const float*)(p.ws + WS_GATES); const bf16_t* KC = (const bf16_t*)(p.ws + WS_KCMP); const bf16_t* VC = (const bf16_t*)(p.ws + WS_VCMP);
    const float* biasp = (const float*)(p.ws + WS_MISC + MISC_BIASP);
    const size_t TS = (size_t)T * 512;
    const bf16_t* KS = KV + 2 * TS; const bf16_t* VS = KV + 3 * TS; const bf16_t* KW = KV + 4 * TS; const bf16_t* VW = KV + 5 * TS;
    float* qs = (float*)(lds_g + wave * 18432);
    f32x4* pl = (f32x4*)(lds_g + wave * 18432 + 2048);
    const float NINF = -__builtin_inff();
    const int gw = blockIdx.x * 8 + wave, NGW = gridDim.x * 8, NU = NB * NG * SEQ, niter = (NU + NGW - 1) / NGW;
    for (int it = 0; it < niter; ++it) {
        int unit = it * NGW + gw; const bool live = unit < NU; if (!live) unit = NU - 1;
        const int bg = unit / SEQ, t = unit % SEQ, b = bg >> 2, g = bg & 3;
        const size_t row = (size_t)b * SEQ + t;
        __syncthreads();
        { const bf16_t* qrow = Q1 + row * DM + g * 512;
          for (int e = lane; e < 512; e += 64) qs[e] = bf2f(qrow[e]); }
        __syncthreads();
        const float* bp = biasp + (g * 4) * 128;
        for (int c = 0; c < 4; ++c) { const int i = lane + 64 * c; float a[4]; dot4(KC + ((size_t)bg * NCMPP + i) * 128, qs, a);
            const int dist = t - (16 * i + 31); const bool valid = (i < NCMP) && dist >= 0;
            f32x4 l = {NINF, NINF, NINF, NINF};
            if (valid) { const bool nr = dist < 128; l.x = a[0] + (nr ? bp[dist] : 0.f); l.y = a[1] + (nr ? bp[128 + dist] : 0.f); l.z = a[2] + (nr ? bp[256 + dist] : 0.f); l.w = a[3] + (nr ? bp[384 + dist] : 0.f); }
            pl[i] = l; }
        __syncthreads();
        softmax4(pl, 256, lane);
        __syncthreads();
        float oc[4][2] = {};
        { const int imax = t >= 31 ? (t - 31) / 16 : -1;
          const unsigned* vb = (const unsigned*)(VC + (size_t)bg * NCMPP * 128) + lane;
#pragma unroll 8
          for (int i = 0; i <= imax; ++i) pv_acc(pl[i], vb[(size_t)i * 64], oc); }
        unsigned long long selmask;
        { const int j = lane; float imp = 0.f;
          for (int i = 4 * j - 1; i <= 4 * j + 3; ++i) if (i >= 0 && i < NCMP) { const f32x4 v = pl[i]; imp += (v.x + v.y) + (v.z + v.w); }
          const int cur = t >> 6; const bool forced = (j == 0) || (j == cur) || (j == cur - 1), visible = (j * 64 <= t);
          const float score = forced ? 1e9f : (visible ? imp : -1e30f);
          int rank = 0;
          for (int jj = 0; jj < 64; ++jj) { const float s2 = __shfl(score, jj); rank += (s2 > score || (s2 == score && jj < j)) ? 1 : 0; }
          selmask = __ballot(rank < 16); }
        __syncthreads();
        { int slot = 0;
          for (int jb = 0; jb < 64; ++jb) { if (!((selmask >> jb) & 1ull)) continue;
              const int pos = jb * 64 + lane; float a[4]; dot4(KS + ((size_t)b * SEQ + pos) * 512 + g * 128, qs, a);
              const int dist = t - pos; f32x4 l = {NINF, NINF, NINF, NINF};
              if (dist >= 0) { const bool nr = dist < 128; l.x = a[0] + (nr ? bp[dist] : 0.f); l.y = a[1] + (nr ? bp[128 + dist] : 0.f); l.z = a[2] + (nr ? bp[256 + dist] : 0.f); l.w = a[3] + (nr ? bp[384 + dist] : 0.f); }
              pl[slot * 64 + lane] = l; ++slot; } }
        __syncthreads();
        softmax4(pl, 1024, lane);
        __syncthreads();
        float os[4][2] = {};
        { int slot = 0;
          for (int jb = 0; jb < 64; ++jb) { if (!((selmask >> jb) & 1ull)) continue;
              if (jb * 64 <= t) { const unsigned* vb = (const unsigned*)(VS + ((size_t)b * SEQ + jb * 64) * 512 + g * 128) + lane;
#pragma unroll 8
                  for (int kk = 0; kk < 64; ++kk) pv_acc(pl[slot * 64 + kk], vb[(size_t)kk * 256], os); }
              ++slot; } }
        __syncthreads();
        for (int c = 0; c < 8; ++c) { const int m = lane + 64 * c, pos = t - 511 + m; const int pc = pos < 0 ? 0 : pos; float a[4]; dot4(KW + ((size_t)b * SEQ + pc) * 512 + g * 128, qs, a);
            const int dist = 511 - m; f32x4 l = {NINF, NINF, NINF, NINF};
            if (pos >= 0) { const bool nr = dist < 128; l.x = a[0] + (nr ? bp[dist] : 0.f); l.y = a[1] + (nr ? bp[128 + dist] : 0.f); l.z = a[2] + (nr ? bp[256 + dist] : 0.f); l.w = a[3] + (nr ? bp[384 + dist] : 0.f); }
            pl[m] = l; }
        __syncthreads();
        softmax4(pl, 512, lane);
        __syncthreads();
        float ow[4][2] = {};
        { const int m0 = t >= 511 ? 0 : 511 - t;
          const unsigned* vb = (const unsigned*)(VW + ((size_t)b * SEQ) * 512 + g * 128) + lane;
#pragma unroll 8
          for (int m = m0; m < 512; ++m) pv_acc(pl[m], vb[(size_t)(t - 511 + m) * 256], ow); }
        if (live) {
            const float* gt = GT + row * 48 + g * 12;
#pragma unroll
            for (int h = 0; h < 4; ++h) { const float gc = gate_of(gt + h * 3 + 0), gs = gate_of(gt + h * 3 + 1), gwn = gate_of(gt + h * 3 + 2);
                const unsigned zv = ((const unsigned*)(Z1 + row * DM + (g * 4 + h) * 128))[lane];
                const float z0 = __uint_as_float(zv << 16), z1 = __uint_as_float(zv & 0xffff0000u);
                const float r0 = (gc * oc[h][0] + gs * os[h][0] + gwn * ow[h][0]) * z0, r1 = (gc * oc[h][1] + gs * os[h][1] + gwn * ow[h][1]) * z1;
                ((unsigned*)(O1 + row * DM + (g * 4 + h) * 128))[lane] = pk2(r0, r1); }
        }
    }
}

__device__ __forceinline__ void compress_mfma(const Params& p, unsigned char* lds_g) {
    LAS unsigned char* L = (LAS unsigned char*)lds_g;
    const int tid = threadIdx.x, lane = tid & 63, wave = __builtin_amdgcn_readfirstlane(tid >> 6), r32 = lane & 31, hi = lane >> 5;
    const bf16_t* KV = (const bf16_t*)(p.ws + WS_E);
    const float* misc = (const float*)(p.ws + WS_MISC);
    constexpr int HRS = 272;
    const int nt = wave & 3, kh = wave >> 2;
    for (int unit = blockIdx.x; unit < 2 * 16 * 8; unit += gridDim.x) {
        const int which = unit >> 7, bg = (unit >> 3) & 15, i0 = (unit & 7) * 32, b = bg >> 2, g = bg & 3;
        const bf16_t* src = KV + (size_t)which * ((size_t)T * 512) + ((size_t)b * SEQ) * 512 + g * 128;
        const bf16_t* w1t = (const bf16_t*)(p.ws + (which ? WS_W1V : WS_W1K)); const bf16_t* w2t = (const bf16_t*)(p.ws + (which ? WS_W2V : WS_W2K));
        bf16_t* dst = (bf16_t*)(p.ws + (which ? WS_VCMP : WS_KCMP)) + (size_t)bg * NCMPP * 128;
        f32x16 acc;
#pragma unroll
        for (int i = 0; i < 16; ++i) acc[i] = 0.f;
        const bf16_t* arow = src + (size_t)(16 * (i0 + r32)) * 512 + 8 * hi;
        const bf16_t* brow = w1t + (size_t)(32 * nt + r32) * 4096 + 8 * hi;
        for (int sb_ = 128 * kh; sb_ < 128 * kh + 128; sb_ += 16) {
            bf16x8 fa[16], fb[16];
#pragma unroll
            for (int u = 0; u < 16; ++u) { const int s2 = sb_ + u, j = s2 >> 3, d0 = (s2 & 7) * 16; fa[u] = *(const bf16x8*)(arow + (size_t)j * 512 + d0); fb[u] = *(const bf16x8*)(brow + 16 * s2); }
            __builtin_amdgcn_sched_barrier(0);
#pragma unroll
            for (int u = 0; u < 16; ++u) acc = __builtin_amdgcn_mfma_f32_32x32x16_bf16(fa[u], fb[u], acc, 0, 0, 0);
            __builtin_amdgcn_sched_barrier(0);
        }
        __syncthreads();
        if (kh == 1) {
#pragma unroll
            for (int q = 0; q < 16; ++q) *(LAS float*)(L + 16384 + ((nt * 16 + q) * 64 + lane) * 4) = acc[q];
        }
        __syncthreads();
        if (kh == 0) {
            const float* b1 = which ? p.pv_b1 : p.pk_b1; const int n = 32 * nt + r32;
            float cv = b1[n];
#pragma unroll
            for (int sl = 0; sl < 8; ++sl) cv += misc[MISC_CVP / 4 + (which * 8 + sl) * 128 + n];
#pragma unroll
            for (int q = 0; q < 16; ++q) { const float h = acc[q] + *(const LAS float*)(L + 16384 + ((nt * 16 + q) * 64 + lane) * 4) + cv;
                *(LAS bf16_t*)(L + crow(q, hi) * HRS + n * 2) = (bf16_t)f2bf(gelu_tanh(h)); }
        }
        __syncthreads();
        if (kh == 0) {
            f32x16 o;
#pragma unroll
            for (int i = 0; i < 16; ++i) o[i] = 0.f;
#pragma unroll
            for (int s2 = 0; s2 < 8; ++s2) { const bf16x8 a = *(const LAS bf16x8*)(L + r32 * HRS + 32 * s2 + 16 * hi);
                const bf16x8 bb = *(const bf16x8*)(w2t + (size_t)(32 * nt + r32) * 128 + 16 * s2 + 8 * hi);
                o = __builtin_amdgcn_mfma_f32_32x32x16_bf16(a, bb, o, 0, 0, 0); }
#pragma unroll
            for (int q = 0; q < 16; ++q) { const int i = i0 + crow(q, hi); dst[(size_t)i * 128 + 32 * nt + r32] = (bf16_t)(i < NCMP ? f2bf(o[q]) : 0u); }
        }
    }
}

namespace at {
constexpr int SHM = 16384, BUF = 38912;
constexpr int L_V = 0, L_K = 16384, L_WS = 32768, L_BIAS = 34816, L_V1 = 38912, L_K1 = 55296, L_SEL = 71680, L_Q = 72192, L_IMP = L_Q + 65536, L_GT = L_IMP + 16384, L_END = L_GT + 8 * 64 * 4 * 4;
constexpr float LOG2E = 1.4426950408889634f;
constexpr float SM_THR = 8.f;
#define KSWZ(row, colB) ((row) * 256 + ((colB) ^ (((row) & 15) << 4)))
#define SBAR() __builtin_amdgcn_sched_barrier(0)
__device__ __forceinline__ int v_rd_base(int lane) { return ((lane & 3) << 3) | (((lane >> 2) & 3) << 6) | (((lane >> 4) & 1) << 5) | (((lane >> 5) & 1) << 8); }
constexpr int v_rd_off(int d0, int ks, int half) { return d0 * 512 + ks * 4096 + half * 2048; }
typedef short s16x4 __attribute__((ext_vector_type(4)));
__device__ __forceinline__ unsigned cvtpk(float lo, float hi) { unsigned r; asm volatile("v_cvt_pk_bf16_f32 %0, %1, %2" : "=v"(r) : "v"(lo), "v"(hi)); return r; }
struct DmaMap { int kr0, kc0, kr1, kc1, vr0, vc0, vr1, vc1; };
__device__ __forceinline__ DmaMap dma_map(int tid) {
    DmaMap m;
    { const int P = tid * 16, row = P >> 8; m.kr0 = row; m.kc0 = ((((P & 255) >> 4) ^ (row & 15))) * 8; m.kr1 = row + 32; m.kc1 = m.kc0; }
    { const int P = tid * 16, st = P >> 9, w = (P & 511) >> 1, kk = (st >> 2) * 8 + (w >> 5); m.vr0 = (kk & ~0xC) | ((kk & 4) << 1) | ((kk & 8) >> 1); m.vc0 = (st & 3) * 32 + (w & 31); }
    { const int P = tid * 16 + 8192, st = P >> 9, w = (P & 511) >> 1, kk = (st >> 2) * 8 + (w >> 5); m.vr1 = (kk & ~0xC) | ((kk & 4) << 1) | ((kk & 8) >> 1); m.vc1 = (st & 3) * 32 + (w & 31); }
    return m;
}
template <int VAR = 0>
__device__ __forceinline__ void dma_k(LAS unsigned char* Lb, const DmaMap& m, const bf16_t* Kp, int ld, int wave) {
    if constexpr ((VAR & 16) != 0) return;
    int o0 = m.kr0 * ld + m.kc0, o1 = m.kr1 * ld + m.kc1; asm volatile("" : "+v"(o0), "+v"(o1));
    __builtin_amdgcn_global_load_lds((const unsigned*)(Kp + o0), (LAS unsigned*)(Lb + L_K + wave * 1024), 16, 0, 0);
    __builtin_amdgcn_global_load_lds((const unsigned*)(Kp + o1), (LAS unsigned*)(Lb + L_K + wave * 1024 + 8192), 16, 0, 0);
}
template <int VAR = 0>
__device__ __forceinline__ void dma_v(LAS unsigned char* Lb, const DmaMap& m, const bf16_t* Vp, int ld, int wave) {
    if constexpr ((VAR & 16) != 0) return;
    int o0 = m.vr0 * ld + m.vc0, o1 = m.vr1 * ld + m.vc1; asm volatile("" : "+v"(o0), "+v"(o1));
    __builtin_amdgcn_global_load_lds((const unsigned*)(Vp + o0), (LAS unsigned*)(Lb + L_V + wave * 1024), 16, 0, 0);
    __builtin_amdgcn_global_load_lds((const unsigned*)(Vp + o1), (LAS unsigned*)(Lb + L_V + wave * 1024 + 8192), 16, 0, 0);
}
#define TILE_SYNC() do { asm volatile("s_waitcnt vmcnt(0) lgkmcnt(0)" ::: "memory"); if constexpr ((VAR & 8) == 0) __builtin_amdgcn_s_barrier(); asm volatile("" ::: "memory"); } while (0)
__device__ __forceinline__ int next_bit(unsigned long long m, int from) {
    const unsigned long long m2 = from >= 64 ? 0ull : (m & (~0ull << from));
    return m2 ? (int)__builtin_ctzll(m2) : -1;
}
template <int VAR, bool NEAR>
__device__ __forceinline__ void qkt_(f32x16& p0, f32x16& p1, int kaddr, int r32, int hi, const bf16x8* qr, const LAS float* bp) {
    if constexpr (NEAR) {
#pragma unroll
        for (int r = 0; r < 16; ++r) { const int c = (r & 3) + 8 * (r >> 2); p0[r] = bp[63 - c]; p1[r] = bp[31 - c]; }
    }
    int ka[4];
#pragma unroll
    for (int dd = 0; dd < 4; ++dd) ka[dd] = kaddr + KSWZ(r32, (dd * 16 + hi * 8) * 2);
    const int h1 = 128 - ((r32 & 8) << 5);
    bf16x8 kA[2][2], kB[2][2];
#define KRD(dst, a, off) asm volatile("ds_read_b128 %0, %1 offset:%2" : "=&v"(dst) : "v"(a), "i"(off) : "memory")
#define LOADG(G, K_) do { _Pragma("unroll") for (int e = 0; e < 2; ++e) { const int d0 = 2 * (G) + e; KRD(K_[e][0], ka[d0 & 3], 0); KRD(K_[e][1], ka[d0 & 3], 8192); } } while (0)
#define MMA1(G, e, K_, C0, C1) do { p0 = __builtin_amdgcn_mfma_f32_32x32x16_bf16(K_[e][0], qr[2 * (G) + e], C0, 0, 0, 0); p1 = __builtin_amdgcn_mfma_f32_32x32x16_bf16(K_[e][1], qr[2 * (G) + e], C1, 0, 0, 0); } while (0)
#define LGK(N) asm volatile("s_waitcnt lgkmcnt(" #N ")" ::: "memory")
    const f32x16 z16 = {0.f, 0.f, 0.f, 0.f, 0.f, 0.f, 0.f, 0.f, 0.f, 0.f, 0.f, 0.f, 0.f, 0.f, 0.f, 0.f};
    LOADG(0, kA); LOADG(1, kB);
#pragma unroll
    for (int dd = 0; dd < 4; ++dd) ka[dd] += h1;
    LGK(4); SBAR();
    if constexpr (NEAR) MMA1(0, 0, kA, p0, p1); else MMA1(0, 0, kA, z16, z16);
    MMA1(0, 1, kA, p0, p1); SBAR();
    LOADG(2, kA); LGK(4); SBAR();
    MMA1(1, 0, kB, p0, p1); MMA1(1, 1, kB, p0, p1); SBAR();
    LOADG(3, kB); LGK(4); SBAR();
    MMA1(2, 0, kA, p0, p1); MMA1(2, 1, kA, p0, p1); SBAR();
    LGK(0); SBAR();
    MMA1(3, 0, kB, p0, p1); MMA1(3, 1, kB, p0, p1);
#undef LGK
#undef MMA1
#undef LOADG
#undef KRD
}
template <int VAR = 0>
__device__ __forceinline__ void qkt(f32x16& p0, f32x16& p1, const LAS unsigned char* Kl, int r32, int hi, const bf16x8* qr, bool near = false, const LAS float* bp = nullptr) {
    const int kaddr = (int)(size_t)Kl;
    if (near) qkt_<VAR, true>(p0, p1, kaddr, r32, hi, qr, bp); else qkt_<VAR, false>(p0, p1, kaddr, r32, hi, qr, bp);
}
__device__ __forceinline__ void pv_tile(f32x16* o, int vb0, bf16x8 pa0, bf16x8 pa1, bf16x8 pa2, bf16x8 pa3) {
#define TRRD(dst, off) asm volatile("ds_read_b64_tr_b16 %0, %1 offset:%2" : "=&v"(dst) : "v"(vb0), "i"(off) : "memory")
#define PV_RD(d0, X) do { constexpr int b_ = v_rd_off(d0, 0, 0); \
        TRRD(X[0], b_); TRRD(X[1], b_ + 2048); TRRD(X[2], b_ + 4096); TRRD(X[3], b_ + 6144); TRRD(X[4], b_ + 8192); TRRD(X[5], b_ + 10240); TRRD(X[6], b_ + 12288); TRRD(X[7], b_ + 14336); } while (0)
#define PV_MM(d0, X) do { \
        o[d0] = __builtin_amdgcn_mfma_f32_32x32x16_bf16(pa0, (bf16x8){X[0][0], X[0][1], X[0][2], X[0][3], X[1][0], X[1][1], X[1][2], X[1][3]}, o[d0], 0, 0, 0); \
        o[d0] = __builtin_amdgcn_mfma_f32_32x32x16_bf16(pa1, (bf16x8){X[2][0], X[2][1], X[2][2], X[2][3], X[3][0], X[3][1], X[3][2], X[3][3]}, o[d0], 0, 0, 0); \
        o[d0] = __builtin_amdgcn_mfma_f32_32x32x16_bf16(pa2, (bf16x8){X[4][0], X[4][1], X[4][2], X[4][3], X[5][0], X[5][1], X[5][2], X[5][3]}, o[d0], 0, 0, 0); \
        o[d0] = __builtin_amdgcn_mfma_f32_32x32x16_bf16(pa3, (bf16x8){X[6][0], X[6][1], X[6][2], X[6][3], X[7][0], X[7][1], X[7][2], X[7][3]}, o[d0], 0, 0, 0); } while (0)
#define LGK(N) asm volatile("s_waitcnt lgkmcnt(" #N ")" ::: "memory")
    s16x4 xa[8], xb[8];
    PV_RD(0, xa); PV_RD(1, xb);
    LGK(8); SBAR(); PV_MM(0, xa); SBAR(); PV_RD(2, xa);
    LGK(8); SBAR(); PV_MM(1, xb); SBAR(); PV_RD(3, xb);
    LGK(8); SBAR(); PV_MM(2, xa); SBAR();
    LGK(0); SBAR(); PV_MM(3, xb);
#undef LGK
#undef PV_MM
#undef PV_RD
#undef TRRD
}
__device__ __forceinline__ void bias_mask(f32x16& p0, f32x16& p1, int dq, unsigned W, bool needmask, int hi) {
    const float NEG = -__builtin_inff();
    const int dq4 = dq - 4 * hi;
    if (needmask) {
#pragma unroll
        for (int r = 0; r < 16; ++r) { const int c = (r & 3) + 8 * (r >> 2);
            if ((unsigned)(dq4 - c) >= W) p0[r] = NEG;
            if ((unsigned)(dq4 - c - 32) >= W) p1[r] = NEG; }
    }
}
__device__ __forceinline__ void bias_mask_cmp(f32x16& p0, f32x16& p1, int dq, int dd, const LAS float* blx, int hi, bool needbias, bool needmask) {
    const float NEG = -__builtin_inff();
    const int dq4 = dq - 4 * hi, dd4 = dd - 64 * hi;
    if (needbias) {
        float bv[16];
#pragma unroll
        for (int r = 0; r < 16; ++r) { const int c = (r & 3) + 8 * (r >> 2); bv[r] = blx[64 + ((dd4 - 16 * c) & 127)]; }
        SBAR();
#pragma unroll
        for (int r = 0; r < 16; ++r) { const int c = (r & 3) + 8 * (r >> 2); p0[r] += ((unsigned)(dd4 - 16 * c) < 128u) ? bv[r] : 0.f; }
        SBAR();
#pragma unroll
        for (int r = 0; r < 16; ++r) { const int c = (r & 3) + 8 * (r >> 2); bv[r] = blx[64 + ((dd4 - 16 * c - 512) & 127)]; }
        SBAR();
#pragma unroll
        for (int r = 0; r < 16; ++r) { const int c = (r & 3) + 8 * (r >> 2); p1[r] += ((unsigned)(dd4 - 16 * c - 512) < 128u) ? bv[r] : 0.f; }
    }
    if (needmask) {
#pragma unroll
        for (int r = 0; r < 16; ++r) { const int c = (r & 3) + 8 * (r >> 2);
            if (c > dq4) p0[r] = NEG;
            if (c + 32 > dq4) p1[r] = NEG; }
    }
}
template <int CTRL> __device__ __forceinline__ float quad_perm(float v) { return __uint_as_float((unsigned)__builtin_amdgcn_update_dpp(0, (int)__float_as_uint(v), CTRL, 0xF, 0xF, true)); }
__device__ __forceinline__ float rowmax32(const f32x16& p0, const f32x16& p1) {
    float pmax = p0[0];
#pragma unroll
    for (int r = 1; r < 16; ++r) pmax = fmaxf(pmax, p0[r]);
#pragma unroll
    for (int r = 0; r < 16; ++r) pmax = fmaxf(pmax, p1[r]);
    auto rr = __builtin_amdgcn_permlane32_swap(__float_as_uint(pmax), __float_as_uint(pmax), false, false);
    return fmaxf(__uint_as_float(rr[0]), __uint_as_float(rr[1]));
}
__device__ __forceinline__ float halfswap_add(float ps) {
    auto rr = __builtin_amdgcn_permlane32_swap(__float_as_uint(ps), __float_as_uint(ps), false, false);
    return __uint_as_float(rr[0]) + __uint_as_float(rr[1]);
}
#define EXP_PK4(P, B_, OUT) do { _Pragma("unroll") for (int e_ = 0; e_ < 8; ++e_) { P[B_ + e_] = (VAR & 1) ? fmaf(P[B_ + e_], LOG2E, mnL) : __builtin_amdgcn_exp2f(fmaf(P[B_ + e_], LOG2E, mnL)); ps += P[B_ + e_]; } \
        unsigned a0 = cvtpk(P[B_ + 0], P[B_ + 1]), a1 = cvtpk(P[B_ + 2], P[B_ + 3]); \
        unsigned b0 = cvtpk(P[B_ + 4], P[B_ + 5]), b1 = cvtpk(P[B_ + 6], P[B_ + 7]); \
        auto r0 = __builtin_amdgcn_permlane32_swap(a0, b0, false, false); auto r1 = __builtin_amdgcn_permlane32_swap(a1, b1, false, false); \
        u32x4 w = {r0[0], r1[0], r0[1], r1[1]}; OUT = *reinterpret_cast<bf16x8*>(&w); } while (0)
template <int VAR = 0>
__device__ __forceinline__ void sm_pv(f32x16& p0, f32x16& p1, float& m_reg, float& l_reg, f32x16* o, int vb, LAS float* al, int r32, int hi, bool rowsel = true) {
    const float pmax = rowsel ? rowmax32(p0, p1) : -__builtin_inff();
    float alpha = 1.f;
    if (!__all(pmax - m_reg <= SM_THR)) {
        const float mn = fmaxf(m_reg, pmax);
        alpha = __builtin_amdgcn_exp2f((m_reg - mn) * LOG2E); m_reg = mn;
        if (hi == 0) al[r32] = alpha; asm volatile("s_waitcnt lgkmcnt(0)" ::: "memory");
        float av[16];
#pragma unroll
        for (int r = 0; r < 16; ++r) av[r] = al[crow(r, hi)];
        SBAR();
#pragma unroll
        for (int d_ = 0; d_ < 4; ++d_)
#pragma unroll
            for (int r = 0; r < 16; ++r) o[d_][r] *= av[r]; }
    const float mnL = rowsel ? -m_reg * LOG2E : -__builtin_inff();
    float ps = 0.f;
    bf16x8 pa0, pa1, pa2, pa3;
    EXP_PK4(p0, 0, pa0); EXP_PK4(p0, 8, pa1); EXP_PK4(p1, 0, pa2); EXP_PK4(p1, 8, pa3);
    l_reg = l_reg * alpha + halfswap_add(ps);
    SBAR();
    if constexpr ((VAR & 2) == 0) pv_tile(o, vb, pa0, pa1, pa2, pa3);
    else { asm volatile("" :: "v"(pa0), "v"(pa1), "v"(pa2), "v"(pa3)); }
}
}

template <int VAR = 0>
__device__ __forceinline__ void nsa_fused(const Params& p, unsigned char* lds_g, bf16_t* O1, const int tidv) {
    using namespace at;
    LAS unsigned char* L = (LAS unsigned char*)lds_g;
    const int tid = tidv, lane = tid & 63, wave = __builtin_amdgcn_readfirstlane(tid >> 6), r32 = lane & 31, hi = lane >> 5;
    const bf16_t* Q1 = (const bf16_t*)(p.ws + WS_D); const bf16_t* KV = (const bf16_t*)(p.ws + WS_E); const bf16_t* Z1 = (const bf16_t*)(p.ws + WS_G);
    const float* GT = (const float*)(p.ws + WS_GATES); const bf16_t* KC = (const bf16_t*)(p.ws + WS_KCMP); const bf16_t* VC = (const bf16_t*)(p.ws + WS_VCMP);
    const float* biasp = (const float*)(p.ws + WS_MISC + MISC_BIASP);
    const size_t TS = (size_t)T * 512;
    LAS float* wsf = (LAS float*)(L + L_WS) + wave * 64;
    LAS float* blw = (LAS float*)(L + L_BIAS);
    LAS float* impS = (LAS float*)(L + L_IMP);
    LAS unsigned* totL = (LAS unsigned*)(L + L_Q) + wave * 2048 + lane;
    LAS unsigned long long* selS = (LAS unsigned long long*)(L + L_SEL);
    const int vb0 = (int)(size_t)(L + L_V) + v_rd_base(lane);
    const int hh = r32 & 3, tl = r32 >> 2;
    const LAS float* bl = blw + hh * 256;
    const DmaMap dm = dma_map(tid);
    const int G = gridDim.x;
    if (wave >= 4) __builtin_amdgcn_s_setprio(1);
    for (int it = blockIdx.x; it < 16 * 32; it += G) {
        int bg, y;
        if (G == 256) { const int xcd = it & 7, q = it >> 3; bg = (xcd * 2 + (q / 32)) & 15; y = q % 32; } else { bg = it / 32; y = it % 32; }
        const int b = bg >> 2, g = bg & 3;
        __syncthreads();
        for (int e = tid; e < 1024; e += 512) { const int d_ = (e & 255) - 64; blw[e] = (d_ >= 0 && d_ < 128) ? biasp[(g * 4 + (e >> 8)) * 128 + d_] : 0.f; }
        for (int pass = 0; pass < 2; ++pass) {
            const int x = pass ? 63 - y : y;
            const int t0 = 64 * x, t = t0 + 8 * wave + tl;
            const size_t row = (size_t)b * SEQ + t;
            const bf16_t* Kb = KV + ((size_t)b * SEQ) * 512 + g * 128;
            const bf16_t* KCb = KC + (size_t)bg * NCMPP * 128; const bf16_t* VCb = VC + (size_t)bg * NCMPP * 128;
            __syncthreads();
            dma_k<VAR>(L, dm, KCb, 128, wave);
            bf16x8 qr[8];
            int qlo_ = lane; asm volatile("" : "+v"(qlo_)); qlo_ = (qlo_ & 3) * 128 + (qlo_ >> 5) * 8;
#pragma unroll
            for (int d0 = 0; d0 < 8; ++d0) qr[d0] = *(const bf16x8*)(Q1 + row * DM + (g * 4) * 128 + qlo_ + d0 * 16);
            LAS float* gtS = (LAS float*)(L + L_GT) + (wave * 64 + lane) * 4;
            { const float* gp_ = GT + row * 48 + (g * 4 + hh) * 3; float gq_[3][4];
#pragma unroll
              for (int c_ = 0; c_ < 3; ++c_)
#pragma unroll
                  for (int k_ = 0; k_ < 4; ++k_) gq_[c_][k_] = gp_[(size_t)k_ * T * 48 + c_];
#pragma unroll
              for (int c_ = 0; c_ < 3; ++c_) gtS[c_] = sigmoidf_((gq_[c_][0] + gq_[c_][1]) + (gq_[c_][2] + gq_[c_][3])); }
            __builtin_amdgcn_s_waitcnt(0x0F70);
            f32x16 o[4]; f32x16 p0, p1; float m_reg, l_reg;
#define BRANCH_INIT() do { m_reg = -1e30f; l_reg = 0.f; _Pragma("unroll") for (int d_ = 0; d_ < 4; ++d_) _Pragma("unroll") for (int r = 0; r < 16; ++r) o[d_][r] = 0.f; } while (0)
#define BRANCH_END(cidx, FIRST) do { \
            if (hi == 0) { wsf[r32] = l_reg > 0.f ? gtS[cidx] / l_reg : 0.f; } \
            asm volatile("s_waitcnt lgkmcnt(0)" ::: "memory"); \
            _Pragma("unroll") for (int r = 0; r < 8; ++r) { const float sc0_ = wsf[crow(2 * r, hi)], sc1_ = wsf[crow(2 * r + 1, hi)]; \
                _Pragma("unroll") for (int d_ = 0; d_ < 4; ++d_) { const unsigned tp_ = (FIRST) ? 0u : totL[(d_ * 8 + r) * 64]; \
                    totL[(d_ * 8 + r) * 64] = cvtpk(__uint_as_float(tp_ << 16) + o[d_][2 * r] * sc0_, __uint_as_float(tp_ & 0xffff0000u) + o[d_][2 * r + 1] * sc1_); } } \
            asm volatile("s_waitcnt lgkmcnt(0)" ::: "memory"); } while (0)
            const int ncmp_t = (VAR & 128) ? 0 : (4 * x + 2) / 64 + 1;
            const int ic = (t - 31) >> 4;
            int buf = 0;
            BRANCH_INIT();
            TILE_SYNC();
            for (int tt = 0; tt < ncmp_t; ++tt) {
                LAS unsigned char* Lb = L + buf * BUF; LAS unsigned char* Ln = L + (buf ^ 1) * BUF;
                if (tt + 1 < ncmp_t) dma_k<VAR>(Ln, dm, KCb + (size_t)(tt + 1) * 64 * 128, 128, wave);
                else { dma_k<VAR>(Ln, dm, KCb, 128, wave); dma_v<VAR>(Ln, dm, VCb, 128, wave); }
                qkt<VAR>(p0, p1, Lb + L_K, r32, hi, qr);
                bias_mask_cmp(p0, p1, ic - 64 * tt, t - 31 - 1024 * tt, bl, hi, (t0 + 8 * wave - 31) - 16 * (64 * tt + 63) < 128, 64 * tt + 63 > ((t0 + 8 * wave - 31) >> 4));
                const float pmax = rowmax32(p0, p1); const float mn = fmaxf(m_reg, pmax); const float alpha = __builtin_amdgcn_exp2f((m_reg - mn) * LOG2E); m_reg = mn;
                const float mnL = -mn * LOG2E; float ps = 0.f;
#pragma unroll
                for (int r = 0; r < 16; ++r) { ps += __builtin_amdgcn_exp2f(fmaf(p0[r], LOG2E, mnL)); ps += __builtin_amdgcn_exp2f(fmaf(p1[r], LOG2E, mnL)); }
                l_reg = l_reg * alpha + halfswap_add(ps);
                TILE_SYNC(); buf ^= 1;
            }
            const float m_c = m_reg, l_c = l_reg, il_c = l_c > 0.f ? 1.f / l_c : 0.f; float imp_carry = 0.f;
            for (int tt = 0; tt < ncmp_t; ++tt) {
                LAS unsigned char* Lb = L + buf * BUF; LAS unsigned char* Ln = L + (buf ^ 1) * BUF;
                if (tt + 1 < ncmp_t) { dma_k<VAR>(Ln, dm, KCb + (size_t)(tt + 1) * 64 * 128, 128, wave); dma_v<VAR>(Ln, dm, VCb + (size_t)(tt + 1) * 64 * 128, 128, wave); }
                qkt<VAR>(p0, p1, Lb + L_K, r32, hi, qr);
                bias_mask_cmp(p0, p1, ic - 64 * tt, t - 31 - 1024 * tt, bl, hi, (t0 + 8 * wave - 31) - 16 * (64 * tt + 63) < 128, 64 * tt + 63 > ((t0 + 8 * wave - 31) >> 4));
                const float mnL = -m_c * LOG2E;
#pragma unroll
                for (int r = 0; r < 16; ++r) { p0[r] = __builtin_amdgcn_exp2f(fmaf(p0[r], LOG2E, mnL)); p1[r] = __builtin_amdgcn_exp2f(fmaf(p1[r], LOG2E, mnL)); }
                { float qa[8], xo[8];
#pragma unroll
                  for (int gq = 0; gq < 8; ++gq) { const int rb = (gq & 3) * 4;
                      float qs_ = gq < 4 ? (p0[rb] + p0[rb + 1]) + (p0[rb + 2] + p0[rb + 3]) : (p1[rb] + p1[rb + 1]) + (p1[rb + 2] + p1[rb + 3]);
                      float ls_ = gq < 4 ? p0[rb + 3] : p1[rb + 3];
                      qs_ *= il_c; ls_ *= il_c;
                      qs_ += quad_perm<0xB1>(qs_); qs_ += quad_perm<0x4E>(qs_); ls_ += quad_perm<0xB1>(ls_); ls_ += quad_perm<0x4E>(ls_);
                      qa[gq] = qs_; { auto rr_ = __builtin_amdgcn_permlane32_swap(__float_as_uint(ls_), __float_as_uint(ls_), false, false); xo[gq] = __uint_as_float(hi ? rr_[0] : rr_[1]); } }
#pragma unroll
                  for (int gq = 0; gq < 8; ++gq) { const float prev = hi ? xo[gq] : (gq ? xo[gq - 1] : imp_carry);
                      if (hh == 0) impS[(8 * wave + tl) * 64 + 16 * tt + 2 * gq + hi] = qa[gq] + prev; }
                  imp_carry = xo[7]; }
                bf16x8 pa0, pa1, pa2, pa3;
#define PK4(P, B_, OUT) do { unsigned a0 = cvtpk(P[B_ + 0], P[B_ + 1]), a1 = cvtpk(P[B_ + 2], P[B_ + 3]); \
        unsigned b0 = cvtpk(P[B_ + 4], P[B_ + 5]), b1 = cvtpk(P[B_ + 6], P[B_ + 7]); \
        auto r0 = __builtin_amdgcn_permlane32_swap(a0, b0, false, false); auto r1 = __builtin_amdgcn_permlane32_swap(a1, b1, false, false); \
        u32x4 w = {r0[0], r1[0], r0[1], r1[1]}; OUT = *reinterpret_cast<bf16x8*>(&w); } while (0)
                PK4(p0, 0, pa0); PK4(p0, 8, pa1); PK4(p1, 0, pa2); PK4(p1, 8, pa3); SBAR();
#undef PK4
                pv_tile(o, vb0 + buf * BUF, pa0, pa1, pa2, pa3);
                TILE_SYNC(); buf ^= 1;
            }
            l_reg = l_c;
            { LAS unsigned char* Lb = L + buf * BUF; dma_k<VAR>(Lb, dm, Kb + 2 * TS, 512, wave); dma_v<VAR>(Lb, dm, Kb + 3 * TS, 512, wave); }
            if (x < 16) { if (lane == 0) { for (int i = 0; i < 8; ++i) selS[8 * wave + i] = ~0ull; } }
            else {
                int ia = (8 * wave * 64 + lane) * 4; asm volatile("" : "+v"(ia));
                const LAS float* ip = (const LAS float*)((LAS unsigned char*)impS + ia);
                const int j = lane;
                const bool forced = (j == 0) || (j == x) || (j == x - 1), visible = j <= x;
                unsigned key[8], thr[8];
#pragma unroll
                for (int i = 0; i < 8; ++i) { const float imp = ip[i * 64];
                    key[i] = forced ? 0xffffffffu : (visible ? __float_as_uint(imp) + 1u : 0u); thr[i] = 0u; }
#pragma unroll 1
                for (int bit = 31; bit >= 0; --bit) {
#pragma unroll
                    for (int i = 0; i < 8; ++i) { const unsigned c = thr[i] | (1u << bit); if (__popcll(__ballot(key[i] >= c)) >= 16) thr[i] = c; } }
#pragma unroll
                for (int i = 0; i < 8; ++i) {
                    const unsigned long long gt = __ballot(key[i] > thr[i]), eq = __ballot(key[i] == thr[i]);
                    const int need = 16 - __popcll(gt);
                    const bool pick = (key[i] > thr[i]) || ((key[i] == thr[i]) && (__popcll(eq & ((1ull << j) - 1ull)) < need));
                    const unsigned long long mk = __ballot(pick);
                    if (lane == 0) selS[8 * wave + i] = mk; }
            }
            TILE_SYNC();
            unsigned long long um = 0ull, wm = 0ull;
            for (int i = 0; i < 64; ++i) { const unsigned long long v = selS[i]; um |= v; if ((i >> 3) == wave) wm |= v; }
            const unsigned long long mym = selS[8 * wave + tl];
            um &= (x >= 63) ? ~0ull : ((1ull << (x + 1)) - 1ull);
            um = ((unsigned long long)__builtin_amdgcn_readfirstlane((unsigned)(um >> 32)) << 32) | (unsigned)__builtin_amdgcn_readfirstlane((unsigned)um);
            wm = ((unsigned long long)__builtin_amdgcn_readfirstlane((unsigned)(wm >> 32)) << 32) | (unsigned)__builtin_amdgcn_readfirstlane((unsigned)wm);
            int j = 0;
            if constexpr ((VAR & 256) != 0) j = -1;
            BRANCH_END(0, true);
            BRANCH_INIT();
            TILE_SYNC();
            while (j >= 0) {
                LAS unsigned char* Lb = L + buf * BUF; LAS unsigned char* Ln = L + (buf ^ 1) * BUF;
                const int jn = next_bit(um, j + 1);
                if (jn >= 0) { dma_k<VAR>(Ln, dm, Kb + 2 * TS + (size_t)(64 * jn) * 512, 512, wave); dma_v<VAR>(Ln, dm, Kb + 3 * TS + (size_t)(64 * jn) * 512, 512, wave); }
                else { const int jl = (x >= 8 ? x - 8 : 0); dma_k<VAR>(Ln, dm, Kb + 4 * TS + (size_t)(64 * jl) * 512, 512, wave); dma_v<VAR>(Ln, dm, Kb + 5 * TS + (size_t)(64 * jl) * 512, 512, wave); }
                if ((wm >> j) & 1ull) {
                    qkt<VAR>(p0, p1, Lb + L_K, r32, hi, qr, j + 2 >= x, bl + (t - 64 * j - 4 * hi + 1));
                    bias_mask(p0, p1, t - 64 * j, 0x7fffffffu, j == x, hi);
                    sm_pv<VAR>(p0, p1, m_reg, l_reg, o, vb0 + buf * BUF, wsf, r32, hi, (mym >> j) & 1ull); }
                TILE_SYNC(); buf ^= 1;
                j = jn;
            }
            BRANCH_END(1, false);
            BRANCH_INIT();
            for (int jw = (x >= 8 ? x - 8 : 0); jw <= x && !(VAR & 512); ++jw) {
                LAS unsigned char* Lb = L + buf * BUF; LAS unsigned char* Ln = L + (buf ^ 1) * BUF;
                if (jw < x) { dma_k<VAR>(Ln, dm, Kb + 4 * TS + (size_t)(64 * (jw + 1)) * 512, 512, wave); dma_v<VAR>(Ln, dm, Kb + 5 * TS + (size_t)(64 * (jw + 1)) * 512, 512, wave); }
                qkt<VAR>(p0, p1, Lb + L_K, r32, hi, qr, jw + 2 >= x, bl + (t - 64 * jw - 4 * hi + 1));
                bias_mask(p0, p1, t - 64 * jw, 512u, jw == x || jw + 8 == x, hi);
                sm_pv<VAR>(p0, p1, m_reg, l_reg, o, vb0 + buf * BUF, wsf, r32, hi);
                TILE_SYNC(); buf ^= 1;
            }
            BRANCH_END(2, false);
            { LAS unsigned char* Tt = L + (wave < 4 ? 0 : BUF) + (wave & 3) * 8192;
              int te_ = t0 + 8 * wave; asm volatile("" : "+s"(te_));
              u32x4 zz[8], tt8[8]; size_t eo[8]; int ln_e = lane; asm volatile("" : "+v"(ln_e));
#pragma unroll
              for (int i = 0; i < 8; ++i) { const int idx = ln_e + 64 * i, rw = idx >> 4, ch = idx & 15;
                  eo[i] = ((size_t)b * SEQ + te_ + (rw >> 2)) * DM + (g * 4 + (rw & 3)) * 128 + 8 * ch;
                  zz[i] = *(const u32x4*)(Z1 + eo[i]); }
              __builtin_amdgcn_sched_barrier(0);
#pragma unroll
              for (int r = 0; r < 8; ++r)
#pragma unroll
                  for (int d_ = 0; d_ < 4; ++d_) { const unsigned tp_ = totL[(d_ * 8 + r) * 64];
                      *(LAS bf16_t*)(Tt + crow(2 * r, hi) * 256 + (32 * d_ + r32) * 2) = (bf16_t)(tp_ & 0xffffu); *(LAS bf16_t*)(Tt + crow(2 * r + 1, hi) * 256 + (32 * d_ + r32) * 2) = (bf16_t)(tp_ >> 16); }
              asm volatile("s_waitcnt lgkmcnt(0)" ::: "memory");
#pragma unroll
              for (int i = 0; i < 8; ++i) { const int idx = ln_e + 64 * i, rw = idx >> 4, ch = idx & 15; tt8[i] = *(const LAS u32x4*)(Tt + rw * 256 + ch * 16); }
              __builtin_amdgcn_sched_barrier(0);
#pragma unroll
              for (int i = 0; i < 8; ++i) { u32x4 w;
#define MULPK(T_, Z_) cvtpk(__uint_as_float((T_) << 16) * __uint_as_float((Z_) << 16), __uint_as_float((T_) & 0xffff0000u) * __uint_as_float((Z_) & 0xffff0000u))
                  w.x = MULPK(tt8[i].x, zz[i].x); w.y = MULPK(tt8[i].y, zz[i].y); w.z = MULPK(tt8[i].z, zz[i].z); w.w = MULPK(tt8[i].w, zz[i].w);
#undef MULPK
                  *(u32x4*)(O1 + eo[i]) = w; }
              asm volatile("s_waitcnt lgkmcnt(0)" ::: "memory"); }
#undef BRANCH_INIT
#undef BRANCH_END
        }
    }
    __builtin_amdgcn_s_setprio(0);
}

#define XB_TMO      128
#define XB_XCNT(j)  (256  + 64 * (j))
#define XB_XSUB(j)  (1280 + 64 * (j))
#define XB_XGEN(j)  (2304 + 64 * (j))
#define XB_TOP      3328
#define XB_TOPGEN   3392
#define XCD_BAR_WORDS 3456
#define XB_SPIN_CAP (1u << 22)
__device__ __forceinline__ unsigned xb_ld(unsigned* p)              { return __hip_atomic_load(p, __ATOMIC_RELAXED, __HIP_MEMORY_SCOPE_AGENT); }
__device__ __forceinline__ unsigned xb_add(unsigned* p, unsigned v) { return __hip_atomic_fetch_add(p, v, __ATOMIC_RELAXED, __HIP_MEMORY_SCOPE_AGENT); }
__device__ __forceinline__ unsigned xb_xcc_id() { return (unsigned)__builtin_amdgcn_s_getreg((3 << 11) | 20) & 0xFu; }
#define XB_SPIN(cond, bar) do { unsigned _sp = 0; while (cond) { __builtin_amdgcn_s_sleep(1); \
    if ((++_sp & 255u) == 0u) { if (xb_ld(&(bar)[XB_TMO])) break; if (_sp > XB_SPIN_CAP) { atomicAdd(&(bar)[XB_TMO], 1u); break; } } } } while (0)
struct XcdBarrier { unsigned* bar; unsigned x; volatile LAS unsigned* st; };
__device__ __forceinline__ XcdBarrier xcd_barrier_post(unsigned* bar, volatile LAS unsigned* st) {
    XcdBarrier b; b.bar = bar; b.x = xb_xcc_id(); b.st = st;
    if (threadIdx.x == 0) (void)xb_add(&bar[XB_XCNT(b.x)], 1u);
    return b;
}
__device__ __forceinline__ void xcd_barrier_complete(unsigned* bar, unsigned x, unsigned& nloc, unsigned& nx) {
    const unsigned G = gridDim.x * gridDim.y * gridDim.z;
    unsigned sum, cnt, mine, sp = 0u;
    for (;;) {
        sum = 0u; cnt = 0u; mine = 0u;
#pragma unroll
        for (unsigned j = 0; j < 16; ++j) { const unsigned c = xb_ld(&bar[XB_XCNT(j)]); sum += c; cnt += (c > 0u) ? 1u : 0u; mine = (j == x) ? c : mine; }
        if (sum == G) break;
        __builtin_amdgcn_s_sleep(1);
        if ((++sp & 255u) == 0u) { if (xb_ld(&bar[XB_TMO])) break; if (sp > XB_SPIN_CAP) { atomicAdd(&bar[XB_TMO], 1u); break; } }
    }
    nloc = mine > 0u ? mine : 1u; nx = cnt > 0u ? cnt : 1u;
}
__device__ __forceinline__ void xcd_barrier(const XcdBarrier& b, const int tidv) {
    asm volatile("s_waitcnt vmcnt(0)" ::: "memory");
    __syncthreads();
    if (tidv == 0) {
        unsigned* bar = b.bar;
        __builtin_amdgcn_s_waitcnt(0);
        unsigned nloc = b.st[0], nx = b.st[1];
        if (nloc == 0u) { xcd_barrier_complete(bar, b.x, nloc, nx); b.st[0] = nloc; b.st[1] = nx; }
        const unsigned old = xb_add(&bar[XB_XSUB(b.x)], 1u);
        const unsigned gen = old / nloc;
        if (old + 1u == (gen + 1u) * nloc) {
            __builtin_amdgcn_fence(__ATOMIC_RELEASE, "agent");
            asm volatile("s_waitcnt vmcnt(0)" ::: "memory");
            const unsigned og = xb_add(&bar[XB_TOP], 1u);
            const unsigned tg = og / nx;
            if (og + 1u == (tg + 1u) * nx) xb_add(&bar[XB_TOPGEN], 1u);
            else XB_SPIN(xb_ld(&bar[XB_TOPGEN]) == tg, bar);
            __builtin_amdgcn_fence(__ATOMIC_ACQUIRE, "agent");
            xb_add(&bar[XB_XGEN(b.x)], 1u);
            asm volatile("s_waitcnt vmcnt(0)" ::: "memory");
        } else {
            XB_SPIN(xb_ld(&bar[XB_XGEN(b.x)]) == gen, bar);
            __builtin_amdgcn_fence(__ATOMIC_ACQUIRE, "agent");
            asm volatile("s_waitcnt vmcnt(0)" ::: "memory");
        }
    }
    __syncthreads();
}

constexpr int NPHASE = 11;
__global__ void __launch_bounds__(512, 2) mk_fwd(Params p) {
    extern __shared__ __attribute__((aligned(16))) unsigned char lds[];
    cg::grid_group grid = cg::this_grid();
    const int lo = p.ph_lo, hi = p.ph_hi;
    PG8_LAS unsigned char* ldsl = (PG8_LAS unsigned char*)lds;
    unsigned char* ws = p.ws;
    bf16_t* A = (bf16_t*)(ws + WS_A);
    if (threadIdx.x < 4) ((LAS unsigned*)((LAS unsigned char*)lds + LDS_BYTES - 16))[threadIdx.x] = 0u;
    __syncthreads();
    XcdBarrier xbar = xcd_barrier_post((unsigned*)(p.ws + WS_BAR), (volatile LAS unsigned*)((LAS unsigned char*)lds + LDS_BYTES - 16));
#define IN(k) (lo <= (k) && (k) < hi)
#define SEAM(k) do { if (IN(k) && IN((k) + 1)) xcd_barrier(xbar, tidv); } while (0)
    if (p.ws == nullptr) grid.sync();
#define RUN(k, BODY) do { if (IN(k)) { BODY; } if (PROBE_REP == (k)) { xcd_barrier(xbar, tidv); BODY; } SEAM(k); } while (0)
#define GEMM_PHASE(EPI, BT, N_, ...) do { pg8::Gemm g{A, (const bf16_t*)(ws + (BT)), T, (N_), DM}; pg8::StaticOrder S; S.init(T, (N_), gridDim.x, blockIdx.x); \
        pg8::EPI E{__VA_ARGS__}; pg8::gemm_phase<pg8::EPI, pg8::StaticOrder, true, true>(ldsl, g, S, E, tidv); } while (0)
    const int wv_s = __builtin_amdgcn_readfirstlane(threadIdx.x >> 6);
    int tidv = threadIdx.x;
    RUN(0, (p0_prep(p, lds), rows_rms16(p.x, p.norm_gains, A, tidv)));
#if !MK_SKEL
    RUN(1, GEMM_PHASE(EpiHgrnIn, WS_W0IN, N0IN, ws, p.out, (const float*)(ws + WS_MISC + MISC_LB)));
#if HGRN_NAIVE
    RUN(2, hgrn_naive(p, lds));
#else
    RUN(2, hgrn_chunk4(p, lds));
#if PROBE_REP == 21
    xcd_barrier(xbar, tidv); hgrn_chunk3<1>(p, lds);
#elif PROBE_REP == 22
    xcd_barrier(xbar, tidv); hgrn_chunk3<2>(p, lds);
#endif
#endif
    if (gridDim.x != 256) { RUN(3, hgrn_headnorm(p)); }
    RUN(4, ({ pg8::Gemm g{A, (const bf16_t*)(ws + WS_W0OUT), T, DM, DM}; pg8::StaticOrder S; S.init(T, DM, gridDim.x, blockIdx.x);
        pg8::EpiResidInit<true, true> E{p.x, (bf16_t*)(ws + WS_B), (float*)(ws + WS_SSQ)}; pg8::gemm_phase<pg8::EpiResidInit<true, true>, pg8::StaticOrder, true, true>(ldsl, g, S, E, tidv); }));
    RUN(6, ({ pg8::Gemm g{(const bf16_t*)(ws + WS_B), (const bf16_t*)(ws + WS_W1IN), T, N1PAD, DM}; pg8::SplitTailOrder S; S.init(T, N1PAD - 256, gridDim.x, blockIdx.x);
        pg8::EpiNsaIn E{ws, (float*)(ws + WS_GATES), ldsl, (const float*)(ws + WS_SSQ)}; pg8::gemm_phase<pg8::EpiNsaIn, pg8::SplitTailOrder, true, true>(ldsl, g, S, E, tidv); }));
#if NSA_NAIVE
    RUN(7, compress_naive(p, lds));
    RUN(8, nsa_naive(p, lds, A));
#else
    RUN(7, compress_mfma(p, lds));
#if NSA_DIFF
    if (IN(8)) { bf16_t* OA = (bf16_t*)(ws + WS_W0IN); nsa_naive(p, lds, OA); grid.sync(); nsa_fused(p, lds, A, tidv); grid.sync();
        for (size_t e = (size_t)blockIdx.x * 512 + threadIdx.x; e < (size_t)T * DM; e += (size_t)gridDim.x * 512) { const float a = bf2f(A[e]), r = bf2f(OA[e]); A[e] = (bf16_t)f2bf(a + NSA_AMP * (a - r)); } } SEAM(8);
#else
    tidv = wv_s * 64 + (int)__builtin_amdgcn_mbcnt_hi(~0u, __builtin_amdgcn_mbcnt_lo(~0u, 0u));
    RUN(8, nsa_fused(p, lds, A, tidv));
#ifdef PROBE_VAR
    if (IN(9)) { tidv = wv_s * 64 + (int)__builtin_amdgcn_mbcnt_hi(~0u, __builtin_amdgcn_mbcnt_lo(~0u, 0u)); nsa_fused<PROBE_VAR>(p, lds, (bf16_t*)(ws + WS_W0IN), tidv);
        tidv = wv_s * 64 + (int)__builtin_amdgcn_mbcnt_hi(~0u, __builtin_amdgcn_mbcnt_lo(~0u, 0u)); xcd_barrier(xbar, tidv); }
#endif
#endif
#endif
    RUN(9, GEMM_PHASE(EpiResidInit<false>, WS_W1OUT, DM, (const bf16_t*)(ws + WS_B), (bf16_t*)(ws + WS_B)));
    RUN(10, rows_rms_b<false>((const bf16_t*)(ws + WS_B), p.final_gain, p.out, tidv));
#else
    for (int k = 1; k < 10; ++k) { SEAM(k); }
    if (IN(10)) { rows_rms_f32(p.x, p.final_gain, p.out, tidv); }
#endif
#undef IN
#undef SEAM
#undef RUN
#undef GEMM_PHASE
}

extern "C" void kernel_launch(void* const* d_in, const int* in_sizes, int n_in, void* d_out, int out_size, void* d_ws, size_t ws_size, hipStream_t stream) {
    static int grid = 0;
    if (grid == 0) {
        if (n_in != 18 || in_sizes[0] != T * DM || out_size != T * DM || ws_size < WS_END) {
            fprintf(stderr, "kernel_launch: unexpected shapes (n_in %d, in0 %d, out %d, ws %zu)\n", n_in, n_in > 0 ? in_sizes[0] : -1, out_size, ws_size); grid = -1; return; }
        int dev = 0, cus = 0, per_cu = 0;
        if (hipGetDevice(&dev) != hipSuccess || hipDeviceGetAttribute(&cus, hipDeviceAttributeMultiprocessorCount, dev) != hipSuccess) { grid = -1; return; }
        if (hipFuncSetAttribute((const void*)mk_fwd, hipFuncAttributeMaxDynamicSharedMemorySize, LDS_BYTES) != hipSuccess) { fprintf(stderr, "kernel_launch: hipFuncSetAttribute failed\n"); grid = -1; return; }
        if (hipOccupancyMaxActiveBlocksPerMultiprocessor(&per_cu, (const void*)mk_fwd, 512, LDS_BYTES) != hipSuccess || per_cu < 1) { fprintf(stderr, "kernel_launch: occupancy query says %d\n", per_cu); per_cu = 1; }
        (void)hipGetLastError();
        grid = cus;
    }
    if (grid < 0) return;
    Params p{};
    p.x = (const float*)d_in[0]; p.norm_gains = (const float*)d_in[1]; p.final_gain = (const float*)d_in[2]; p.rel_bias = (const float*)d_in[3]; p.hgrn_lb = (const float*)d_in[4];
    p.hgrn_w_in = (const float*)d_in[5]; p.hgrn_head_gain = (const float*)d_in[6]; p.hgrn_w_out = (const float*)d_in[7]; p.nsa_w_in = (const float*)d_in[8];
    p.pe_k = (const float*)d_in[9]; p.pe_v = (const float*)d_in[10]; p.pk_w1 = (const float*)d_in[11]; p.pk_b1 = (const float*)d_in[12]; p.pk_w2 = (const float*)d_in[13];
    p.pv_w1 = (const float*)d_in[14]; p.pv_b1 = (const float*)d_in[15]; p.pv_w2 = (const float*)d_in[16]; p.nsa_w_out = (const float*)d_in[17];
    p.out = (float*)d_out; p.ws = (unsigned char*)d_ws;
#if MK_MULTI
    for (int k = 0; k < NPHASE; ++k) { p.ph_lo = k; p.ph_hi = k + 1; hipLaunchKernelGGL(mk_fwd, dim3(grid), dim3(512), LDS_BYTES, stream, p); }
#else
    p.ph_lo = 0; p.ph_hi = NPHASE;
    if (hipMemsetAsync((unsigned char*)d_ws + WS_BAR, 0, BAR_BYTES, stream) != hipSuccess) { fprintf(stderr, "kernel_launch: memset of the barrier words failed\n"); return; }
    void* args[] = {&p};
    hipError_t e = hipLaunchCooperativeKernel((const void*)mk_fwd, dim3(grid), dim3(512), args, LDS_BYTES, stream);
    if (e != hipSuccess) fprintf(stderr, "kernel_launch: cooperative launch failed: %s (grid %d)\n", hipGetErrorString(e), grid);
#endif
}
```

```cpp
#include <hip/hip_runtime.h>
#include <hip/hip_cooperative_groups.h>
#include <cstdio>
#include <cstdint>
namespace cg = cooperative_groups;

#ifndef MK_SKEL
#define MK_SKEL 0
#endif
#ifndef HGRN_NAIVE
#define HGRN_NAIVE 0
#endif
#ifndef NSA_NAIVE
#define NSA_NAIVE 0
#endif
#ifndef NSA_DIFF
#define NSA_DIFF 0
#endif
#define NSA_AMP 64.f
#ifndef PROBE_REP
#define PROBE_REP -1
#endif
#ifndef MK_MULTI
constexpr bool LOGF_L2 = true;
#define MK_MULTI 0
#endif

#define LAS __attribute__((address_space(3)))
typedef unsigned short bf16_t;
typedef short bf16x8 __attribute__((ext_vector_type(8)));
typedef float f32x4 __attribute__((ext_vector_type(4)));
typedef float f32x2 __attribute__((ext_vector_type(2)));
typedef unsigned u32x4 __attribute__((ext_vector_type(4)));
typedef unsigned u32x2 __attribute__((ext_vector_type(2)));
typedef _Float16 f16x8 __attribute__((ext_vector_type(8)));
typedef _Float16 f16x4 __attribute__((ext_vector_type(4)));

constexpr int NB = 4, SEQ = 4096, T = NB * SEQ, DM = 2048;
constexpr int NH = 16, HD = 128, NG = 4;
constexpr int N0IN = 8192;
constexpr int N1IN = 7216, N1PAD = 7424;
constexpr int NCMP = 255, NCMPP = 256;
constexpr float RMS_EPS = 1e-6f;
constexpr float QSCALE = 0.08838834764831845f;

constexpr size_t MiB = 1u << 20;
constexpr size_t WS_A = 0;
constexpr size_t WS_B = 64 * MiB;
constexpr size_t WS_D = 192 * MiB;
constexpr size_t WS_E = 256 * MiB;
constexpr size_t WS_G = 352 * MiB;
constexpr size_t WS_SSQ = 160 * MiB;
constexpr size_t WS_W0IN = 416 * MiB;
constexpr size_t WS_W0OUT = 448 * MiB;
constexpr size_t WS_W1IN = 456 * MiB;
constexpr size_t WS_W1OUT = 486 * MiB;
constexpr size_t WS_GATES = 128 * MiB;
constexpr size_t WS_KCMP = 497 * MiB;
constexpr size_t WS_VCMP = 498 * MiB;
constexpr size_t WS_MISC = 499 * MiB;
constexpr size_t WS_W1K = 500 * MiB;
constexpr size_t WS_W1V = 501 * MiB;
constexpr size_t WS_W2K = 502 * MiB;
constexpr size_t WS_W2V = 502 * MiB + 65536;
constexpr size_t WS_BAR = 503 * MiB;
constexpr size_t BAR_BYTES = 16384;
constexpr size_t WS_END = 504 * MiB;
constexpr size_t MISC_LB = 0, MISC_BIASP = 8192, MISC_CVP = 16384;

constexpr int LDS_BYTES = 160 * 1024;

struct Params {
    const float* x; const float* norm_gains; const float* final_gain; const float* rel_bias; const float* hgrn_lb;
    const float* hgrn_w_in; const float* hgrn_head_gain; const float* hgrn_w_out; const float* nsa_w_in;
    const float* pe_k; const float* pe_v; const float* pk_w1; const float* pk_b1; const float* pk_w2;
    const float* pv_w1; const float* pv_b1; const float* pv_w2; const float* nsa_w_out;
    float* out; unsigned char* ws;
    int ph_lo, ph_hi;
};

__device__ __forceinline__ float bf2f(bf16_t b) { return __uint_as_float(((unsigned)b) << 16); }
__device__ __forceinline__ unsigned f2bf(float f) { unsigned u = __float_as_uint(f); return (u + 0x7fffu + ((u >> 16) & 1u)) >> 16; }
__device__ __forceinline__ unsigned pk2(float lo, float hi) { return f2bf(lo) | (f2bf(hi) << 16); }
__device__ __forceinline__ float wave_sum(float v) {
#pragma unroll
    for (int o = 1; o < 64; o <<= 1) v += __shfl_xor(v, o);
    return v;
}
__device__ __forceinline__ float wave_max(float v) {
#pragma unroll
    for (int o = 1; o < 64; o <<= 1) v = fmaxf(v, __shfl_xor(v, o));
    return v;
}
__device__ __forceinline__ float sigmoidf_(float x) { return __builtin_amdgcn_rcpf(1.f + __expf(-x)); }
__device__ __forceinline__ float gate_of(const float* g) { return sigmoidf_((g[0] + g[(size_t)T * 48]) + (g[(size_t)2 * T * 48] + g[(size_t)3 * T * 48])); }
#define LDS_WAIT() asm volatile("s_waitcnt lgkmcnt(0)" ::: "memory")
#define LDS_BARRIER() do { asm volatile("s_waitcnt lgkmcnt(0)" ::: "memory"); __builtin_amdgcn_s_barrier(); asm volatile("" ::: "memory"); } while (0)

__device__ __forceinline__ float lane_x16(float v, int sel) { auto r = __builtin_amdgcn_permlane16_swap(__float_as_uint(v), __float_as_uint(v), false, false); return __uint_as_float((sel & 1) ? r[0] : r[1]); }
__device__ __forceinline__ float lane_x32(float v, int sel) { auto r = __builtin_amdgcn_permlane32_swap(__float_as_uint(v), __float_as_uint(v), false, false); return __uint_as_float((sel & 2) ? r[0] : r[1]); }
namespace pg8 {
#define PG8_LAS __attribute__((address_space(3)))
constexpr int BM = 256, BK = 64, HALF = 128, HTB = HALF * BK * 2, STAGE_BYTES = 8 * HTB, NXCD = 8, WGM = 8;
__host__ __device__ __forceinline__ int lds_byte(int r, int c) { const int st = (r >> 4) * 2 + (c >> 5), rr = r & 15, cc = c & 31, ob = rr * 64 + cc * 2; return st * 1024 + (ob ^ (((ob >> 9) & 1) << 5)); }
__host__ __device__ __forceinline__ void stage_rc(int b, int& R, int& C) { const int st = b / 1024, sb = b % 1024, swz = sb ^ (((sb >> 9) & 1) << 5); R = (st >> 1) * 16 + swz / 64; C = (st & 1) * 32 + (swz % 64) / 2; }
__host__ __device__ __forceinline__ int perm32(int rho) { const int n = rho >> 4, i = rho & 15; return 8 * (i >> 2) + 4 * n + (i & 3); }
struct Unit { int pm, pn, ks; };
struct Gemm { const bf16_t* A; const bf16_t* Bt; int M, N, K; };
struct StaticOrder {
    int nM, nN, nwg, G, c;
    __host__ __device__ void init(int M, int N, int G_, int c_) { nM = M / BM; nN = N / BM; nwg = nM * nN; G = G_; c = c_; }
    __host__ __device__ bool next(int i, Unit& u) const {
        const long L = (long)i * G + c; if (L >= nwg) return false;
        int wgid = (int)L; { const int q = nwg / NXCD, r = nwg % NXCD, xcd = wgid % NXCD, off = wgid / NXCD; wgid = (xcd < r ? xcd * (q + 1) : r * (q + 1) + (xcd - r) * q) + off; }
        const int nig = WGM * nN, gid = wgid / nig, fm = gid * WGM, gsz = (nM - fm) < WGM ? (nM - fm) : WGM;
        u.pm = fm + ((wgid % nig) % gsz); u.pn = (wgid % nig) / gsz; u.ks = 0; return true;
    }
    __device__ __forceinline__ int nt(const Unit&, int ntf) const { return ntf; }
    __device__ __forceinline__ size_t kbytes(const Unit&, int) const { return 0; }
    __device__ __forceinline__ void a_ready(const Unit&) const {}
    __device__ __forceinline__ void done(const Unit&) const {}
};
struct SplitTailOrder {
    StaticOrder so;
    __host__ __device__ void init(int M, int Nfull, int G_, int c_) { so.init(M, Nfull, G_, c_); }
    __host__ __device__ bool next(int i, Unit& u) const {
        const long L = (long)i * so.G + so.c;
        if (L < so.nwg) return so.next(i, u);
        const int idx = (int)(L - so.nwg); if (idx >= so.nM * 4) return false;
        u.pm = idx >> 2; u.pn = so.nN; u.ks = idx & 3; return true;
    }
    __device__ __forceinline__ int nt(const Unit& u, int ntf) const { return u.pn == so.nN ? (ntf >> 2) : ntf; }
    __device__ __forceinline__ size_t kbytes(const Unit& u, int K) const { return u.pn == so.nN ? (size_t)u.ks * (size_t)(K >> 2) * 2 : 0; }
    __device__ __forceinline__ void a_ready(const Unit&) const {}
    __device__ __forceinline__ void done(const Unit&) const {}
};
__device__ __forceinline__ unsigned cvt_pk_bf16(float lo, float hi) { unsigned r; asm volatile("v_cvt_pk_bf16_f32 %0, %1, %2" : "=v"(r) : "v"(lo), "v"(hi)); return r; }


struct EpiHgrnIn {
    static constexpr bool PERM = true, AFTER_DRAIN = false, INIT = false, ROWSCALE = false;
    unsigned char* ws; float* LOGF; const float* lb;
    __device__ __forceinline__ void operator()(const f32x4 (&acc)[2][2][4][2], const Unit& u, int wr, int wc, int fr, int fq) const {
        const int row0 = u.pm * BM + wr * 64 + fr, sect = u.pn >> 3, col0 = (u.pn & 7) * BM + wc * 32 + 8 * fq;
        if (sect == 1) {
            f32x4 lbv[2][2];
#pragma unroll
            for (int bj = 0; bj < 2; ++bj)
#pragma unroll
                for (int n = 0; n < 2; ++n) lbv[bj][n] = *(const f32x4*)(lb + col0 + bj * HALF + 4 * n);
#pragma unroll
            for (int ai = 0; ai < 2; ++ai)
#pragma unroll
                for (int m = 0; m < 4; ++m) { _Float16* rowp = (_Float16*)LOGF + (size_t)(row0 + ai * HALF + m * 16) * DM + col0;
#pragma unroll
                    for (int bj = 0; bj < 2; ++bj) { f16x8 o;
#pragma unroll
                        for (int n = 0; n < 2; ++n) { const f32x4 x = acc[ai][bj][m][n], l = lbv[bj][n];
#pragma unroll
                            for (int e = 0; e < 4; ++e) { const float sg = sigmoidf_(x[e]); o[4 * n + e] = (_Float16)(LOGF_L2 ? __log2f(l[e] + (1.f - l[e]) * sg) : __logf(l[e] + (1.f - l[e]) * sg)); } }
                        *(f16x8*)(rowp + bj * HALF) = o; } }
        } else {
            const size_t boff = sect == 0 ? WS_B : (sect == 2 ? WS_B + 64 * MiB : WS_D);
            bf16_t* base = (bf16_t*)(ws + boff);
#pragma unroll
            for (int ai = 0; ai < 2; ++ai)
#pragma unroll
                for (int m = 0; m < 4; ++m) { bf16_t* rowp = base + (size_t)(row0 + ai * HALF + m * 16) * DM + col0;
#pragma unroll
                    for (int bj = 0; bj < 2; ++bj) { f32x4 v0 = acc[ai][bj][m][0], v1 = acc[ai][bj][m][1];
                        if (sect == 0) { v0 = v0 * QSCALE; v1 = v1 * QSCALE; }
                        u32x4 w; w.x = cvt_pk_bf16(v0[0], v0[1]); w.y = cvt_pk_bf16(v0[2], v0[3]); w.z = cvt_pk_bf16(v1[0], v1[1]); w.w = cvt_pk_bf16(v1[2], v1[3]);
                        *(u32x4*)(rowp + bj * HALF) = w; } }
        }
    }
};
template <bool RF32>
struct EpiResidT {
    static constexpr bool PERM = true, AFTER_DRAIN = false, INIT = false, ROWSCALE = false;
    const void* R; bf16_t* O;
    __device__ __forceinline__ void operator()(const f32x4 (&acc)[2][2][4][2], const Unit& u, int wr, int wc, int fr, int fq) const {
        const int row0 = u.pm * BM + wr * 64 + fr, col0 = u.pn * BM + wc * 32 + 8 * fq;
#pragma unroll
        for (int ai = 0; ai < 2; ++ai) { f32x4 rv[4][2][RF32 ? 2 : 1];
#pragma unroll
            for (int m = 0; m < 4; ++m) { const size_t off = (size_t)(row0 + ai * HALF + m * 16) * DM + col0;
#pragma unroll
                for (int bj = 0; bj < 2; ++bj) {
                    if constexpr (RF32) { rv[m][bj][0] = *(const f32x4*)((const float*)R + off + bj * HALF); rv[m][bj][1] = *(const f32x4*)((const float*)R + off + bj * HALF + 4); }
                    else rv[m][bj][0] = *(const f32x4*)((const bf16_t*)R + off + bj * HALF); } }
            __builtin_amdgcn_sched_barrier(0);
#pragma unroll
            for (int m = 0; m < 4; ++m) { const size_t off = (size_t)(row0 + ai * HALF + m * 16) * DM + col0;
#pragma unroll
                for (int bj = 0; bj < 2; ++bj) { f32x4 r0, r1;
                    if constexpr (RF32) { r0 = rv[m][bj][0]; r1 = rv[m][bj][1]; }
                    else { const f32x4 q = rv[m][bj][0]; const unsigned a = __float_as_uint(q.x), b = __float_as_uint(q.y), c = __float_as_uint(q.z), d = __float_as_uint(q.w);
                        r0 = (f32x4){__uint_as_float(a << 16), __uint_as_float(a & 0xffff0000u), __uint_as_float(b << 16), __uint_as_float(b & 0xffff0000u)};
                        r1 = (f32x4){__uint_as_float(c << 16), __uint_as_float(c & 0xffff0000u), __uint_as_float(d << 16), __uint_as_float(d & 0xffff0000u)}; }
                    const f32x4 v0 = r0 + acc[ai][bj][m][0], v1 = r1 + acc[ai][bj][m][1];
                    u32x4 w; w.x = cvt_pk_bf16(v0[0], v0[1]); w.y = cvt_pk_bf16(v0[2], v0[3]); w.z = cvt_pk_bf16(v1[0], v1[1]); w.w = cvt_pk_bf16(v1[2], v1[3]);
                    *(u32x4*)(O + off + bj * HALF) = w; } }
            __builtin_amdgcn_sched_barrier(0); }
    }
};
template <bool RF32, bool SSQ = false>
struct EpiResidInit {
    static constexpr bool PERM = true, AFTER_DRAIN = false, INIT = true, ROWSCALE = false;
    const void* R; bf16_t* O; float* SS = nullptr;
    __device__ __forceinline__ bool first(const Unit& u) const { return (((u.pn >> 2) ^ ((int)blockIdx.x >> 3)) & 1) == 0; }
    __device__ __forceinline__ void init(f32x4 (&acc)[2][2][4][2], const Unit& u, int wr, int wc, int fr, int fq) const {
        const int row0 = u.pm * BM + wr * 64 + fr, col0 = u.pn * BM + wc * 32 + 8 * fq;
        if (!first(u)) {
#pragma unroll
            for (int ai = 0; ai < 2; ++ai)
#pragma unroll
                for (int bj = 0; bj < 2; ++bj)
#pragma unroll
                    for (int m = 0; m < 4; ++m) { acc[ai][bj][m][0] = (f32x4){0.f, 0.f, 0.f, 0.f}; acc[ai][bj][m][1] = (f32x4){0.f, 0.f, 0.f, 0.f}; }
            return; }
#pragma unroll
        for (int ai = 0; ai < 2; ++ai)
#pragma unroll
            for (int m = 0; m < 4; ++m) { const size_t off = (size_t)(row0 + ai * HALF + m * 16) * DM + col0;
#pragma unroll
                for (int bj = 0; bj < 2; ++bj) {
                    if constexpr (RF32) { acc[ai][bj][m][0] = *(const f32x4*)((const float*)R + off + bj * HALF); acc[ai][bj][m][1] = *(const f32x4*)((const float*)R + off + bj * HALF + 4); }
                    else { const f32x4 q = *(const f32x4*)((const bf16_t*)R + off + bj * HALF); const unsigned a = __float_as_uint(q.x), b = __float_as_uint(q.y), c = __float_as_uint(q.z), d = __float_as_uint(q.w);
                        acc[ai][bj][m][0] = (f32x4){__uint_as_float(a << 16), __uint_as_float(a & 0xffff0000u), __uint_as_float(b << 16), __uint_as_float(b & 0xffff0000u)};
                        acc[ai][bj][m][1] = (f32x4){__uint_as_float(c << 16), __uint_as_float(c & 0xffff0000u), __uint_as_float(d << 16), __uint_as_float(d & 0xffff0000u)}; } } }
    }
    __device__ __forceinline__ void operator()(const f32x4 (&acc)[2][2][4][2], const Unit& u, int wr, int wc, int fr, int fq) const {
        const int row0 = u.pm * BM + wr * 64 + fr, col0 = u.pn * BM + wc * 32 + 8 * fq;
        const bool fst = first(u);
#pragma unroll
        for (int ai = 0; ai < 2; ++ai) {
            f32x4 rv[4][2][2];
            if (!fst) {
#pragma unroll
                for (int m = 0; m < 4; ++m) { const size_t off = (size_t)(row0 + ai * HALF + m * 16) * DM + col0;
#pragma unroll
                    for (int bj = 0; bj < 2; ++bj) {
                        if constexpr (RF32) { rv[m][bj][0] = *(const f32x4*)((const float*)R + off + bj * HALF); rv[m][bj][1] = *(const f32x4*)((const float*)R + off + bj * HALF + 4); }
                        else { const f32x4 q = *(const f32x4*)((const bf16_t*)R + off + bj * HALF); const unsigned a = __float_as_uint(q.x), b = __float_as_uint(q.y), c = __float_as_uint(q.z), d = __float_as_uint(q.w);
                            rv[m][bj][0] = (f32x4){__uint_as_float(a << 16), __uint_as_float(a & 0xffff0000u), __uint_as_float(b << 16), __uint_as_float(b & 0xffff0000u)};
                            rv[m][bj][1] = (f32x4){__uint_as_float(c << 16), __uint_as_float(c & 0xffff0000u), __uint_as_float(d << 16), __uint_as_float(d & 0xffff0000u)}; } } }
            } else {
#pragma unroll
                for (int m = 0; m < 4; ++m)
#pragma unroll
                    for (int bj = 0; bj < 2; ++bj) { rv[m][bj][0] = (f32x4){0.f, 0.f, 0.f, 0.f}; rv[m][bj][1] = (f32x4){0.f, 0.f, 0.f, 0.f}; }
            }
#pragma unroll
            for (int m = 0; m < 4; ++m) { const size_t off = (size_t)(row0 + ai * HALF + m * 16) * DM + col0; float ss = 0.f;
#pragma unroll
                for (int bj = 0; bj < 2; ++bj) { const f32x4 v0 = acc[ai][bj][m][0] + rv[m][bj][0], v1 = acc[ai][bj][m][1] + rv[m][bj][1];
                    if constexpr (SSQ) ss += ((v0[0] * v0[0] + v0[1] * v0[1]) + (v0[2] * v0[2] + v0[3] * v0[3])) + ((v1[0] * v1[0] + v1[1] * v1[1]) + (v1[2] * v1[2] + v1[3] * v1[3]));
                    u32x4 w; w.x = cvt_pk_bf16(v0[0], v0[1]); w.y = cvt_pk_bf16(v0[2], v0[3]); w.z = cvt_pk_bf16(v1[0], v1[1]); w.w = cvt_pk_bf16(v1[2], v1[3]);
                    *(u32x4*)(O + off + bj * HALF) = w; }
                if constexpr (SSQ) { ss += lane_x16(ss, fq); ss += lane_x32(ss, fq);
                    if (fq == 0) SS[(size_t)(row0 + ai * HALF + m * 16) * 32 + u.pn * 4 + wc] = ss; } } }
    }
};
struct EpiNsaIn {
    static constexpr bool PERM = true, AFTER_DRAIN = false, INIT = false, ROWSCALE = true;
    unsigned char* ws; float* GT; PG8_LAS unsigned char* ldsb; const float* SS;
    static constexpr int RS_OFF = STAGE_BYTES;
    __device__ __forceinline__ void load_rowscale(int pm, int tid) const {
        asm volatile("s_waitcnt lgkmcnt(0)" ::: "memory"); __builtin_amdgcn_s_barrier();
        if (tid < BM) { const f32x4* pp = (const f32x4*)(SS + (size_t)(pm * BM + tid) * 32); f32x4 a = pp[0];
#pragma unroll
            for (int i = 1; i < 8; ++i) a += pp[i];
            ((PG8_LAS float*)(ldsb + RS_OFF))[tid] = rsqrtf(((a.x + a.y) + (a.z + a.w)) * (1.f / DM) + RMS_EPS); }
        asm volatile("s_waitcnt lgkmcnt(0)" ::: "memory"); __builtin_amdgcn_s_barrier();
    }
    __device__ __forceinline__ void operator()(const f32x4 (&acc)[2][2][4][2], const Unit& u, int wr, int wc, int fr, int fq) const {
        const int row0 = u.pm * BM + wr * 64 + fr, pn = u.pn, cl = wc * 32 + 8 * fq;
        if (pn == 28) {
#pragma unroll
            for (int ai = 0; ai < 2; ++ai)
#pragma unroll
                for (int m = 0; m < 4; ++m) { float* rowp = GT + ((size_t)u.ks * T + (size_t)(row0 + ai * HALF + m * 16)) * 48;
                    const float r_ = ((const PG8_LAS float*)(ldsb + RS_OFF))[wr * 64 + fr + ai * HALF + m * 16];
                    if (cl < 48) {
#pragma unroll
                        for (int n = 0; n < 2; ++n) *(f32x4*)(rowp + cl + 4 * n) = acc[ai][0][m][n] * r_; } }
            return;
        }
        size_t boff; int ld, colb; int mode = 0;
        if (pn < 8) { boff = WS_D; ld = DM; colb = pn * BM; mode = 1; }
        else if (pn < 20) { const int idx = pn - 8; boff = WS_E + (size_t)(idx >> 1) * ((size_t)T * 512 * 2); ld = 512; colb = (idx & 1) * BM; }
        else { boff = WS_G; ld = DM; colb = (pn - 20) * BM; mode = 2; }
        bf16_t* base = (bf16_t*)(ws + boff);
#pragma unroll
        for (int ai = 0; ai < 2; ++ai)
#pragma unroll
            for (int m = 0; m < 4; ++m) { bf16_t* rowp = base + (size_t)(row0 + ai * HALF + m * 16) * ld + colb + cl;
                const float r0_ = ((const PG8_LAS float*)(ldsb + RS_OFF))[wr * 64 + fr + ai * HALF + m * 16], r_ = mode == 1 ? r0_ * QSCALE : r0_;
#pragma unroll
                for (int bj = 0; bj < 2; ++bj) { f32x4 v0 = acc[ai][bj][m][0] * r_, v1 = acc[ai][bj][m][1] * r_;
                    if (mode == 2) {
#pragma unroll
                        for (int e = 0; e < 4; ++e) { v0[e] = v0[e] * sigmoidf_(v0[e]); v1[e] = v1[e] * sigmoidf_(v1[e]); } }
                    u32x4 w; w.x = cvt_pk_bf16(v0[0], v0[1]); w.y = cvt_pk_bf16(v0[2], v0[3]); w.z = cvt_pk_bf16(v1[0], v1[1]); w.w = cvt_pk_bf16(v1[2], v1[3]);
                    *(u32x4*)(rowp + bj * HALF) = w; } }
    }
};

template <class Epi, class Sched, bool ALIGN_EPI = false, bool SP2 = false>
__device__ __forceinline__ void gemm_phase(PG8_LAS unsigned char* lds, const Gemm g, const Sched& S, const Epi& E, const int tidv) {
    const int tid = tidv, wid = __builtin_amdgcn_readfirstlane(tid >> 6), lane = tid & 63, wr = wid >> 2, wc = wid & 3, fr = lane & 15, fq = lane >> 4;
    const int K = g.K, nt = K / BK;
    unsigned voffA[2], voffB[2];
#pragma unroll
    for (int i = 0; i < 2; ++i) { int R, C; stage_rc(tid * 16 + i * 8192, R, C); const int Rb = Epi::PERM ? ((R & ~31) + perm32(R & 31)) : R;
        voffA[i] = (unsigned)(R * K + C) * 2u; voffB[i] = (unsigned)(Rb * K + C) * 2u; }
    const size_t kstep = (size_t)(BK * 2);
    const size_t hstep = (size_t)HALF * K * 2;
    const size_t tstep = 2 * hstep;
    const unsigned ldsw = (unsigned)wid * 1024u;
    const int aoff = lds_byte(wr * 64 + fr, fq * 8), boff = lds_byte(wc * 32 + fr, fq * 8);
#define PG8_SA(b, h) (((b) * 2 + (h)) * HTB)
#define PG8_SB(b, h) ((4 + (b) * 2 + (h)) * HTB)
#define PG8_STAGE(bufoff, gbase, voff) do { _Pragma("unroll") for (int _i = 0; _i < 2; ++_i) \
        __builtin_amdgcn_global_load_lds((const unsigned*)((const char*)(gbase) + (voff)[_i]), (PG8_LAS unsigned*)(lds + (bufoff) + ldsw + _i * 8192), 16, 0, 0); } while (0)
#define PG8_LDA(dst, b, h) do { _Pragma("unroll") for (int m = 0; m < 4; ++m) _Pragma("unroll") for (int k = 0; k < 2; ++k) dst[m][k] = *(const PG8_LAS bf16x8*)(lds + PG8_SA(b, h) + aoff + m * 2048 + k * 1024); } while (0)
#define PG8_LDB(dst, b, h) do { _Pragma("unroll") for (int n = 0; n < 2; ++n) _Pragma("unroll") for (int k = 0; k < 2; ++k) dst[n][k] = *(const PG8_LAS bf16x8*)(lds + PG8_SB(b, h) + boff + n * 2048 + k * 1024); } while (0)
#define PG8_MMA(ai, bj, At, Bt) do { __builtin_amdgcn_s_setprio(1); _Pragma("unroll") for (int m = 0; m < 4; ++m) _Pragma("unroll") for (int n = 0; n < 2; ++n) _Pragma("unroll") for (int k = 0; k < 2; ++k) \
        acc[ai][bj][m][n] = __builtin_amdgcn_mfma_f32_16x16x32_bf16(Bt[n][k], At[m][k], acc[ai][bj][m][n], 0, 0, 0); __builtin_amdgcn_s_setprio(0); } while (0)
#define PG8_WAIT_V(n) asm volatile("s_waitcnt vmcnt(" #n ")" ::: "memory")
#define PG8_WAIT_L(n) asm volatile("s_waitcnt lgkmcnt(" #n ")" ::: "memory")
#define PG8_BAR __builtin_amdgcn_s_barrier()
#define PG8_SCHED __builtin_amdgcn_sched_barrier(0)
    Unit cur, nxt; int ui = 0;
    if (!S.next(0, cur)) return;
    f32x4 acc[2][2][4][2];
    if constexpr (Epi::ROWSCALE) E.load_rowscale(cur.pm, tid);
    if constexpr (Epi::INIT) E.init(acc, cur, wr, wc, fr, fq);
    else {
#pragma unroll
    for (int a = 0; a < 2; ++a)
#pragma unroll
        for (int b = 0; b < 2; ++b)
#pragma unroll
            for (int m = 0; m < 4; ++m)
#pragma unroll
                for (int n = 0; n < 2; ++n) acc[a][b][m][n] = (f32x4){0.f, 0.f, 0.f, 0.f};
    }
    bf16x8 At[4][2], B0[2][2], B1[2][2];
    const char* cA = (const char*)g.A + (size_t)cur.pm * tstep + S.kbytes(cur, K); const char* cB = (const char*)g.Bt + (size_t)cur.pn * tstep + S.kbytes(cur, K);
    S.a_ready(cur);
    if constexpr (SP2) {
        PG8_STAGE(PG8_SB(0, 0), cB, voffB); PG8_STAGE(PG8_SB(0, 1), cB + hstep, voffB); PG8_STAGE(PG8_SA(0, 0), cA, voffA); PG8_STAGE(PG8_SA(0, 1), cA + hstep, voffA);
        if (wr == 1) PG8_BAR;
        PG8_WAIT_V(2); PG8_BAR;
        PG8_STAGE(PG8_SB(1, 0), cB + kstep, voffB); PG8_STAGE(PG8_SA(1, 0), cA + kstep, voffA); PG8_STAGE(PG8_SB(1, 1), cB + hstep + kstep, voffB);
        PG8_WAIT_V(6); PG8_BAR;
    } else {
        PG8_STAGE(PG8_SB(0, 0), cB, voffB); PG8_STAGE(PG8_SA(0, 0), cA, voffA); PG8_STAGE(PG8_SB(0, 1), cB + hstep, voffB); PG8_STAGE(PG8_SA(0, 1), cA + hstep, voffA);
        if (wr == 1) PG8_BAR;
        PG8_WAIT_V(4); PG8_BAR;
        PG8_STAGE(PG8_SB(1, 0), cB + kstep, voffB); PG8_STAGE(PG8_SA(1, 0), cA + kstep, voffA); PG8_STAGE(PG8_SB(1, 1), cB + hstep + kstep, voffB);
        PG8_WAIT_V(6); PG8_BAR;
    }
    for (;;) {
        const bool has_next = S.next(ui + 1, nxt);
        const char* nA = has_next ? (const char*)g.A + (size_t)nxt.pm * tstep + S.kbytes(nxt, K) : cA; const char* nB = has_next ? (const char*)g.Bt + (size_t)nxt.pn * tstep + S.kbytes(nxt, K) : cB;
        const int ntc = S.nt(cur, nt);
        for (int t = 0; t < ntc; t += 2) {
            const bool last = (t == ntc - 2);
            const char* a1 = cA + (size_t)(t + 1) * kstep;
            const char* a2 = last ? nA : cA + (size_t)(t + 2) * kstep; const char* b2 = last ? nB : cB + (size_t)(t + 2) * kstep;
            const char* a3 = a2 + kstep; const char* b3 = b2 + kstep;
            if (last && has_next) S.a_ready(nxt);
            if constexpr (SP2) {
            PG8_LDB(B0, 0, 0); PG8_LDB(B1, 0, 1); PG8_SCHED; PG8_LDA(At, 0, 0); PG8_STAGE(PG8_SA(1, 1), a1 + hstep, voffA);
            PG8_WAIT_V(8); PG8_WAIT_L(0); PG8_BAR; PG8_MMA(0, 0, At, B0); PG8_MMA(0, 1, At, B1); PG8_BAR; PG8_SCHED;
            PG8_LDA(At, 0, 1); PG8_STAGE(PG8_SB(0, 0), b2, voffB); PG8_STAGE(PG8_SB(0, 1), b2 + hstep, voffB); PG8_STAGE(PG8_SA(0, 0), a2, voffA);
            PG8_WAIT_V(8); PG8_WAIT_L(0); PG8_BAR; PG8_MMA(1, 0, At, B0); PG8_MMA(1, 1, At, B1); PG8_BAR; PG8_SCHED;
            PG8_LDB(B0, 1, 0); PG8_LDB(B1, 1, 1); PG8_SCHED; PG8_LDA(At, 1, 0); PG8_STAGE(PG8_SA(0, 1), a2 + hstep, voffA);
            PG8_WAIT_V(8); PG8_WAIT_L(0); PG8_BAR; PG8_MMA(0, 0, At, B0); PG8_MMA(0, 1, At, B1); PG8_BAR; PG8_SCHED;
            PG8_LDA(At, 1, 1); PG8_STAGE(PG8_SB(1, 0), b3, voffB); PG8_STAGE(PG8_SB(1, 1), b3 + hstep, voffB); PG8_STAGE(PG8_SA(1, 0), a3, voffA);
            PG8_WAIT_V(8); PG8_WAIT_L(0); PG8_BAR; PG8_MMA(1, 0, At, B0); PG8_MMA(1, 1, At, B1); PG8_BAR; PG8_SCHED;
            } else {
            PG8_LDB(B0, 0, 0); PG8_SCHED; PG8_LDA(At, 0, 0); PG8_STAGE(PG8_SA(1, 1), a1 + hstep, voffA);
            PG8_WAIT_L(8); PG8_BAR; PG8_WAIT_L(0); PG8_MMA(0, 0, At, B0); PG8_BAR; PG8_SCHED;
            PG8_LDB(B1, 0, 1); PG8_STAGE(PG8_SB(0, 0), b2, voffB);
            PG8_BAR; PG8_WAIT_L(0); PG8_MMA(0, 1, At, B1); PG8_BAR;
            PG8_LDA(At, 0, 1); PG8_STAGE(PG8_SA(0, 0), a2, voffA);
            PG8_BAR; PG8_WAIT_L(0); PG8_MMA(1, 0, At, B0); PG8_BAR; PG8_SCHED;
            PG8_STAGE(PG8_SB(0, 1), b2 + hstep, voffB);
            PG8_WAIT_V(6); PG8_BAR; PG8_MMA(1, 1, At, B1); PG8_BAR;
            PG8_LDB(B0, 1, 0); PG8_SCHED; PG8_LDA(At, 1, 0); PG8_STAGE(PG8_SA(0, 1), a2 + hstep, voffA);
            PG8_WAIT_L(8); PG8_BAR; PG8_WAIT_L(0); PG8_MMA(0, 0, At, B0); PG8_BAR; PG8_SCHED;
            PG8_LDB(B1, 1, 1); PG8_STAGE(PG8_SB(1, 0), b3, voffB);
            PG8_BAR; PG8_WAIT_L(0); PG8_MMA(0, 1, At, B1); PG8_BAR;
            PG8_LDA(At, 1, 1); PG8_STAGE(PG8_SA(1, 0), a3, voffA);
            PG8_BAR; PG8_WAIT_L(0); PG8_MMA(1, 0, At, B0); PG8_BAR; PG8_SCHED;
            PG8_STAGE(PG8_SB(1, 1), b3 + hstep, voffB);
            PG8_WAIT_V(6); PG8_BAR; PG8_MMA(1, 1, At, B1); PG8_BAR;
            }
        }
        if constexpr (ALIGN_EPI) { if (wr == 0) PG8_BAR; }
        if constexpr (!Epi::AFTER_DRAIN) { E(acc, cur, wr, wc, fr, fq); S.done(cur); }
        if (!has_next) break;
        if constexpr (Epi::ROWSCALE) { if (nxt.pm != cur.pm) E.load_rowscale(nxt.pm, tid); }
        if constexpr (Epi::INIT) E.init(acc, nxt, wr, wc, fr, fq);
        else {
#pragma unroll
        for (int a = 0; a < 2; ++a)
#pragma unroll
            for (int b = 0; b < 2; ++b)
#pragma unroll
                for (int m = 0; m < 4; ++m)
#pragma unroll
                    for (int n = 0; n < 2; ++n) acc[a][b][m][n] = (f32x4){0.f, 0.f, 0.f, 0.f};
        }
        cur = nxt; cA = nA; cB = nB; ++ui;
        if constexpr (ALIGN_EPI) { if (wr == 1) PG8_BAR; }
    }
    PG8_WAIT_V(0);
    if constexpr (!ALIGN_EPI) { if (wr == 0) PG8_BAR; }
    PG8_BAR;
#undef PG8_SA
#undef PG8_SB
#undef PG8_STAGE
#undef PG8_LDA
#undef PG8_LDB
#undef PG8_MMA
#undef PG8_WAIT_V
#undef PG8_WAIT_L
#undef PG8_BAR
#undef PG8_SCHED
}
}

__device__ __forceinline__ int t5_bucket(int n) {
    if (n < 16) return n;
    const int large = 16 + (int)(logf((float)n / 16.f) / 2.0794415416798357f * 16.f);
    return large < 31 ? large : 31;
}
template <class ColMap, bool FRAG = false>
__device__ __forceinline__ void transpose_item(const float* W, int Nsrc, int K, bf16_t* WT, LAS float* scr, int kb, int nb, int lane, ColMap cm, const float* kgain = nullptr) {
    const int k0 = 64 * kb, n0 = 32 * nb;
    const int kq = lane >> 3, n4 = 4 * (lane & 7);
    const int nsrc = cm(n0 + n4);
    f32x4 wv[8];
#pragma unroll
    for (int i = 0; i < 8; ++i) wv[i] = nsrc >= 0 ? *(const f32x4*)(W + (size_t)(k0 + 8 * i + kq) * Nsrc + nsrc) : (f32x4){0.f, 0.f, 0.f, 0.f};
    if (kgain != nullptr) {
#pragma unroll
        for (int i = 0; i < 8; ++i) wv[i] = wv[i] * kgain[k0 + 8 * i + kq]; }
#pragma unroll
    for (int i = 0; i < 8; ++i) { LAS float* d = scr + (8 * i + kq) * 33 + n4; d[0] = wv[i].x; d[1] = wv[i].y; d[2] = wv[i].z; d[3] = wv[i].w; }
    LDS_WAIT(); asm volatile("" ::: "memory");
    const int c = lane & 7;
#pragma unroll
    for (int j = 0; j < 4; ++j) { const int n = (lane >> 3) + 8 * j; const LAS float* s = scr + (8 * c) * 33 + n;
        u32x4 o; o.x = pk2(s[0 * 33], s[1 * 33]); o.y = pk2(s[2 * 33], s[3 * 33]); o.z = pk2(s[4 * 33], s[5 * 33]); o.w = pk2(s[6 * 33], s[7 * 33]);
        if constexpr (FRAG) { const int nn = n0 + n, k8 = (k0 >> 3) + c; *(u32x4*)(WT + ((size_t)((nn >> 5) * (K / 16) + (k8 >> 1)) * 64 + (k8 & 1) * 32 + (nn & 31)) * 8) = o; }
        else *(u32x4*)(WT + (size_t)(n0 + n) * K + k0 + 8 * c) = o; }
    LDS_WAIT(); asm volatile("" ::: "memory");
}
struct CmIdent { __device__ __forceinline__ int operator()(int n) const { return n; } };
struct CmNsaIn { __device__ __forceinline__ int operator()(int n) const { return n < 5120 ? n : (n < 7168 ? n + 48 : (n < N1IN ? n - 2048 : -1)); } };

__device__ __forceinline__ void rms_row_bf16(const float* xrow, const float* gain, bf16_t* orow, int lane) {
    const f32x4* xr = (const f32x4*)xrow + lane; const f32x4* gr = (const f32x4*)gain + lane;
    f32x4 v[8]; float s = 0.f;
#pragma unroll
    for (int j = 0; j < 8; ++j) { v[j] = xr[64 * j]; s += (v[j].x * v[j].x + v[j].y * v[j].y) + (v[j].z * v[j].z + v[j].w * v[j].w); }
    const float r = rsqrtf(wave_sum(s) * (1.f / DM) + RMS_EPS);
    u32x2* o8 = (u32x2*)orow + lane;
#pragma unroll
    for (int j = 0; j < 8; ++j) { const f32x4 g = gr[64 * j]; u32x2 w; w.x = pk2(v[j].x * r * g.x, v[j].y * r * g.y); w.y = pk2(v[j].z * r * g.z, v[j].w * r * g.w); o8[64 * j] = w; }
}
__device__ __forceinline__ void rms_row_f32(const float* xrow, const float* gain, float* orow, int lane) {
    const f32x4* xr = (const f32x4*)xrow + lane; const f32x4* gr = (const f32x4*)gain + lane;
    f32x4 v[8]; float s = 0.f;
#pragma unroll
    for (int j = 0; j < 8; ++j) { v[j] = xr[64 * j]; s += (v[j].x * v[j].x + v[j].y * v[j].y) + (v[j].z * v[j].z + v[j].w * v[j].w); }
    const float r = rsqrtf(wave_sum(s) * (1.f / DM) + RMS_EPS);
    f32x4* o = (f32x4*)orow + lane;
#pragma unroll
    for (int j = 0; j < 8; ++j) { const f32x4 g = gr[64 * j]; o[64 * j] = v[j] * r * g; }
}

__device__ __forceinline__ void p0_prep(const Params& p, unsigned char* lds_g) {
    const int tid = threadIdx.x, lane = tid & 63, wave = tid >> 6, G = gridDim.x, bx = blockIdx.x;
    const int gw = bx * 8 + wave, NGW = G * 8;
    float* misc = (float*)(p.ws + WS_MISC);
    if (bx == 0) {
#pragma unroll
        for (int c = tid; c < DM; c += 512) { const float a = p.hgrn_lb[c], b = p.hgrn_lb[DM + c], d = p.hgrn_lb[2 * DM + c]; const float m = fmaxf(a, fmaxf(b, d));
            const float ea = expf(a - m), eb = expf(b - m), ed = expf(d - m); misc[MISC_LB / 4 + c] = ea / (ea + eb + ed); }
    }
    if (bx == 1 % G) {
#pragma unroll
        for (int e = tid; e < NH * 128; e += 512) { const int head = e >> 7, dist = e & 127; misc[MISC_BIASP / 4 + e] = p.rel_bias[t5_bucket(dist) * NH + head] - p.rel_bias[31 * NH + head]; }
    }
    if (bx >= 2 && bx < 18 && G >= 18) {
        const int which = (bx - 2) >> 3, slice = (bx - 2) & 7;
        const float* pe = which ? p.pe_v : p.pe_k; const float* w1 = which ? p.pv_w1 : p.pk_w1;
        float* red = (float*)lds_g;
        const int n4 = (tid & 31) * 4, rg = tid >> 5; f32x4 s = {0.f, 0.f, 0.f, 0.f};
        const int r0 = slice * 512 + rg;
#pragma unroll
        for (int h = 0; h < 2; ++h) { f32x4 wv[16]; float pv[16];
#pragma unroll
            for (int i = 0; i < 16; ++i) { const int r = r0 + 16 * (16 * h + i); wv[i] = *(const f32x4*)(w1 + (size_t)r * 128 + n4); pv[i] = pe[r]; }
#pragma unroll
            for (int i = 0; i < 16; ++i) s += wv[i] * pv[i]; }
        __syncthreads(); *(f32x4*)(red + rg * 128 + n4) = s; __syncthreads();
        if (tid < 128) { float t = 0.f;
#pragma unroll
            for (int g = 0; g < 16; ++g) t += red[g * 128 + tid];
            misc[MISC_CVP / 4 + (which * 8 + slice) * 128 + tid] = t; }
        __syncthreads();
    }
    LAS float* scr = (LAS float*)((LAS unsigned char*)lds_g + 4096 + wave * 8704);
    constexpr int I0IN = 32 * (N0IN / 32), IOUT = 32 * (DM / 32), I1IN = 32 * (N1PAD / 32);
    constexpr int IW1 = (4096 / 64) * (128 / 32), IW2 = (128 / 64) * (128 / 32);
    constexpr int NITEMS = I0IN + IOUT + I1IN + IOUT + 2 * IW1 + 2 * IW2;
    for (int it = gw; it < NITEMS; it += NGW) {
        int r = it;
        if (r < I0IN) { transpose_item(p.hgrn_w_in, N0IN, DM, (bf16_t*)(p.ws + WS_W0IN), scr, r / (N0IN / 32), r % (N0IN / 32), lane, CmIdent()); continue; } r -= I0IN;
        if (r < IOUT) { transpose_item(p.hgrn_w_out, DM, DM, (bf16_t*)(p.ws + WS_W0OUT), scr, r / (DM / 32), r % (DM / 32), lane, CmIdent()); continue; } r -= IOUT;
        if (r < I1IN) { transpose_item(p.nsa_w_in, N1IN, DM, (bf16_t*)(p.ws + WS_W1IN), scr, r / (N1PAD / 32), r % (N1PAD / 32), lane, CmNsaIn(), p.norm_gains + DM); continue; } r -= I1IN;
        if (r < IOUT) { transpose_item(p.nsa_w_out, DM, DM, (bf16_t*)(p.ws + WS_W1OUT), scr, r / (DM / 32), r % (DM / 32), lane, CmIdent()); continue; } r -= IOUT;
        if (r < IW1) { transpose_item<CmIdent, true>(p.pk_w1, 128, 4096, (bf16_t*)(p.ws + WS_W1K), scr, r / 4, r % 4, lane, CmIdent()); continue; } r -= IW1;
        if (r < IW1) { transpose_item<CmIdent, true>(p.pv_w1, 128, 4096, (bf16_t*)(p.ws + WS_W1V), scr, r / 4, r % 4, lane, CmIdent()); continue; } r -= IW1;
        if (r < IW2) { transpose_item(p.pk_w2, 128, 128, (bf16_t*)(p.ws + WS_W2K), scr, r / 4, r % 4, lane, CmIdent()); continue; } r -= IW2;
        transpose_item(p.pv_w2, 128, 128, (bf16_t*)(p.ws + WS_W2V), scr, r / 4, r % 4, lane, CmIdent());
    }
}

__device__ __forceinline__ void hgrn_naive(const Params& p, unsigned char* lds_g) {
    const int tid = threadIdx.x;
    const bf16_t* Q0 = (const bf16_t*)(p.ws + WS_B); const bf16_t* V0 = (const bf16_t*)(p.ws + WS_B + 64 * MiB);
    const float* LOGF = p.out; bf16_t* O0 = (bf16_t*)(p.ws + WS_E);
    float* qs = (float*)lds_g; float* fs = qs + 16 * 128; float* part = fs + 16 * 128;
    const int v = tid & 127, kq = tid >> 7;
    for (int unit = blockIdx.x; unit < NB * NH; unit += gridDim.x) {
        const int b = unit / NH, h = unit % NH;
        float S[32];
#pragma unroll
        for (int i = 0; i < 32; ++i) S[i] = 0.f;
        for (int t0 = 0; t0 < SEQ; t0 += 16) {
            __syncthreads();
            for (int e = tid; e < 2048; e += 512) { const int tt = e >> 7, k = e & 127; const size_t idx = (size_t)(b * SEQ + t0 + tt) * DM + h * HD + k;
                qs[e] = bf2f(Q0[idx]); fs[e] = __expf(LOGF[idx]); }
            __syncthreads();
            for (int tt = 0; tt < 16; ++tt) {
                const float vv = bf2f(V0[(size_t)(b * SEQ + t0 + tt) * DM + h * HD + v]);
                float o = 0.f;
#pragma unroll
                for (int kk = 0; kk < 32; ++kk) { const float f = fs[tt * 128 + kq * 32 + kk]; S[kk] = f * S[kk] + (1.f - f) * vv; o += S[kk] * qs[tt * 128 + kq * 32 + kk]; }
                part[(tt * 4 + kq) * 128 + v] = o;
            }
            __syncthreads();
            for (int e = tid; e < 2048; e += 512) { const int tt = e >> 7, vx = e & 127;
                const float o = (part[(tt * 4 + 0) * 128 + vx] + part[(tt * 4 + 1) * 128 + vx]) + (part[(tt * 4 + 2) * 128 + vx] + part[(tt * 4 + 3) * 128 + vx]);
                O0[(size_t)(b * SEQ + t0 + tt) * DM + h * HD + vx] = (bf16_t)f2bf(o); }
        }
    }
}
typedef float f32x16 __attribute__((ext_vector_type(16)));
__device__ __forceinline__ int crow(int r, int hi) { return (r & 3) + 8 * (r >> 2) + 4 * hi; }
namespace hg {
constexpr int RS = 272, RS2 = 144;
constexpr int QS = 0, QD = 17408, KS = 34816, KST = 52224, VT = 70656, PP = 75264, SOP0 = 84480, SOP1 = 93184, SEGT = 101888, VEC = 105984;
}
__device__ __forceinline__ u32x2 pack4bf(float a, float b, float c, float d) { u32x2 w; w.x = pg8::cvt_pk_bf16(a, b); w.y = pg8::cvt_pk_bf16(c, d); return w; }
__device__ __forceinline__ void hgrn_chunk(const Params& p, unsigned char* lds_g) {
    using namespace hg;
    LAS unsigned char* L = (LAS unsigned char*)lds_g;
    const int tid = threadIdx.x, lane = tid & 63, wave = __builtin_amdgcn_readfirstlane(tid >> 6), r32 = lane & 31, hi = lane >> 5;
    const bf16_t* Q0 = (const bf16_t*)(p.ws + WS_B); const bf16_t* V0 = (const bf16_t*)(p.ws + WS_B + 64 * MiB);
    const float* LOGF = p.out; bf16_t* O0 = (bf16_t*)(p.ws + WS_E);
    const int vs = tid >> 3, vv4 = (tid & 7) * 4;
    for (int unit = blockIdx.x; unit < 256; unit += gridDim.x) {
        const int bh = unit & 63, c4 = unit >> 6, b = bh >> 4, h = bh & 15;
        const size_t rowb = (size_t)b * SEQ; const int colb = h * HD;
        f32x16 S;
#pragma unroll
        for (int i = 0; i < 16; ++i) S[i] = 0.f;
        __syncthreads();
        for (int e = tid; e < (SOP1 - SOP0) / 4; e += 512) ((LAS unsigned*)(L + SOP0))[e] = 0u;
        int cur = 0;
        f32x2 lf[8]; unsigned qv[8]; u32x2 vraw;
#pragma unroll
        for (int i = 0; i < 8; ++i) { const size_t idx = (rowb + 8 * wave + i) * DM + colb + 2 * lane; lf[i] = *(const f32x2*)(LOGF + idx); qv[i] = *(const unsigned*)(Q0 + idx); }
        vraw = *(const u32x2*)(V0 + (rowb + vs) * DM + colb + c4 * 32 + vv4);
        for (int c = 0; c < 64; ++c) {
            float c0[8], c1[8]; float s0 = 0.f, s1 = 0.f;
#pragma unroll
            for (int i = 0; i < 8; ++i) { s0 += lf[i].x; c0[i] = s0; s1 += lf[i].y; c1[i] = s1; }
            *(LAS f32x2*)(L + SEGT + (wave * 128 + 2 * lane) * 4) = (f32x2){s0, s1};
            LDS_BARRIER();
            float pre0 = 0.f, pre1 = 0.f, br0 = 0.f, br1 = 0.f, bl0 = 0.f, bl1 = 0.f;
#pragma unroll
            for (int w = 0; w < 8; ++w) { const f32x2 v = *(const LAS f32x2*)(L + SEGT + (w * 128 + 2 * lane) * 4);
                if (w < wave) { pre0 += v.x; pre1 += v.y; } if (w < 4) { br0 += v.x; br1 += v.y; } bl0 += v.x; bl1 += v.y; }
            const float er0 = __expf(br0), er1 = __expf(br1);
            if (wave == 0) { *(LAS f32x2*)(L + VEC + (2 * lane) * 4) = (f32x2){__expf(bl0 - br0), __expf(bl1 - br1)}; *(LAS f32x2*)(L + VEC + 512 + (2 * lane) * 4) = (f32x2){__expf(bl0), __expf(bl1)}; }
            float kt0[8], kt1[8];
#pragma unroll
            for (int i = 0; i < 8; ++i) { const int t = 8 * wave + i;
                const float q0 = __uint_as_float(qv[i] << 16), q1 = __uint_as_float(qv[i] & 0xffff0000u);
                const float d0 = fminf(fmaxf(pre0 + c0[i] - br0, -80.f), 80.f), d1 = fminf(fmaxf(pre1 + c1[i] - br1, -80.f), 80.f);
                const float k0 = 1.f - __expf(lf[i].x), k1 = 1.f - __expf(lf[i].y);
                const float qs0 = q0 * __expf(d0), qs1 = q1 * __expf(d1), ks0 = k0 * __expf(-d0), ks1 = k1 * __expf(-d1);
                *(LAS unsigned*)(L + QS + t * RS + 4 * lane) = pg8::cvt_pk_bf16(qs0, qs1);
                *(LAS unsigned*)(L + QD + t * RS + 4 * lane) = pg8::cvt_pk_bf16(qs0 * er0, qs1 * er1);
                *(LAS unsigned*)(L + KS + t * RS + 4 * lane) = pg8::cvt_pk_bf16(ks0, ks1);
                kt0[i] = ks0; kt1[i] = ks1; }
            { u32x4 w0, w1;
              w0.x = pg8::cvt_pk_bf16(kt0[0], kt0[1]); w0.y = pg8::cvt_pk_bf16(kt0[2], kt0[3]); w0.z = pg8::cvt_pk_bf16(kt0[4], kt0[5]); w0.w = pg8::cvt_pk_bf16(kt0[6], kt0[7]);
              w1.x = pg8::cvt_pk_bf16(kt1[0], kt1[1]); w1.y = pg8::cvt_pk_bf16(kt1[2], kt1[3]); w1.z = pg8::cvt_pk_bf16(kt1[4], kt1[5]); w1.w = pg8::cvt_pk_bf16(kt1[6], kt1[7]);
              *(LAS u32x4*)(L + KST + (2 * lane) * RS2 + 16 * wave) = w0; *(LAS u32x4*)(L + KST + (2 * lane + 1) * RS2 + 16 * wave) = w1; }
            { LAS bf16_t* vt = (LAS bf16_t*)(L + VT);
              vt[(vv4 + 0) * (RS2 / 2) + vs] = (bf16_t)(vraw.x & 0xffff); vt[(vv4 + 1) * (RS2 / 2) + vs] = (bf16_t)(vraw.x >> 16);
              vt[(vv4 + 2) * (RS2 / 2) + vs] = (bf16_t)(vraw.y & 0xffff); vt[(vv4 + 3) * (RS2 / 2) + vs] = (bf16_t)(vraw.y >> 16); }
            if (c + 1 < 64) {
#pragma unroll
                for (int i = 0; i < 8; ++i) { const size_t idx = (rowb + 64 * (c + 1) + 8 * wave + i) * DM + colb + 2 * lane; lf[i] = *(const f32x2*)(LOGF + idx); qv[i] = *(const unsigned*)(Q0 + idx); }
                vraw = *(const u32x2*)(V0 + (rowb + 64 * (c + 1) + vs) * DM + colb + c4 * 32 + vv4);
            }
            LDS_BARRIER();
            const int sopc = cur ? SOP1 : SOP0, sopn = cur ? SOP0 : SOP1;
            if (wave < 3) {
                const int si = wave >> 1, ti = (wave + 1) >> 1;
                f32x16 acc;
#pragma unroll
                for (int i = 0; i < 16; ++i) acc[i] = 0.f;
#pragma unroll
                for (int ks = 0; ks < 8; ++ks) { const bf16x8 a = *(const LAS bf16x8*)(L + KS + (32 * si + r32) * RS + 32 * ks + 16 * hi);
                    const bf16x8 bq = *(const LAS bf16x8*)(L + QS + (32 * ti + r32) * RS + 32 * ks + 16 * hi);
                    acc = __builtin_amdgcn_mfma_f32_32x32x16_bf16(a, bq, acc, 0, 0, 0); }
                const int t = 32 * ti + r32;
#pragma unroll
                for (int q = 0; q < 16; ++q) { const int sidx = 32 * si + crow(q, hi); if (sidx > t) acc[q] = 0.f; }
#pragma unroll
                for (int g = 0; g < 4; ++g) *(LAS u32x2*)(L + PP + t * RS2 + (32 * si + 8 * g + 4 * hi) * 2) = pack4bf(acc[4 * g], acc[4 * g + 1], acc[4 * g + 2], acc[4 * g + 3]);
            } else if (wave >= 4) {
                const int kt = wave - 4;
                f32x16 U;
#pragma unroll
                for (int i = 0; i < 16; ++i) U[i] = 0.f;
#pragma unroll
                for (int ss = 0; ss < 4; ++ss) { const bf16x8 a = *(const LAS bf16x8*)(L + KST + (32 * kt + r32) * RS2 + 32 * ss + 16 * hi);
                    const bf16x8 bv = *(const LAS bf16x8*)(L + VT + r32 * RS2 + 32 * ss + 16 * hi);
                    U = __builtin_amdgcn_mfma_f32_32x32x16_bf16(a, bv, U, 0, 0, 0); }
#pragma unroll
                for (int g = 0; g < 4; ++g) { const int k0 = 32 * kt + 8 * g + 4 * hi;
                    const f32x4 el = *(const LAS f32x4*)(L + VEC + k0 * 4), dl = *(const LAS f32x4*)(L + VEC + 512 + k0 * 4);
#pragma unroll
                    for (int e = 0; e < 4; ++e) S[4 * g + e] = dl[e] * S[4 * g + e] + el[e] * U[4 * g + e];
                    *(LAS u32x2*)(L + sopn + r32 * RS + k0 * 2) = pack4bf(S[4 * g], S[4 * g + 1], S[4 * g + 2], S[4 * g + 3]); }
            }
            LDS_BARRIER();
            if (wave < 2) {
                const int ti = wave;
                f32x16 o;
#pragma unroll
                for (int i = 0; i < 16; ++i) o[i] = 0.f;
#pragma unroll
                for (int ks = 0; ks < 8; ++ks) { const bf16x8 a = *(const LAS bf16x8*)(L + QD + (32 * ti + r32) * RS + 32 * ks + 16 * hi);
                    const bf16x8 bs = *(const LAS bf16x8*)(L + sopc + r32 * RS + 32 * ks + 16 * hi);
                    o = __builtin_amdgcn_mfma_f32_32x32x16_bf16(a, bs, o, 0, 0, 0); }
#pragma unroll
                for (int ss = 0; ss < 4; ++ss) { if (ss < 2 || ti == 1) {
                    const bf16x8 a = *(const LAS bf16x8*)(L + PP + (32 * ti + r32) * RS2 + 32 * ss + 16 * hi);
                    const bf16x8 bv = *(const LAS bf16x8*)(L + VT + r32 * RS2 + 32 * ss + 16 * hi);
                    o = __builtin_amdgcn_mfma_f32_32x32x16_bf16(a, bv, o, 0, 0, 0); } }
                bf16_t* orow = O0 + (rowb + 64 * c + 32 * ti) * DM + colb + c4 * 32 + r32;
#pragma unroll
                for (int q = 0; q < 16; ++q) orow[(size_t)crow(q, hi) * DM] = (bf16_t)f2bf(o[q]);
            }
            cur ^= 1;
        }
    }
}
namespace hg2 {
constexpr int RS = 272, RS2 = 144;
constexpr int QS = 0, KS = 17408, KST = 34816, VT = 53248, VEC = 57856, SETSZ = 59392;
constexpr int PP = 2 * SETSZ, SOP0 = PP + 9216, SOP1 = SOP0 + 8704, SEGT = SOP1 + 8704;
}
__device__ __forceinline__ void hgrn_chunk2(const Params& p, unsigned char* lds_g) {
    using namespace hg2;
    LAS unsigned char* L = (LAS unsigned char*)lds_g;
    const int tid = threadIdx.x, lane = tid & 63, wave = __builtin_amdgcn_readfirstlane(tid >> 6), r32 = lane & 31, hi = lane >> 5;
    const bf16_t* Q0 = (const bf16_t*)(p.ws + WS_B); const bf16_t* V0 = (const bf16_t*)(p.ws + WS_B + 64 * MiB);
    const float* LOGF = p.out; bf16_t* O0 = (bf16_t*)(p.ws + WS_E);
    const bool isP = wave < 4;
    const int vs = (tid & 255) >> 2, v8 = (tid & 3) * 8;
    for (int unit = blockIdx.x; unit < 256; unit += gridDim.x) {
        const int bh = unit & 63, c4 = unit >> 6, b = bh >> 4, h = bh & 15;
        const size_t rowb = (size_t)b * SEQ; const int colb = h * HD;
        __syncthreads();
        f32x16 S;
#pragma unroll
        for (int i = 0; i < 16; ++i) S[i] = 0.f;
        f32x2 lf[16], lfn[16]; unsigned qv[16], qvn[16]; u32x4 vraw, vrawn;
#define HG_LOAD_RAW(cn_, lf, qv, vraw) do { _Pragma("unroll") for (int i = 0; i < 16; ++i) { const size_t ro_ = (rowb + 64 * (cn_) + 16 * wave + i) * DM + colb;     \
            lf[i] = *(const f32x2*)((LOGF + ro_) + 2 * lane); qv[i] = *(const unsigned*)((Q0 + ro_) + 2 * lane); } \
            vraw = *(const u32x4*)((V0 + (rowb + 64 * (cn_)) * DM + colb + c4 * 32) + vs * DM + v8); } while (0)
        if (isP) HG_LOAD_RAW(0, lf, qv, vraw);
        for (int it = -1; it < 64; ++it) {
            const int cn = it + 1;
            LAS unsigned char* Sc = L + (it & 1) * SETSZ;
            LAS unsigned char* Sn = L + (cn & 1) * SETSZ;
            const int sopc = (it & 1) ? SOP1 : SOP0, sopn = (it & 1) ? SOP0 : SOP1;
            if (isP) {
                if (cn < 64) {
                    float s0 = 0.f, s1 = 0.f;
#pragma unroll
                    for (int i = 0; i < 16; ++i) { s0 += lf[i].x; s1 += lf[i].y; }
                    *(LAS f32x2*)(L + SEGT + (wave * 128 + 2 * lane) * 4) = (f32x2){s0, s1};
                }
            } else {
                const int mw = wave - 4;
                if (it < 0) { for (int e = lane + 64 * mw; e < 8704 / 4; e += 256) ((LAS unsigned*)(L + SOP0))[e] = 0u; }
                else {
                    f32x16 U;
#pragma unroll
                    for (int i = 0; i < 16; ++i) U[i] = 0.f;
#pragma unroll
                    for (int ss = 0; ss < 4; ++ss) { const bf16x8 a = *(const LAS bf16x8*)(Sc + KST + (32 * mw + r32) * RS2 + 32 * ss + 16 * hi);
                        const bf16x8 bv = *(const LAS bf16x8*)(Sc + VT + r32 * RS2 + 32 * ss + 16 * hi);
                        U = __builtin_amdgcn_mfma_f32_32x32x16_bf16(a, bv, U, 0, 0, 0); }
#pragma unroll
                    for (int g = 0; g < 4; ++g) { const int k0 = 32 * mw + 8 * g + 4 * hi;
                        const f32x4 el = *(const LAS f32x4*)(Sc + VEC + k0 * 4), dl = *(const LAS f32x4*)(Sc + VEC + 512 + k0 * 4);
#pragma unroll
                        for (int e = 0; e < 4; ++e) S[4 * g + e] = dl[e] * S[4 * g + e] + el[e] * U[4 * g + e]; }
                    if (mw < 3) {
                        const int si = mw >> 1, ti = (mw + 1) >> 1;
                        f32x16 acc;
#pragma unroll
                        for (int i = 0; i < 16; ++i) acc[i] = 0.f;
#pragma unroll
                        for (int ks = 0; ks < 8; ++ks) { const bf16x8 a = *(const LAS bf16x8*)(Sc + KS + (32 * si + r32) * RS + 32 * ks + 16 * hi);
                            const bf16x8 bq = *(const LAS bf16x8*)(Sc + QS + (32 * ti + r32) * RS + 32 * ks + 16 * hi);
                            acc = __builtin_amdgcn_mfma_f32_32x32x16_bf16(a, bq, acc, 0, 0, 0); }
                        const int t = 32 * ti + r32;
#pragma unroll
                        for (int q = 0; q < 16; ++q) { const int sidx = 32 * si + crow(q, hi); if (sidx > t) acc[q] = 0.f; }
#pragma unroll
                        for (int g = 0; g < 4; ++g) *(LAS u32x2*)(L + PP + t * RS2 + (32 * si + 8 * g + 4 * hi) * 2) = pack4bf(acc[4 * g], acc[4 * g + 1], acc[4 * g + 2], acc[4 * g + 3]);
                    }
                }
            }
            LDS_BARRIER();
            if (isP) {
                if (cn < 64) {
                    if (cn + 1 < 64) HG_LOAD_RAW(cn + 1, lfn, qvn, vrawn);
                    float pre0 = 0.f, pre1 = 0.f, br0 = 0.f, br1 = 0.f, bl0 = 0.f, bl1 = 0.f;
#pragma unroll
                    for (int w = 0; w < 4; ++w) { const f32x2 v = *(const LAS f32x2*)(L + SEGT + (w * 128 + 2 * lane) * 4);
                        if (w < wave) { pre0 += v.x; pre1 += v.y; } if (w < 2) { br0 += v.x; br1 += v.y; } bl0 += v.x; bl1 += v.y; }
                    if (wave == 0) { *(LAS f32x2*)(Sn + VEC + (2 * lane) * 4) = (f32x2){__expf(bl0 - br0), __expf(bl1 - br1)}; *(LAS f32x2*)(Sn + VEC + 512 + (2 * lane) * 4) = (f32x2){__expf(bl0), __expf(bl1)}; }
                    unsigned kt0[8], kt1[8]; float kp0 = 0.f, kp1 = 0.f;
                    float b0 = pre0 - br0, b1 = pre1 - br1;
#pragma unroll
                    for (int i = 0; i < 16; ++i) { const int t = 16 * wave + i;
                        const float q0 = __uint_as_float(qv[i] << 16), q1 = __uint_as_float(qv[i] & 0xffff0000u);
                        b0 += lf[i].x; b1 += lf[i].y;
                        const float d0 = fminf(fmaxf(b0, -80.f), 80.f), d1 = fminf(fmaxf(b1, -80.f), 80.f);
                        const float ks0 = (1.f - __expf(lf[i].x)) * __expf(-d0), ks1 = (1.f - __expf(lf[i].y)) * __expf(-d1);
                        *(LAS unsigned*)(Sn + QS + t * RS + 4 * lane) = pg8::cvt_pk_bf16(q0 * __expf(d0), q1 * __expf(d1));
                        *(LAS unsigned*)(Sn + KS + t * RS + 4 * lane) = pg8::cvt_pk_bf16(ks0, ks1);
                        if (i & 1) { kt0[i >> 1] = pg8::cvt_pk_bf16(kp0, ks0); kt1[i >> 1] = pg8::cvt_pk_bf16(kp1, ks1); }
                        else { kp0 = ks0; kp1 = ks1; } }
                    *(LAS u32x4*)(Sn + KST + (2 * lane) * RS2 + 32 * wave) = (u32x4){kt0[0], kt0[1], kt0[2], kt0[3]}; *(LAS u32x4*)(Sn + KST + (2 * lane) * RS2 + 32 * wave + 16) = (u32x4){kt0[4], kt0[5], kt0[6], kt0[7]};
                    *(LAS u32x4*)(Sn + KST + (2 * lane + 1) * RS2 + 32 * wave) = (u32x4){kt1[0], kt1[1], kt1[2], kt1[3]}; *(LAS u32x4*)(Sn + KST + (2 * lane + 1) * RS2 + 32 * wave + 16) = (u32x4){kt1[4], kt1[5], kt1[6], kt1[7]};
                    { LAS bf16_t* vt = (LAS bf16_t*)(Sn + VT);
                      vt[(v8 + 0) * (RS2 / 2) + vs] = (bf16_t)(vraw.x & 0xffff); vt[(v8 + 1) * (RS2 / 2) + vs] = (bf16_t)(vraw.x >> 16);
                      vt[(v8 + 2) * (RS2 / 2) + vs] = (bf16_t)(vraw.y & 0xffff); vt[(v8 + 3) * (RS2 / 2) + vs] = (bf16_t)(vraw.y >> 16);
                      vt[(v8 + 4) * (RS2 / 2) + vs] = (bf16_t)(vraw.z & 0xffff); vt[(v8 + 5) * (RS2 / 2) + vs] = (bf16_t)(vraw.z >> 16);
                      vt[(v8 + 6) * (RS2 / 2) + vs] = (bf16_t)(vraw.w & 0xffff); vt[(v8 + 7) * (RS2 / 2) + vs] = (bf16_t)(vraw.w >> 16); }
#pragma unroll
                    for (int i = 0; i < 16; ++i) { lf[i] = lfn[i]; qv[i] = qvn[i]; }
                    vraw = vrawn;
                }
            } else if (it >= 0) {
                const int mw = wave - 4;
                if (cn < 64) {
#pragma unroll
                    for (int g = 0; g < 4; ++g) { const int k0 = 32 * mw + 8 * g + 4 * hi;
                        const f32x4 s0 = *(const LAS f32x4*)(L + SEGT + k0 * 4), s1 = *(const LAS f32x4*)(L + SEGT + (128 + k0) * 4);
                        *(LAS u32x2*)(L + sopn + r32 * RS + k0 * 2) = pack4bf(S[4 * g] * __expf(s0[0] + s1[0]), S[4 * g + 1] * __expf(s0[1] + s1[1]), S[4 * g + 2] * __expf(s0[2] + s1[2]), S[4 * g + 3] * __expf(s0[3] + s1[3])); }
                }
                if (mw < 2) {
                    const int ti = mw;
                    f32x16 o;
#pragma unroll
                    for (int i = 0; i < 16; ++i) o[i] = 0.f;
#pragma unroll
                    for (int ks = 0; ks < 8; ++ks) { const bf16x8 a = *(const LAS bf16x8*)(Sc + QS + (32 * ti + r32) * RS + 32 * ks + 16 * hi);
                        const bf16x8 bs = *(const LAS bf16x8*)(L + sopc + r32 * RS + 32 * ks + 16 * hi);
                        o = __builtin_amdgcn_mfma_f32_32x32x16_bf16(a, bs, o, 0, 0, 0); }
#pragma unroll
                    for (int ss = 0; ss < 4; ++ss) { if (ss < 2 || ti == 1) {
                        const bf16x8 a = *(const LAS bf16x8*)(L + PP + (32 * ti + r32) * RS2 + 32 * ss + 16 * hi);
                        const bf16x8 bv = *(const LAS bf16x8*)(Sc + VT + r32 * RS2 + 32 * ss + 16 * hi);
                        o = __builtin_amdgcn_mfma_f32_32x32x16_bf16(a, bv, o, 0, 0, 0); } }
                    bf16_t* orow = O0 + (rowb + 64 * it + 32 * ti) * DM + colb + c4 * 32 + r32;
#pragma unroll
                    for (int q = 0; q < 16; ++q) orow[(size_t)crow(q, hi) * DM] = (bf16_t)f2bf(o[q]);
                }
            }
            LDS_BARRIER();
        }
#undef HG_LOAD_RAW
    }
}
namespace hg3 {
constexpr int RS = 272, RS2 = 144;
constexpr int QS = 0, KS = 17408, VT = 33792, VEC = 37888, SETSZ = 38912;
constexpr int PP = 2 * SETSZ, SOP0 = PP + 9216, SOP1 = SOP0 + 8704, SEGT = SOP1 + 8704;
struct Raw { f16x4 lf[8]; u32x2 q[8]; u32x4 v; };
typedef short v4i16_t __attribute__((ext_vector_type(4)));
__device__ __forceinline__ int offb(int row, int ch) { return 256 * row + 16 * (ch ^ (((row & 3) << 2) | ((row >> 2) & 3))); }
__device__ __forceinline__ v4i16_t trrd(const LAS unsigned char* p) { return __builtin_amdgcn_ds_read_tr16_b64_v4i16((LAS v4i16_t*)p); }
__device__ __forceinline__ bf16x8 tr_frag_ks(const LAS unsigned char* Kb, int lane, int c, int ks) {
    const int h = lane >> 5, blk = (lane >> 4) & 1, q = (lane & 15) >> 2, pp = lane & 3, r0 = 16 * ks + 8 * h + q, ch = 4 * c + 2 * blk + (pp >> 1);
    const v4i16_t lo = trrd(Kb + offb(r0, ch) + 8 * (pp & 1)), hi4 = trrd(Kb + offb(r0 + 4, ch) + 8 * (pp & 1));
    return (bf16x8){lo[0], lo[1], lo[2], lo[3], hi4[0], hi4[1], hi4[2], hi4[3]};
}
__device__ __forceinline__ bf16x8 tr_frag_v(const LAS unsigned char* Vb, int lane, int ks) {
    const int h = lane >> 5, blk = (lane >> 4) & 1, q = (lane & 15) >> 2, pp = lane & 3;
    const LAS unsigned char* a = Vb + (16 * ks + 8 * h + q) * 64 + (2 * blk + (pp >> 1)) * 16 + 8 * (pp & 1);
    const v4i16_t lo = trrd(a), hi4 = trrd(a + 4 * 64);
    return (bf16x8){lo[0], lo[1], lo[2], lo[3], hi4[0], hi4[1], hi4[2], hi4[3]};
}
}
__device__ __forceinline__ void hg3_a1(LAS unsigned char* L, const hg3::Raw& R, int sg, int k4, int sb, int segt = hg3::SEGT) {
    f32x4 s = __builtin_convertvector(R.lf[0], f32x4);
#pragma unroll
    for (int i = 1; i < 8; ++i) s += __builtin_convertvector(R.lf[i], f32x4);
    *(LAS f32x4*)(L + segt + sb * 4096 + (sg * 128 + k4) * 4) = s;
}
struct HgA2 { f32x4 bb; };
template <int HALF>
__device__ __forceinline__ void hg3_a2h(LAS unsigned char* L, LAS unsigned char* Sn, const hg3::Raw& R, int sg, int k4, int sb, int vs, int v8, HgA2& st, int segt = hg3::SEGT, bool wr_br = false) {
    using namespace hg3;
    if (HALF == 0) {
        f32x4 pre = {0.f, 0.f, 0.f, 0.f}, br = pre, bl = pre;
#pragma unroll
        for (int w = 0; w < 8; ++w) { const f32x4 v = *(const LAS f32x4*)(L + segt + sb * 4096 + (w * 128 + k4) * 4); if (w < sg) pre += v; if (w < 4) br += v; bl += v; }
        if (sg == 0) { f32x4 el, dl;
#pragma unroll
            for (int e = 0; e < 4; ++e) { el[e] = __expf(bl[e] - br[e]); dl[e] = __expf(bl[e]); }
            *(LAS f32x4*)(Sn + VEC + k4 * 4) = el; *(LAS f32x4*)(Sn + VEC + 512 + k4 * 4) = dl; if (wr_br) *(LAS f32x4*)(Sn + VEC + 1024 + k4 * 4) = br; }
        st.bb = pre - br;
    }
#pragma unroll
    for (int i = 4 * HALF; i < 4 * HALF + 4; ++i) { const int t = 8 * sg + i;
        float q[4]; q[0] = __uint_as_float(R.q[i].x << 16); q[1] = __uint_as_float(R.q[i].x & 0xffff0000u); q[2] = __uint_as_float(R.q[i].y << 16); q[3] = __uint_as_float(R.q[i].y & 0xffff0000u);
        const f32x4 lfi = __builtin_convertvector(R.lf[i], f32x4);
        st.bb += lfi;
        float qs[4], ks[4];
#pragma unroll
        for (int e = 0; e < 4; ++e) { const float d = fminf(fmaxf(st.bb[e], -80.f), 80.f); qs[e] = q[e] * __expf(d); ks[e] = (1.f - __expf(lfi[e])) * __expf(-d); }
        *(LAS u32x2*)(Sn + QS + t * RS + k4 * 2) = pack4bf(qs[0], qs[1], qs[2], qs[3]);
        *(LAS u32x2*)(Sn + KS + offb(t, k4 >> 3) + (k4 & 4) * 2) = pack4bf(ks[0], ks[1], ks[2], ks[3]); }
    if (HALF == 1) *(LAS u32x4*)(Sn + VT + vs * 64 + v8 * 2) = R.v;
}
struct HgA2p { f32x4 tt; };
template <int HALF>
__device__ __forceinline__ void hg3_a2p(LAS unsigned char* L, LAS unsigned char* Sn, const hg3::Raw& R, int sg, int k4, int sb, int vs, int v8, HgA2p& st, int segt) {
    using namespace hg3;
    if (HALF == 0) {
        f32x4 pre = {0.f, 0.f, 0.f, 0.f}, br = pre, bl = pre;
#pragma unroll
        for (int w = 0; w < 8; ++w) { const f32x4 v = *(const LAS f32x4*)(L + segt + sb * 4096 + (w * 128 + k4) * 4); if (w < sg) pre += v; if (w < 4) br += v; bl += v; }
        if (sg == 0) { f32x4 el, dl;
#pragma unroll
            for (int e = 0; e < 4; ++e) { el[e] = __builtin_amdgcn_exp2f(bl[e] - br[e]); dl[e] = __builtin_amdgcn_exp2f(bl[e]); }
            *(LAS f32x4*)(Sn + VEC + k4 * 4) = el; *(LAS f32x4*)(Sn + VEC + 512 + k4 * 4) = dl; *(LAS f32x4*)(Sn + VEC + 1024 + k4 * 4) = br; }
#pragma unroll
        for (int e = 0; e < 4; ++e) st.tt[e] = __builtin_amdgcn_exp2f(fminf(fmaxf(pre[e] - br[e], -115.f), 115.f));
    }
#pragma unroll
    for (int i = 4 * HALF; i < 4 * HALF + 4; ++i) { const int t = 8 * sg + i;
        float q[4]; q[0] = __uint_as_float(R.q[i].x << 16); q[1] = __uint_as_float(R.q[i].x & 0xffff0000u); q[2] = __uint_as_float(R.q[i].y << 16); q[3] = __uint_as_float(R.q[i].y & 0xffff0000u);
        const f32x4 lfi = __builtin_convertvector(R.lf[i], f32x4);
        float qs[4], ks[4];
#pragma unroll
        for (int e = 0; e < 4; ++e) { const float f = __builtin_amdgcn_exp2f(lfi[e]); const float tn = fminf(fmaxf(st.tt[e] * f, 1.8e-35f), 5.5e34f); st.tt[e] = tn;
            qs[e] = q[e] * tn; ks[e] = (1.f - f) * __builtin_amdgcn_rcpf(tn); }
        *(LAS u32x2*)(Sn + QS + t * RS + k4 * 2) = pack4bf(qs[0], qs[1], qs[2], qs[3]);
        *(LAS u32x2*)(Sn + KS + offb(t, k4 >> 3) + (k4 & 4) * 2) = pack4bf(ks[0], ks[1], ks[2], ks[3]); }
    if (HALF == 1) *(LAS u32x4*)(Sn + VT + vs * 64 + v8 * 2) = R.v;
}
__device__ __forceinline__ void hg3_m1(LAS unsigned char* L, LAS unsigned char* Sc, int it, int mw, int r32, int hi, f32x16& S, int pp = hg3::PP, int sop0 = hg3::SOP0) {
    using namespace hg3;
    const int lane = hi * 32 + r32;
    if (it < 0) { for (int e = lane + 64 * mw; e < 8704 / 4; e += 256) ((LAS unsigned*)(L + sop0))[e] = 0u; return; }
    bf16x8 ua[4], ub[4];
#pragma unroll
    for (int ss = 0; ss < 4; ++ss) { ua[ss] = tr_frag_ks(Sc + KS, lane, mw, ss); ub[ss] = tr_frag_v(Sc + VT, lane, ss); }
    f32x4 el[4], dl[4];
#pragma unroll
    for (int g = 0; g < 4; ++g) { const int k0 = 32 * mw + 8 * g + 4 * hi; el[g] = *(const LAS f32x4*)(Sc + VEC + k0 * 4); dl[g] = *(const LAS f32x4*)(Sc + VEC + 512 + k0 * 4); }
    const int si = mw >> 1, ti = (mw + 1) >> 1;
    bf16x8 sa[8], sq[8];
    if (mw < 3) {
#pragma unroll
        for (int ks = 0; ks < 8; ++ks) { sa[ks] = *(const LAS bf16x8*)(Sc + KS + offb(32 * si + r32, 2 * ks + hi)); sq[ks] = *(const LAS bf16x8*)(Sc + QS + (32 * ti + r32) * RS + 32 * ks + 16 * hi); }
    }
    __builtin_amdgcn_sched_barrier(0);
    f32x16 U;
#pragma unroll
    for (int i = 0; i < 16; ++i) U[i] = 0.f;
#pragma unroll
    for (int ss = 0; ss < 4; ++ss) U = __builtin_amdgcn_mfma_f32_32x32x16_bf16(ua[ss], ub[ss], U, 0, 0, 0);
    if (mw < 3) {
        f32x16 acc;
#pragma unroll
        for (int i = 0; i < 16; ++i) acc[i] = 0.f;
#pragma unroll
        for (int ks = 0; ks < 8; ++ks) acc = __builtin_amdgcn_mfma_f32_32x32x16_bf16(sa[ks], sq[ks], acc, 0, 0, 0);
        const int t = 32 * ti + r32;
#pragma unroll
        for (int q = 0; q < 16; ++q) { const int sidx = 32 * si + crow(q, hi); if (sidx > t) acc[q] = 0.f; }
#pragma unroll
        for (int g = 0; g < 4; ++g) *(LAS u32x2*)(L + pp + t * RS2 + (32 * si + 8 * g + 4 * hi) * 2) = pack4bf(acc[4 * g], acc[4 * g + 1], acc[4 * g + 2], acc[4 * g + 3]);
    }
#pragma unroll
    for (int g = 0; g < 4; ++g)
#pragma unroll
        for (int e = 0; e < 4; ++e) S[4 * g + e] = dl[g][e] * S[4 * g + e] + el[g][e] * U[4 * g + e];
}
__device__ __forceinline__ void hg4_m1(LAS unsigned char* L, LAS unsigned char* Sc, int it, int mw, int r32, int hi, f32x16& S, int pp, int sop0) {
    using namespace hg3;
    const int lane = hi * 32 + r32;
    if (it < 0) { for (int e = lane + 64 * mw; e < 8704 / 4; e += 256) ((LAS unsigned*)(L + sop0))[e] = 0u; return; }
    bf16x8 ua[4], ub[4];
#pragma unroll
    for (int ss = 0; ss < 4; ++ss) { ua[ss] = tr_frag_ks(Sc + KS, lane, mw, ss); ub[ss] = tr_frag_v(Sc + VT, lane, ss); }
    f32x4 el[4], dl[4];
#pragma unroll
    for (int g = 0; g < 4; ++g) { const int k0 = 32 * mw + 8 * g + 4 * hi; el[g] = *(const LAS f32x4*)(Sc + VEC + k0 * 4); dl[g] = *(const LAS f32x4*)(Sc + VEC + 512 + k0 * 4); }
    const int si = mw, ti0 = mw;
    bf16x8 sa[8], sq[8];
    if (mw < 2) {
#pragma unroll
        for (int ks = 0; ks < 8; ++ks) { sa[ks] = *(const LAS bf16x8*)(Sc + KS + offb(32 * si + r32, 2 * ks + hi)); sq[ks] = *(const LAS bf16x8*)(Sc + QS + (32 * ti0 + r32) * RS + 32 * ks + 16 * hi); }
    }
    __builtin_amdgcn_sched_barrier(0);
    f32x16 U;
#pragma unroll
    for (int i = 0; i < 16; ++i) U[i] = 0.f;
#pragma unroll
    for (int ss = 0; ss < 4; ++ss) U = __builtin_amdgcn_mfma_f32_32x32x16_bf16(ua[ss], ub[ss], U, 0, 0, 0);
    if (mw < 2) {
        f32x16 acc;
#pragma unroll
        for (int i = 0; i < 16; ++i) acc[i] = 0.f;
#pragma unroll
        for (int ks = 0; ks < 8; ++ks) acc = __builtin_amdgcn_mfma_f32_32x32x16_bf16(sa[ks], sq[ks], acc, 0, 0, 0);
        if (mw == 0) {
#pragma unroll
            for (int ks = 0; ks < 8; ++ks) sq[ks] = *(const LAS bf16x8*)(Sc + QS + (32 + r32) * RS + 32 * ks + 16 * hi);
        }
        { const int t = 32 * ti0 + r32;
#pragma unroll
          for (int q = 0; q < 16; ++q) { const int sidx = 32 * si + crow(q, hi); if (sidx > t) acc[q] = 0.f; }
#pragma unroll
          for (int g = 0; g < 4; ++g) *(LAS u32x2*)(L + pp + t * RS2 + (32 * si + 8 * g + 4 * hi) * 2) = pack4bf(acc[4 * g], acc[4 * g + 1], acc[4 * g + 2], acc[4 * g + 3]); }
        if (mw == 0) {
            __builtin_amdgcn_sched_barrier(0);
            f32x16 ac2;
#pragma unroll
            for (int i = 0; i < 16; ++i) ac2[i] = 0.f;
#pragma unroll
            for (int ks = 0; ks < 8; ++ks) ac2 = __builtin_amdgcn_mfma_f32_32x32x16_bf16(sa[ks], sq[ks], ac2, 0, 0, 0);
            const int t = 32 + r32;
#pragma unroll
            for (int g = 0; g < 4; ++g) *(LAS u32x2*)(L + pp + t * RS2 + (8 * g + 4 * hi) * 2) = pack4bf(ac2[4 * g], ac2[4 * g + 1], ac2[4 * g + 2], ac2[4 * g + 3]);
        }
    }
#pragma unroll
    for (int g = 0; g < 4; ++g)
#pragma unroll
        for (int e = 0; e < 4; ++e) S[4 * g + e] = dl[g][e] * S[4 * g + e] + el[g][e] * U[4 * g + e];
}
__device__ __forceinline__ void hg3_m2(LAS unsigned char* L, LAS unsigned char* Sc, int sopc, int sopn, int it, int mw, int r32, int hi, const f32x16& S, bf16_t* Ob, int pp = hg3::PP, const LAS unsigned char* brp = nullptr, bool out_hi = false, bool wide = false) {
    using namespace hg3;
    const int lane = hi * 32 + r32;
    const int sbn = ((it + 1) & 1) * 4096;
    const int ti = out_hi ? mw - 2 : mw;
    const bool outw = out_hi ? (mw >= 2) : (mw < 2);
    bf16x8 oa[8], ob[8], pa[4], pv[4];
    if (outw) {
#pragma unroll
        for (int ks = 0; ks < 8; ++ks) { oa[ks] = *(const LAS bf16x8*)(Sc + QS + (32 * ti + r32) * RS + 32 * ks + 16 * hi); ob[ks] = *(const LAS bf16x8*)(L + sopc + r32 * RS + 32 * ks + 16 * hi); }
#pragma unroll
        for (int ss = 0; ss < 4; ++ss) { pa[ss] = *(const LAS bf16x8*)(L + pp + (32 * ti + r32) * RS2 + 32 * ss + 16 * hi); pv[ss] = tr_frag_v(Sc + VT, lane, ss); }
    }
    f32x4 sb[4];
    if (it + 1 < 64) {
#pragma unroll
        for (int g = 0; g < 4; ++g) { const int k0 = 32 * mw + 8 * g + 4 * hi;
            if (brp != nullptr) sb[g] = *(const LAS f32x4*)(brp + k0 * 4);
            else sb[g] = (*(const LAS f32x4*)(L + SEGT + sbn + k0 * 4) + *(const LAS f32x4*)(L + SEGT + sbn + (128 + k0) * 4)) + (*(const LAS f32x4*)(L + SEGT + sbn + (256 + k0) * 4) + *(const LAS f32x4*)(L + SEGT + sbn + (384 + k0) * 4)); }
    }
    __builtin_amdgcn_sched_barrier(0);
    if (outw) {
        f32x16 o;
#pragma unroll
        for (int i = 0; i < 16; ++i) o[i] = 0.f;
#pragma unroll
        for (int ks = 0; ks < 8; ++ks) o = __builtin_amdgcn_mfma_f32_32x32x16_bf16(oa[ks], ob[ks], o, 0, 0, 0);
#pragma unroll
        for (int ss = 0; ss < 4; ++ss) { if (ss < 2 || ti == 1) o = __builtin_amdgcn_mfma_f32_32x32x16_bf16(pa[ss], pv[ss], o, 0, 0, 0); }
        if (wide) {
            LAS unsigned char* Tp = L + pp + (32 * ti) * RS2;
            asm volatile("s_nop 15\n\ts_nop 7" : "+v"(o));
#pragma unroll
            for (int qq = 0; qq < 8; ++qq) { const unsigned w = pg8::cvt_pk_bf16(o[2 * qq], o[2 * qq + 1]);
                *(LAS bf16_t*)(Tp + crow(2 * qq, hi) * RS2 + r32 * 2) = (bf16_t)(w & 0xffffu); *(LAS bf16_t*)(Tp + crow(2 * qq + 1, hi) * RS2 + r32 * 2) = (bf16_t)(w >> 16); }
            asm volatile("s_waitcnt lgkmcnt(0)" ::: "memory");
#pragma unroll
            for (int i = 0; i < 2; ++i) { const int row = (lane >> 2) + 16 * i, ch = lane & 3;
                const u32x4 v = *(const LAS u32x4*)(Tp + row * RS2 + ch * 16);
                *(u32x4*)(Ob + (size_t)(32 * ti + row) * DM + ch * 8) = v; }
        } else {
        bf16_t* orow = Ob + (size_t)(32 * ti) * DM + r32;
#pragma unroll
        for (int q = 0; q < 16; ++q) orow[(size_t)crow(q, hi) * DM] = (bf16_t)f2bf(o[q]);
        }
    }
    if (it + 1 < 64) {
#pragma unroll
        for (int g = 0; g < 4; ++g) { const int k0 = 32 * mw + 8 * g + 4 * hi;
            *(LAS u32x2*)(L + sopn + r32 * RS + k0 * 2) = (brp != nullptr) ? pack4bf(S[4 * g] * __builtin_amdgcn_exp2f(sb[g][0]), S[4 * g + 1] * __builtin_amdgcn_exp2f(sb[g][1]), S[4 * g + 2] * __builtin_amdgcn_exp2f(sb[g][2]), S[4 * g + 3] * __builtin_amdgcn_exp2f(sb[g][3]))
                                                                              : pack4bf(S[4 * g] * __expf(sb[g][0]), S[4 * g + 1] * __expf(sb[g][1]), S[4 * g + 2] * __expf(sb[g][2]), S[4 * g + 3] * __expf(sb[g][3])); }
    }
}
template <int MODE>
__device__ __forceinline__ void hgrn_chunk3(const Params& p, unsigned char* lds_g) {
    using namespace hg3;
    LAS unsigned char* L = (LAS unsigned char*)lds_g;
    const int tid = threadIdx.x, lane = tid & 63, wave = __builtin_amdgcn_readfirstlane(tid >> 6), r32 = lane & 31, hi = lane >> 5;
    const bf16_t* Q0 = (const bf16_t*)(p.ws + WS_B); const bf16_t* V0 = (const bf16_t*)(p.ws + WS_B + 64 * MiB);
    const _Float16* LOGF16 = (const _Float16*)p.out; bf16_t* O0 = MODE == 2 ? (bf16_t*)((unsigned char*)p.out + 64 * MiB) : (bf16_t*)(p.ws + WS_E);
    const bool isP = wave < 4;
    const int sg = 2 * (wave & 3) + hi, k4 = 4 * r32;
    const int vs = (tid & 255) >> 2, v8 = (tid & 3) * 8;
    for (int unit = blockIdx.x; unit < 256; unit += gridDim.x) {
        const int bh = unit & 63, c4 = unit >> 6, b = bh >> 4, h = bh & 15;
        const size_t rowb = (size_t)b * SEQ; const int colb = h * HD;
        __syncthreads();
        f32x16 S;
#pragma unroll
        for (int i = 0; i < 16; ++i) S[i] = 0.f;
        Raw R0, R1, R2;
#define HG_LOAD(cn_, R_) do { int lo_ = hi * 8 * DM + k4, vo_ = vs * DM + v8; asm volatile("" : "+v"(lo_), "+v"(vo_));     \
            _Pragma("unroll") for (int i = 0; i < 8; ++i) { const size_t ro_ = (rowb + 64 * (cn_) + 8 * (2 * (wave & 3)) + i) * DM + colb;     \
            R_.lf[i] = *(const f16x4*)((LOGF16 + ro_) + lo_); R_.q[i] = *(const u32x2*)((Q0 + ro_) + lo_); } \
            R_.v = *(const u32x4*)((V0 + (rowb + 64 * (cn_)) * DM + colb + c4 * 32) + vo_); } while (0)
        if (isP) {
            __builtin_amdgcn_s_setprio(1);
            HgA2 st;
            if (MODE != 2) { HG_LOAD(0, R0); HG_LOAD(1, R1); hg3_a1(L, R0, sg, k4, 0); }
            LDS_BARRIER();
#define HG_PITER(it_, RC_, RN_, RF_) do { const int cn = (it_) + 1; LAS unsigned char* Sn = L + (cn & 1) * SETSZ; const int cf = cn + 2 < 63 ? cn + 2 : 63; \
            if (MODE != 2) { HG_LOAD(cf, RF_); hg3_a2h<0>(L, Sn, RC_, sg, k4, cn & 1, vs, v8, st); } LDS_BARRIER(); \
            if (MODE != 2) { hg3_a2h<1>(L, Sn, RC_, sg, k4, cn & 1, vs, v8, st); hg3_a1(L, RN_, sg, k4, (cn + 1) & 1); } LDS_BARRIER(); } while (0)
            for (int base = -1; base < 65; base += 3) { HG_PITER(base, R0, R1, R2); HG_PITER(base + 1, R1, R2, R0); HG_PITER(base + 2, R2, R0, R1); }
#undef HG_PITER
            __builtin_amdgcn_s_setprio(0);
        } else {
            LDS_BARRIER();
            for (int it = -1; it < 65; ++it) {
                LAS unsigned char* Sc = L + (it & 1) * SETSZ; const int sopc = (it & 1) ? SOP1 : SOP0, sopn = (it & 1) ? SOP0 : SOP1;
                if (MODE != 1 && it < 64) hg3_m1(L, Sc, it, wave - 4, r32, hi, S);
                LDS_BARRIER();
                if (MODE != 1 && it >= 0 && it < 64) hg3_m2(L, Sc, sopc, sopn, it, wave - 4, r32, hi, S, O0 + (rowb + 64 * it) * DM + colb + c4 * 32);
                LDS_BARRIER();
            }
        }
#undef HG_LOAD
    }
}
namespace hg4 {
constexpr int SETSZ = hg3::SETSZ + 512;
constexpr int PP0 = 3 * SETSZ, PP1 = PP0 + 9216, SOP0 = PP1 + 9216, SOP1 = SOP0 + 8704, SEGT = SOP1 + 8704, END = SEGT + 8192;
static_assert(END <= LDS_BYTES - 16, "hgrn_chunk4 LDS map");
}
__device__ __forceinline__ void hgrn_chunk4(const Params& p, unsigned char* lds_g) {
    using namespace hg3;
    LAS unsigned char* L = (LAS unsigned char*)lds_g;
    const int tid = threadIdx.x, lane = tid & 63, wave = __builtin_amdgcn_readfirstlane(tid >> 6), r32 = lane & 31, hi = lane >> 5;
    const bf16_t* Q0 = (const bf16_t*)(p.ws + WS_B); const bf16_t* V0 = (const bf16_t*)(p.ws + WS_B + 64 * MiB);
    const _Float16* LOGF16 = (const _Float16*)p.out; bf16_t* O0 = (bf16_t*)(p.ws + WS_E);
    const bool isP = wave < 4;
    const int sg = 2 * (wave & 3) + hi, k4 = 4 * r32;
    const int vs = (tid & 255) >> 2, v8 = (tid & 3) * 8;
    for (int unit = blockIdx.x; unit < 256; unit += gridDim.x) {
        const int bh = unit & 63, c4 = unit >> 6, b = bh >> 4, h = bh & 15;
        const size_t rowb = (size_t)b * SEQ; const int colb = h * HD;
        __syncthreads();
        f32x16 S;
#pragma unroll
        for (int i = 0; i < 16; ++i) S[i] = 0.f;
        Raw R0, R1, R2;
#define HG_LOAD(cn_, R_) do { int lo_ = hi * 8 * DM + k4, vo_ = vs * DM + v8; asm volatile("" : "+v"(lo_), "+v"(vo_));     \
            _Pragma("unroll") for (int i = 0; i < 8; ++i) { const size_t ro_ = (rowb + 64 * (cn_) + 8 * (2 * (wave & 3)) + i) * DM + colb;     \
            R_.lf[i] = *(const f16x4*)((LOGF16 + ro_) + lo_); R_.q[i] = *(const u32x2*)((Q0 + ro_) + lo_); } \
            R_.v = *(const u32x4*)((V0 + (rowb + 64 * (cn_)) * DM + colb + c4 * 32) + vo_); } while (0)
        if (isP) {
            __builtin_amdgcn_s_setprio(1);
            HgA2p st;
            HG_LOAD(0, R0); HG_LOAD(1, R1); hg3_a1(L, R0, sg, k4, 0, hg4::SEGT);
            LDS_BARRIER();
#define HG_PSTEP(s_, RC_, RN_, RF_) do { const int cn = (s_) + 1; LAS unsigned char* Sn = L + (cn % 3) * hg4::SETSZ; const int cf = cn + 2 < 63 ? cn + 2 : 63; \
            HG_LOAD(cf, RF_); hg3_a2p<0>(L, Sn, RC_, sg, k4, cn & 1, vs, v8, st, hg4::SEGT); hg3_a2p<1>(L, Sn, RC_, sg, k4, cn & 1, vs, v8, st, hg4::SEGT); \
            hg3_a1(L, RN_, sg, k4, (cn + 1) & 1, hg4::SEGT); LDS_BARRIER(); } while (0)
            for (int base = -1; base < 65; base += 3) { HG_PSTEP(base, R0, R1, R2); HG_PSTEP(base + 1, R1, R2, R0); HG_PSTEP(base + 2, R2, R0, R1); }
#undef HG_PSTEP
            __builtin_amdgcn_s_setprio(0);
        } else {
            LDS_BARRIER();
            for (int s = -1; s < 65; ++s) {
                const int c2 = s - 1;
                if (c2 >= 0 && c2 < 64) hg3_m2(L, L + (c2 % 3) * hg4::SETSZ, (c2 & 1) ? hg4::SOP1 : hg4::SOP0, (c2 & 1) ? hg4::SOP0 : hg4::SOP1, c2, wave - 4, r32, hi, S,
                                               O0 + (rowb + 64 * c2) * DM + colb + c4 * 32, (c2 & 1) ? hg4::PP1 : hg4::PP0, L + ((c2 + 1) % 3) * hg4::SETSZ + VEC + 1024, true, true);
                if (s < 64) hg3_m1(L, L + ((s + 3) % 3) * hg4::SETSZ, s, wave - 4, r32, hi, S, (s & 1) ? hg4::PP1 : hg4::PP0, hg4::SOP0);
                LDS_BARRIER();
            }
        }
#undef HG_LOAD
    }
}
__device__ __forceinline__ void hn_unpack(const u32x4 v, float (&o)[8]) {
    o[0] = __uint_as_float(v.x << 16); o[1] = __uint_as_float(v.x & 0xffff0000u); o[2] = __uint_as_float(v.y << 16); o[3] = __uint_as_float(v.y & 0xffff0000u);
    o[4] = __uint_as_float(v.z << 16); o[5] = __uint_as_float(v.z & 0xffff0000u); o[6] = __uint_as_float(v.w << 16); o[7] = __uint_as_float(v.w & 0xffff0000u);
}
__device__ __forceinline__ void hgrn_headnorm(const Params& p) {
    const int tid = threadIdx.x, lane = tid & 63, wave = tid >> 6, gw = blockIdx.x * 8 + wave, NGW = gridDim.x * 8;
    const bf16_t* O0 = (const bf16_t*)(p.ws + WS_E); const bf16_t* Z0 = (const bf16_t*)(p.ws + WS_D); bf16_t* ON = (bf16_t*)(p.ws + WS_A);
    const int sub = lane & 15;
    float gn[8];
#pragma unroll
    for (int e = 0; e < 8; ++e) gn[e] = p.hgrn_head_gain[8 * sub + e];
    constexpr int NR4 = T * NH / 4;
    for (int r4 = gw; r4 < NR4; r4 += 4 * NGW) {
        size_t off[4]; u32x4 ov[4], zv[4];
#pragma unroll
        for (int u = 0; u < 4; ++u) { const int rr = r4 + u * NGW < NR4 ? r4 + u * NGW : r4; off[u] = ((size_t)rr * 4 + (lane >> 4)) * 128 + 8 * sub; ov[u] = *(const u32x4*)(O0 + off[u]); zv[u] = *(const u32x4*)(Z0 + off[u]); }
#pragma unroll
        for (int u = 0; u < 4; ++u) { float o[8], z[8]; hn_unpack(ov[u], o); hn_unpack(zv[u], z);
#pragma unroll
            for (int e = 0; e < 8; ++e) z[e] = z[e] * sigmoidf_(z[e]);
            float ss = 0.f;
#pragma unroll
            for (int e = 0; e < 8; ++e) ss += o[e] * o[e];
            ss += __shfl_xor(ss, 1); ss += __shfl_xor(ss, 2); ss += __shfl_xor(ss, 4); ss += __shfl_xor(ss, 8);
            const float rr = rsqrtf(ss * (1.f / HD) + RMS_EPS);
            u32x4 w; w.x = pk2(o[0] * rr * gn[0] * z[0], o[1] * rr * gn[1] * z[1]); w.y = pk2(o[2] * rr * gn[2] * z[2], o[3] * rr * gn[3] * z[3]);
            w.z = pk2(o[4] * rr * gn[4] * z[4], o[5] * rr * gn[5] * z[5]); w.w = pk2(o[6] * rr * gn[6] * z[6], o[7] * rr * gn[7] * z[7]);
            *(u32x4*)(ON + off[u]) = w; }
    }
}
template <bool OUT_BF16>
__device__ __forceinline__ void rows_rms2(const float* X, const float* gain, void* Ov, const int tidv) {
    const int lane = tidv & 63, gw = blockIdx.x * 8 + (tidv >> 6), NGW = gridDim.x * 8;
    const f32x4* gr = (const f32x4*)gain + lane;
    for (int m = gw; m < T; m += 2 * NGW) {
        const int m2 = m + NGW < T ? m + NGW : m;
        const f32x4* xa = (const f32x4*)(X + (size_t)m * DM) + lane; const f32x4* xb = (const f32x4*)(X + (size_t)m2 * DM) + lane;
        f32x4 va[8], vb[8]; float sa = 0.f, sb = 0.f;
#pragma unroll
        for (int j = 0; j < 8; ++j) va[j] = xa[64 * j];
#pragma unroll
        for (int j = 0; j < 8; ++j) vb[j] = xb[64 * j];
#pragma unroll
        for (int j = 0; j < 8; ++j) { sa += (va[j].x * va[j].x + va[j].y * va[j].y) + (va[j].z * va[j].z + va[j].w * va[j].w); sb += (vb[j].x * vb[j].x + vb[j].y * vb[j].y) + (vb[j].z * vb[j].z + vb[j].w * vb[j].w); }
        const float ra = rsqrtf(wave_sum(sa) * (1.f / DM) + RMS_EPS), rb = rsqrtf(wave_sum(sb) * (1.f / DM) + RMS_EPS);
        if (OUT_BF16) { u32x2* oa = (u32x2*)((bf16_t*)Ov + (size_t)m * DM) + lane; u32x2* ob = (u32x2*)((bf16_t*)Ov + (size_t)m2 * DM) + lane;
#pragma unroll
            for (int j = 0; j < 8; ++j) { const f32x4 g = gr[64 * j]; u32x2 w; w.x = pk2(va[j].x * ra * g.x, va[j].y * ra * g.y); w.y = pk2(va[j].z * ra * g.z, va[j].w * ra * g.w); oa[64 * j] = w;
                w.x = pk2(vb[j].x * rb * g.x, vb[j].y * rb * g.y); w.y = pk2(vb[j].z * rb * g.z, vb[j].w * rb * g.w); ob[64 * j] = w; } }
        else { f32x4* oa = (f32x4*)((float*)Ov + (size_t)m * DM) + lane; f32x4* ob = (f32x4*)((float*)Ov + (size_t)m2 * DM) + lane;
#pragma unroll
            for (int j = 0; j < 8; ++j) { const f32x4 g = gr[64 * j]; oa[64 * j] = va[j] * ra * g; ob[64 * j] = vb[j] * rb * g; } }
    }
}
template <bool OUT_BF16>
__device__ __forceinline__ void rows_rms_b(const bf16_t* X, const float* gain, void* Ov, const int tidv) {
    const int lane = tidv & 63, gw = blockIdx.x * 8 + (tidv >> 6), NGW = gridDim.x * 8;
    const f32x4* gr = (const f32x4*)gain + 2 * lane;
    for (int m = gw; m < T; m += 4 * NGW) {
        int mr[4]; u32x4 v[4][4]; float rr[4];
#pragma unroll
        for (int r = 0; r < 4; ++r) mr[r] = m + r * NGW < T ? m + r * NGW : m;
#pragma unroll
        for (int r = 0; r < 4; ++r)
#pragma unroll
            for (int j = 0; j < 4; ++j) v[r][j] = *((const u32x4*)(X + (size_t)mr[r] * DM) + lane + 64 * j);
#pragma unroll
        for (int r = 0; r < 4; ++r) { float s = 0.f;
#pragma unroll
            for (int j = 0; j < 4; ++j)
#pragma unroll
                for (int e = 0; e < 4; ++e) { const float lo = __uint_as_float(v[r][j][e] << 16), hi = __uint_as_float(v[r][j][e] & 0xffff0000u); s += lo * lo + hi * hi; }
            rr[r] = s; }
#pragma unroll
        for (int r = 0; r < 4; ++r) rr[r] = rsqrtf(wave_sum(rr[r]) * (1.f / DM) + RMS_EPS);
#pragma unroll
        for (int j = 0; j < 4; ++j) { const f32x4 g0 = gr[128 * j], g1 = gr[128 * j + 1];
#pragma unroll
            for (int r = 0; r < 4; ++r) { const u32x4 q = v[r][j]; const float k = rr[r];
                const f32x4 o0 = (f32x4){__uint_as_float(q.x << 16) * k * g0.x, __uint_as_float(q.x & 0xffff0000u) * k * g0.y, __uint_as_float(q.y << 16) * k * g0.z, __uint_as_float(q.y & 0xffff0000u) * k * g0.w};
                const f32x4 o1 = (f32x4){__uint_as_float(q.z << 16) * k * g1.x, __uint_as_float(q.z & 0xffff0000u) * k * g1.y, __uint_as_float(q.w << 16) * k * g1.z, __uint_as_float(q.w & 0xffff0000u) * k * g1.w};
                if (OUT_BF16) { u32x4 w; w.x = pk2(o0.x, o0.y); w.y = pk2(o0.z, o0.w); w.z = pk2(o1.x, o1.y); w.w = pk2(o1.z, o1.w); *((u32x4*)((bf16_t*)Ov + (size_t)mr[r] * DM) + lane + 64 * j) = w; }
                else { f32x4* o = (f32x4*)((float*)Ov + (size_t)mr[r] * DM) + 2 * lane + 128 * j; o[0] = o0; o[1] = o1; } } }
    }
}
__device__ __forceinline__ void rows_rms16(const float* X, const float* gain, bf16_t* O, const int tidv) {
    const int lane = tidv & 63, gw = blockIdx.x * 8 + (tidv >> 6), NGW = gridDim.x * 8;
    const f32x4* gr = (const f32x4*)gain + 2 * lane;
    for (int m = gw; m < T; m += 2 * NGW) {
        const int m2 = m + NGW < T ? m + NGW : m;
        const f32x4* xa = (const f32x4*)(X + (size_t)m * DM) + 2 * lane; const f32x4* xb = (const f32x4*)(X + (size_t)m2 * DM) + 2 * lane;
        f32x4 va[8], vb[8]; float sa = 0.f, sb = 0.f;
#pragma unroll
        for (int j = 0; j < 4; ++j) { va[2 * j] = xa[128 * j]; va[2 * j + 1] = xa[128 * j + 1]; }
#pragma unroll
        for (int j = 0; j < 4; ++j) { vb[2 * j] = xb[128 * j]; vb[2 * j + 1] = xb[128 * j + 1]; }
#pragma unroll
        for (int j = 0; j < 8; ++j) { sa += (va[j].x * va[j].x + va[j].y * va[j].y) + (va[j].z * va[j].z + va[j].w * va[j].w); sb += (vb[j].x * vb[j].x + vb[j].y * vb[j].y) + (vb[j].z * vb[j].z + vb[j].w * vb[j].w); }
        const float ra = rsqrtf(wave_sum(sa) * (1.f / DM) + RMS_EPS), rb = rsqrtf(wave_sum(sb) * (1.f / DM) + RMS_EPS);
        u32x4* oa = (u32x4*)(O + (size_t)m * DM) + lane; u32x4* ob = (u32x4*)(O + (size_t)m2 * DM) + lane;
#pragma unroll
        for (int j = 0; j < 4; ++j) { const f32x4 g0 = gr[128 * j], g1 = gr[128 * j + 1]; u32x4 w;
            w.x = pk2(va[2 * j].x * ra * g0.x, va[2 * j].y * ra * g0.y); w.y = pk2(va[2 * j].z * ra * g0.z, va[2 * j].w * ra * g0.w);
            w.z = pk2(va[2 * j + 1].x * ra * g1.x, va[2 * j + 1].y * ra * g1.y); w.w = pk2(va[2 * j + 1].z * ra * g1.z, va[2 * j + 1].w * ra * g1.w); oa[64 * j] = w;
            w.x = pk2(vb[2 * j].x * rb * g0.x, vb[2 * j].y * rb * g0.y); w.y = pk2(vb[2 * j].z * rb * g0.z, vb[2 * j].w * rb * g0.w);
            w.z = pk2(vb[2 * j + 1].x * rb * g1.x, vb[2 * j + 1].y * rb * g1.y); w.w = pk2(vb[2 * j + 1].z * rb * g1.z, vb[2 * j + 1].w * rb * g1.w); ob[64 * j] = w; }
    }
}
__device__ __forceinline__ void rows_rms_bf16(const float* X, const float* gain, bf16_t* O, const int tidv) { rows_rms2<true>(X, gain, O, tidv); }
__device__ __forceinline__ void rows_rms_f32(const float* X, const float* gain, float* O, const int tidv) { rows_rms2<false>(X, gain, O, tidv); }

__device__ __forceinline__ float gelu_tanh(float x) { const float u = 0.7978845608028654f * (x + 0.044715f * x * x * x); return 0.5f * x * (1.f + tanhf(u)); }
__device__ __forceinline__ void compress_naive(const Params& p, unsigned char* lds_g) {
    const int tid = threadIdx.x;
    const bf16_t* KV = (const bf16_t*)(p.ws + WS_E);
    const float* misc = (const float*)(p.ws + WS_MISC);
    float* xs = (float*)lds_g;
    float* red = xs + 144 * 128;
    float* hid = red + 4 * 8 * 128;
    const int n = tid & 127, part = tid >> 7;
    for (int unit = blockIdx.x; unit < 2 * 16 * 32; unit += gridDim.x) {
        const int which = unit / 512, bg = (unit % 512) / 32, i0 = (unit % 32) * 8, b = bg >> 2, g = bg & 3;
        const bf16_t* src = KV + (size_t)which * ((size_t)T * 512);
        const float* w1 = which ? p.pv_w1 : p.pk_w1; const float* w2 = which ? p.pv_w2 : p.pk_w2; const float* b1n = which ? p.pv_b1 : p.pk_b1; const float* cvp = misc + MISC_CVP / 4 + which * 8 * 128;
        bf16_t* dst = (bf16_t*)(p.ws + (which ? WS_VCMP : WS_KCMP)) + (size_t)bg * NCMPP * 128;
        __syncthreads();
        for (int e = tid; e < 144 * 128; e += 512) { const int tt = e >> 7, d = e & 127; const int tok = 16 * i0 + tt;
            xs[e] = tok < SEQ ? bf2f(src[(size_t)(b * SEQ + tok) * 512 + g * 128 + d]) : 0.f; }
        __syncthreads();
        float acc[8];
#pragma unroll
        for (int k = 0; k < 8; ++k) acc[k] = 0.f;
        for (int r = part * 1024; r < part * 1024 + 1024; ++r) {
            const float w = w1[(size_t)r * 128 + n]; const int j = r >> 7, d = r & 127;
#pragma unroll
            for (int k = 0; k < 8; ++k) acc[k] += xs[(16 * k + j) * 128 + d] * w;
        }
#pragma unroll
        for (int k = 0; k < 8; ++k) red[(part * 8 + k) * 128 + n] = acc[k];
        __syncthreads();
        for (int e = tid; e < 1024; e += 512) { const int k = e >> 7, nn = e & 127;
            float cvs = b1n[nn]; for (int sl = 0; sl < 8; ++sl) cvs += cvp[sl * 128 + nn];
            const float h = cvs + ((red[(0 * 8 + k) * 128 + nn] + red[(1 * 8 + k) * 128 + nn]) + (red[(2 * 8 + k) * 128 + nn] + red[(3 * 8 + k) * 128 + nn]));
            hid[e] = gelu_tanh(h); }
        __syncthreads();
        for (int e = tid; e < 1024; e += 512) { const int k = e >> 7, nn = e & 127; float s = 0.f;
            for (int m = 0; m < 128; ++m) s += hid[k * 128 + m] * w2[m * 128 + nn];
            const int i = i0 + k;
            dst[(size_t)i * 128 + nn] = (bf16_t)(i < NCMP ? f2bf(s) : 0u); }
    }
}

__device__ __forceinline__ void dot4(const bf16_t* krow, const float* qs, float (&a)[4]) {
    a[0] = a[1] = a[2] = a[3] = 0.f;
#pragma unroll 4
    for (int c = 0; c < 16; ++c) { const u32x4 kv = *(const u32x4*)(krow + 8 * c);
        float kf[8]; kf[0] = __uint_as_float(kv.x << 16); kf[1] = __uint_as_float(kv.x & 0xffff0000u); kf[2] = __uint_as_float(kv.y << 16); kf[3] = __uint_as_float(kv.y & 0xffff0000u);
        kf[4] = __uint_as_float(kv.z << 16); kf[5] = __uint_as_float(kv.z & 0xffff0000u); kf[6] = __uint_as_float(kv.w << 16); kf[7] = __uint_as_float(kv.w & 0xffff0000u);
#pragma unroll
        for (int h = 0; h < 4; ++h) { const f32x4 q0 = *(const f32x4*)(qs + h * 128 + 8 * c), q1 = *(const f32x4*)(qs + h * 128 + 8 * c + 4);
            a[h] += (kf[0] * q0.x + kf[1] * q0.y) + (kf[2] * q0.z + kf[3] * q0.w) + (kf[4] * q1.x + kf[5] * q1.y) + (kf[6] * q1.z + kf[7] * q1.w); } }
}
__device__ __forceinline__ void softmax4(f32x4* pl, int n, int lane) {
    const float NINF = -__builtin_inff();
    f32x4 m = {NINF, NINF, NINF, NINF};
    for (int i = lane; i < n; i += 64) { const f32x4 v = pl[i]; m.x = fmaxf(m.x, v.x); m.y = fmaxf(m.y, v.y); m.z = fmaxf(m.z, v.z); m.w = fmaxf(m.w, v.w); }
    m.x = wave_max(m.x); m.y = wave_max(m.y); m.z = wave_max(m.z); m.w = wave_max(m.w);
    f32x4 s = {0.f, 0.f, 0.f, 0.f};
    for (int i = lane; i < n; i += 64) { const f32x4 v = pl[i]; f32x4 e;
        e.x = m.x == NINF ? 0.f : __expf(v.x - m.x); e.y = m.y == NINF ? 0.f : __expf(v.y - m.y); e.z = m.z == NINF ? 0.f : __expf(v.z - m.z); e.w = m.w == NINF ? 0.f : __expf(v.w - m.w);
        pl[i] = e; s += e; }
    s.x = wave_sum(s.x); s.y = wave_sum(s.y); s.z = wave_sum(s.z); s.w = wave_sum(s.w);
    f32x4 inv; inv.x = s.x > 0.f ? 1.f / s.x : 0.f; inv.y = s.y > 0.f ? 1.f / s.y : 0.f; inv.z = s.z > 0.f ? 1.f / s.z : 0.f; inv.w = s.w > 0.f ? 1.f / s.w : 0.f;
    for (int i = lane; i < n; i += 64) pl[i] = pl[i] * inv;
}
__device__ __forceinline__ void pv_acc(const f32x4 pw, unsigned vv, float (&o)[4][2]) {
    const float v0 = __uint_as_float(vv << 16), v1 = __uint_as_float(vv & 0xffff0000u);
    o[0][0] += pw.x * v0; o[0][1] += pw.x * v1; o[1][0] += pw.y * v0; o[1][1] += pw.y * v1; o[2][0] += pw.z * v0; o[2][1] += pw.z * v1; o[3][0] += pw.w * v0; o[3][1] += pw.w * v1;
}
__device__ __forceinline__ void nsa_naive(const Params& p, unsigned char* lds_g, bf16_t* O1) {
    const int tid = threadIdx.x, lane = tid & 63, wave = tid >> 6;
    const bf16_t* Q1 = (const bf16_t*)(p.ws + WS_D); const bf16_t* KV = (const bf16_t*)(p.ws + WS_E); const bf16_t* Z1 = (const bf16_t*)(p.ws + WS_G);
    const float* GT = (const float*)(p.ws + WS_GATES); const bf16_t* KC = (const bf16_t*)(p.ws + WS_KCMP); const bf16_t* VC = (const bf16_t*)(p.ws + WS_VCMP);
    const float* biasp = (const float*)(p.ws + WS_MISC + MISC_BIASP);
    const size_t TS = (size_t)T * 512;
    const bf16_t* KS = KV + 2 * TS; const bf16_t* VS = KV + 3 * TS; const bf16_t* KW = KV + 4 * TS; const bf16_t* VW = KV + 5 * TS;
    float* qs = (float*)(lds_g + wave * 18432);
    f32x4* pl = (f32x4*)(lds_g + wave * 18432 + 2048);
    const float NINF = -__builtin_inff();
    const int gw = blockIdx.x * 8 + wave, NGW = gridDim.x * 8, NU = NB * NG * SEQ, niter = (NU + NGW - 1) / NGW;
    for (int it = 0; it < niter; ++it) {
        int unit = it * NGW + gw; const bool live = unit < NU; if (!live) unit = NU - 1;
        const int bg = unit / SEQ, t = unit % SEQ, b = bg >> 2, g = bg & 3;
        const size_t row = (size_t)b * SEQ + t;
        __syncthreads();
        { const bf16_t* qrow = Q1 + row * DM + g * 512;
          for (int e = lane; e < 512; e += 64) qs[e] = bf2f(qrow[e]); }
        __syncthreads();
        const float* bp = biasp + (g * 4) * 128;
        for (int c = 0; c < 4; ++c) { const int i = lane + 64 * c; float a[4]; dot4(KC + ((size_t)bg * NCMPP + i) * 128, qs, a);
            const int dist = t - (16 * i + 31); const bool valid = (i < NCMP) && dist >= 0;
            f32x4 l = {NINF, NINF, NINF, NINF};
            if (valid) { const bool nr = dist < 128; l.x = a[0] + (nr ? bp[dist] : 0.f); l.y = a[1] + (nr ? bp[128 + dist] : 0.f); l.z = a[2] + (nr ? bp[256 + dist] : 0.f); l.w = a[3] + (nr ? bp[384 + dist] : 0.f); }
            pl[i] = l; }
        __syncthreads();
        softmax4(pl, 256, lane);
        __syncthreads();
        float oc[4][2] = {};
        { const int imax = t >= 31 ? (t - 31) / 16 : -1;
          const unsigned* vb = (const unsigned*)(VC + (size_t)bg * NCMPP * 128) + lane;
#pragma unroll 8
          for (int i = 0; i <= imax; ++i) pv_acc(pl[i], vb[(size_t)i * 64], oc); }
        unsigned long long selmask;
        { const int j = lane; float imp = 0.f;
          for (int i = 4 * j - 1; i <= 4 * j + 3; ++i) if (i >= 0 && i < NCMP) { const f32x4 v = pl[i]; imp += (v.x + v.y) + (v.z + v.w); }
          const int cur = t >> 6; const bool forced = (j == 0) || (j == cur) || (j == cur - 1), visible = (j * 64 <= t);
          const float score = forced ? 1e9f : (visible ? imp : -1e30f);
          int rank = 0;
          for (int jj = 0; jj < 64; ++jj) { const float s2 = __shfl(score, jj); rank += (s2 > score || (s2 == score && jj < j)) ? 1 : 0; }
          selmask = __ballot(rank < 16); }
        __syncthreads();
        { int slot = 0;
          for (int jb = 0; jb < 64; ++jb) { if (!((selmask >> jb) & 1ull)) continue;
              const int pos = jb * 64 + lane; float a[4]; dot4(KS + ((size_t)b * SEQ + pos) * 512 + g * 128, qs, a);
              const int dist = t - pos; f32x4 l = {NINF, NINF, NINF, NINF};
              if (dist >= 0) { const bool nr = dist < 128; l.x = a[0] + (nr ? bp[dist] : 0.f); l.y = a[1] + (nr ? bp[128 + dist] : 0.f); l.z = a[2] + (nr ? bp[256 + dist] : 0.f); l.w = a[3] + (nr ? bp[384 + dist] : 0.f); }
              pl[slot * 64 + lane] = l; ++slot; } }
        __syncthreads();
        softmax4(pl, 1024, lane);
        __syncthreads();
        float os[4][2] = {};
        { int slot = 0;
          for (int jb = 0; jb < 64; ++jb) { if (!((selmask >> jb) & 1ull)) continue;
              if (jb * 64 <= t) { const unsigned* vb = (const unsigned*)(VS + ((size_t)b * SEQ + jb * 64) * 512 + g * 128) + lane;
#pragma unroll 8
                  for (int kk = 0; kk < 64; ++kk) pv_acc(pl[slot * 64 + kk], vb[(size_t)kk * 256], os); }
              ++slot; } }
        __syncthreads();
        for (int c = 0; c < 8; ++c) { const int m = lane + 64 * c, pos = t - 511 + m; const int pc = pos < 0 ? 0 : pos; float a[4]; dot4(KW + ((size_t)b * SEQ + pc) * 512 + g * 128, qs, a);
            const int dist = 511 - m; f32x4 l = {NINF, NINF, NINF, NINF};
            if (pos >= 0) { const bool nr = dist < 128; l.x = a[0] + (nr ? bp[dist] : 0.f); l.y = a[1] + (nr ? bp[128 + dist] : 0.f); l.z = a[2] + (nr ? bp[256 + dist] : 0.f); l.w = a[3] + (nr ? bp[384 + dist] : 0.f); }
            pl[m] = l; }
        __syncthreads();
        softmax4(pl, 512, lane);
        __syncthreads();
        float ow[4][2] = {};
        { const int m0 = t >= 511 ? 0 : 511 - t;
          const unsigned* vb = (const unsigned*)(VW + ((size_t)b * SEQ) * 512 + g * 128) + lane;
#pragma unroll 8
          for (int m = m0; m < 512; ++m) pv_acc(pl[m], vb[(size_t)(t - 511 + m) * 256], ow); }
        if (live) {
            const float* gt = GT + row * 48 + g * 12;
#pragma unroll
            for (int h = 0; h < 4; ++h) { const float gc = gate_of(gt + h * 3 + 0), gs = gate_of(gt + h * 3 + 1), gwn = gate_of(gt + h * 3 + 2);
                const unsigned zv = ((const unsigned*)(Z1 + row * DM + (g * 4 + h) * 128))[lane];
                const float z0 = __uint_as_float(zv << 16), z1 = __uint_as_float(zv & 0xffff0000u);
                const float r0 = (gc * oc[h][0] + gs * os[h][0] + gwn * ow[h][0]) * z0, r1 = (gc * oc[h][1] + gs * os[h][1] + gwn * ow[h][1]) * z1;
                ((unsigned*)(O1 + row * DM + (g * 4 + h) * 128))[lane] = pk2(r0, r1); }
        }
    }
}

__device__ __forceinline__ void compress_mfma(const Params& p, unsigned char* lds_g) {
    LAS unsigned char* L = (LAS unsigned char*)lds_g;
    const int tid = threadIdx.x, lane = tid & 63, wave = __builtin_amdgcn_readfirstlane(tid >> 6), r32 = lane & 31, hi = lane >> 5;
    const bf16_t* KV = (const bf16_t*)(p.ws + WS_E);
    const float* misc = (const float*)(p.ws + WS_MISC);
    constexpr int HRS = 272;
    const int nt = wave & 3, kh = wave >> 2;
    for (int unit = blockIdx.x; unit < 2 * 16 * 8; unit += gridDim.x) {
        const int which = unit >> 7, bg = (unit >> 3) & 15, i0 = (unit & 7) * 32, b = bg >> 2, g = bg & 3;
        const bf16_t* src = KV + (size_t)which * ((size_t)T * 512) + ((size_t)b * SEQ) * 512 + g * 128;
        const bf16_t* w1t = (const bf16_t*)(p.ws + (which ? WS_W1V : WS_W1K)); const bf16_t* w2t = (const bf16_t*)(p.ws + (which ? WS_W2V : WS_W2K));
        bf16_t* dst = (bf16_t*)(p.ws + (which ? WS_VCMP : WS_KCMP)) + (size_t)bg * NCMPP * 128;
        f32x16 acc;
#pragma unroll
        for (int i = 0; i < 16; ++i) acc[i] = 0.f;
        __syncthreads();
        { u32x4 tv[17];
#pragma unroll
            for (int q = 0; q < 17; ++q) { int pc = tid + 512 * q; pc = pc < 528 * 16 ? pc : 528 * 16 - 1; const int tk = pc >> 4, sl = pc & 15; int ta = 16 * i0 + tk; ta = ta < SEQ ? ta : SEQ - 1;
                tv[q] = *(const u32x4*)(src + (size_t)ta * 512 + sl * 8); }
#pragma unroll
            for (int q = 0; q < 17; ++q) { const int pc = tid + 512 * q; const int tk = pc >> 4, sl = pc & 15;
                if (pc < 528 * 16) *(LAS u32x4*)(L + tk * 256 + ((sl ^ ((tk >> 4) & 15)) << 4)) = tv[q]; } }
        __syncthreads();
        const bf16_t* bfrag = w1t + ((size_t)(nt * 256) * 64 + lane) * 8;
        for (int sb_ = 128 * kh; sb_ < 128 * kh + 128; sb_ += 16) {
            bf16x8 fa[16], fb[16];
#pragma unroll
            for (int u = 0; u < 16; ++u) { const int s2 = sb_ + u; fb[u] = *(const bf16x8*)(bfrag + (size_t)s2 * 512); }
#pragma unroll
            for (int u = 0; u < 16; ++u) { const int s2 = sb_ + u, j = s2 >> 3, tk = 16 * r32 + j, sl = (s2 & 7) * 2 + hi; fa[u] = *(const LAS bf16x8*)(L + tk * 256 + ((sl ^ ((tk >> 4) & 15)) << 4)); }
            __builtin_amdgcn_sched_barrier(0);
#pragma unroll
            for (int u = 0; u < 16; ++u) acc = __builtin_amdgcn_mfma_f32_32x32x16_bf16(fa[u], fb[u], acc, 0, 0, 0);
            __builtin_amdgcn_sched_barrier(0);
        }
        float cv = 0.f;
        if (kh == 0) { const float* b1 = which ? p.pv_b1 : p.pk_b1; const int n = 32 * nt + r32;
            cv = b1[n];
#pragma unroll
            for (int sl = 0; sl < 8; ++sl) cv += misc[MISC_CVP / 4 + (which * 8 + sl) * 128 + n]; }
        __syncthreads();
        if (kh == 1) {
#pragma unroll
            for (int q = 0; q < 16; ++q) *(LAS float*)(L + 16384 + ((nt * 16 + q) * 64 + lane) * 4) = acc[q];
        }
        __syncthreads();
        if (kh == 0) {
            const int n = 32 * nt + r32;
#pragma unroll
            for (int q = 0; q < 16; ++q) { const float h = acc[q] + *(const LAS float*)(L + 16384 + ((nt * 16 + q) * 64 + lane) * 4) + cv;
                *(LAS bf16_t*)(L + crow(q, hi) * HRS + n * 2) = (bf16_t)f2bf(gelu_tanh(h)); }
        }
        __syncthreads();
        if (kh == 0) {
            f32x16 o;
#pragma unroll
            for (int i = 0; i < 16; ++i) o[i] = 0.f;
            bf16x8 w2f[8], ha[8];
#pragma unroll
            for (int s2 = 0; s2 < 8; ++s2) { w2f[s2] = *(const bf16x8*)(w2t + (size_t)(32 * nt + r32) * 128 + 16 * s2 + 8 * hi); ha[s2] = *(const LAS bf16x8*)(L + r32 * HRS + 32 * s2 + 16 * hi); }
            __builtin_amdgcn_sched_barrier(0);
#pragma unroll
            for (int s2 = 0; s2 < 8; ++s2) o = __builtin_amdgcn_mfma_f32_32x32x16_bf16(ha[s2], w2f[s2], o, 0, 0, 0);
#pragma unroll
            for (int q = 0; q < 16; ++q) { const int i = i0 + crow(q, hi); dst[(size_t)i * 128 + 32 * nt + r32] = (bf16_t)(i < NCMP ? f2bf(o[q]) : 0u); }
        }
    }
}

namespace at {
constexpr int SHM = 16384, BUF = 38912;
constexpr int L_V = 0, L_K = 16384, L_WS = 32768, L_BIAS = 34816, L_V1 = 38912, L_K1 = 55296, L_SEL = 71680, L_Q = 72192, L_IMP = L_Q + 65536, L_GT = L_IMP + 16384, L_END = L_GT + 8 * 64 * 4 * 4;
constexpr float LOG2E = 1.4426950408889634f;
constexpr float SM_THR = 8.f;
#define KSWZ(row, colB) ((row) * 256 + ((colB) ^ (((row) & 15) << 4)))
#define SBAR() __builtin_amdgcn_sched_barrier(0)
__device__ __forceinline__ int v_rd_base(int lane) { return ((lane & 3) << 3) | (((lane >> 2) & 3) << 6) | (((lane >> 4) & 1) << 5) | (((lane >> 5) & 1) << 8); }
constexpr int v_rd_off(int d0, int ks, int half) { return d0 * 512 + ks * 4096 + half * 2048; }
typedef short s16x4 __attribute__((ext_vector_type(4)));
__device__ __forceinline__ unsigned cvtpk(float lo, float hi) { unsigned r; asm volatile("v_cvt_pk_bf16_f32 %0, %1, %2" : "=v"(r) : "v"(lo), "v"(hi)); return r; }
struct DmaMap { int kr0, kc0, kr1, kc1, vr0, vc0, vr1, vc1; };
__device__ __forceinline__ DmaMap dma_map(int tid) {
    DmaMap m;
    { const int P = tid * 16, row = P >> 8; m.kr0 = row; m.kc0 = ((((P & 255) >> 4) ^ (row & 15))) * 8; m.kr1 = row + 32; m.kc1 = m.kc0; }
    { const int P = tid * 16, st = P >> 9, w = (P & 511) >> 1, kk = (st >> 2) * 8 + (w >> 5); m.vr0 = (kk & ~0xC) | ((kk & 4) << 1) | ((kk & 8) >> 1); m.vc0 = (st & 3) * 32 + (w & 31); }
    { const int P = tid * 16 + 8192, st = P >> 9, w = (P & 511) >> 1, kk = (st >> 2) * 8 + (w >> 5); m.vr1 = (kk & ~0xC) | ((kk & 4) << 1) | ((kk & 8) >> 1); m.vc1 = (st & 3) * 32 + (w & 31); }
    return m;
}
template <int VAR = 0>
__device__ __forceinline__ void dma_k(LAS unsigned char* Lb, const DmaMap& m, const bf16_t* Kp, int ld, int wave) {
    if constexpr ((VAR & 16) != 0) return;
    int o0 = m.kr0 * ld + m.kc0, o1 = m.kr1 * ld + m.kc1; asm volatile("" : "+v"(o0), "+v"(o1));
    __builtin_amdgcn_global_load_lds((const unsigned*)(Kp + o0), (LAS unsigned*)(Lb + L_K + wave * 1024), 16, 0, 0);
    __builtin_amdgcn_global_load_lds((const unsigned*)(Kp + o1), (LAS unsigned*)(Lb + L_K + wave * 1024 + 8192), 16, 0, 0);
}
template <int VAR = 0>
__device__ __forceinline__ void dma_v(LAS unsigned char* Lb, const DmaMap& m, const bf16_t* Vp, int ld, int wave) {
    if constexpr ((VAR & 16) != 0) return;
    int o0 = m.vr0 * ld + m.vc0, o1 = m.vr1 * ld + m.vc1; asm volatile("" : "+v"(o0), "+v"(o1));
    __builtin_amdgcn_global_load_lds((const unsigned*)(Vp + o0), (LAS unsigned*)(Lb + L_V + wave * 1024), 16, 0, 0);
    __builtin_amdgcn_global_load_lds((const unsigned*)(Vp + o1), (LAS unsigned*)(Lb + L_V + wave * 1024 + 8192), 16, 0, 0);
}
#define TILE_SYNC() do { asm volatile("s_waitcnt vmcnt(0) lgkmcnt(0)" ::: "memory"); if constexpr ((VAR & 8) == 0) __builtin_amdgcn_s_barrier(); asm volatile("" ::: "memory"); } while (0)
__device__ __forceinline__ int next_bit(unsigned long long m, int from) {
    const unsigned long long m2 = from >= 64 ? 0ull : (m & (~0ull << from));
    return m2 ? (int)__builtin_ctzll(m2) : -1;
}
template <int VAR, bool NEAR>
__device__ __forceinline__ void qkt_(f32x16& p0, f32x16& p1, int kaddr, int r32, int hi, const bf16x8* qr, const LAS float* bp) {
    if constexpr (NEAR) {
#pragma unroll
        for (int r = 0; r < 16; ++r) { const int c = (r & 3) + 8 * (r >> 2); p0[r] = bp[63 - c]; p1[r] = bp[31 - c]; }
    }
    int ka[4];
#pragma unroll
    for (int dd = 0; dd < 4; ++dd) ka[dd] = kaddr + KSWZ(r32, (dd * 16 + hi * 8) * 2);
    const int h1 = 128 - ((r32 & 8) << 5);
    bf16x8 kA[2][2], kB[2][2];
#define KRD(dst, a, off) asm volatile("ds_read_b128 %0, %1 offset:%2" : "=&v"(dst) : "v"(a), "i"(off) : "memory")
#define LOADG(G, K_) do { _Pragma("unroll") for (int e = 0; e < 2; ++e) { const int d0 = 2 * (G) + e; KRD(K_[e][0], ka[d0 & 3], 0); KRD(K_[e][1], ka[d0 & 3], 8192); } } while (0)
#define MMA1(G, e, K_, C0, C1) do { p0 = __builtin_amdgcn_mfma_f32_32x32x16_bf16(K_[e][0], qr[2 * (G) + e], C0, 0, 0, 0); p1 = __builtin_amdgcn_mfma_f32_32x32x16_bf16(K_[e][1], qr[2 * (G) + e], C1, 0, 0, 0); } while (0)
#define LGK(N) asm volatile("s_waitcnt lgkmcnt(" #N ")" ::: "memory")
    const f32x16 z16 = {0.f, 0.f, 0.f, 0.f, 0.f, 0.f, 0.f, 0.f, 0.f, 0.f, 0.f, 0.f, 0.f, 0.f, 0.f, 0.f};
    LOADG(0, kA); LOADG(1, kB);
#pragma unroll
    for (int dd = 0; dd < 4; ++dd) ka[dd] += h1;
    LGK(4); SBAR();
    if constexpr (NEAR) MMA1(0, 0, kA, p0, p1); else MMA1(0, 0, kA, z16, z16);
    MMA1(0, 1, kA, p0, p1); SBAR();
    LOADG(2, kA); LGK(4); SBAR();
    MMA1(1, 0, kB, p0, p1); MMA1(1, 1, kB, p0, p1); SBAR();
    LOADG(3, kB); LGK(4); SBAR();
    MMA1(2, 0, kA, p0, p1); MMA1(2, 1, kA, p0, p1); SBAR();
    LGK(0); SBAR();
    MMA1(3, 0, kB, p0, p1); MMA1(3, 1, kB, p0, p1);
#undef LGK
#undef MMA1
#undef LOADG
#undef KRD
}
template <int VAR = 0>
__device__ __forceinline__ void qkt(f32x16& p0, f32x16& p1, const LAS unsigned char* Kl, int r32, int hi, const bf16x8* qr, bool near = false, const LAS float* bp = nullptr) {
    const int kaddr = (int)(size_t)Kl;
    if (near) qkt_<VAR, true>(p0, p1, kaddr, r32, hi, qr, bp); else qkt_<VAR, false>(p0, p1, kaddr, r32, hi, qr, bp);
}
__device__ __forceinline__ void pv_tile(f32x16* o, int vb0, bf16x8 pa0, bf16x8 pa1, bf16x8 pa2, bf16x8 pa3) {
#define TRRD(dst, off) asm volatile("ds_read_b64_tr_b16 %0, %1 offset:%2" : "=&v"(dst) : "v"(vb0), "i"(off) : "memory")
#define PV_RD(d0, X) do { constexpr int b_ = v_rd_off(d0, 0, 0); \
        TRRD(X[0], b_); TRRD(X[1], b_ + 2048); TRRD(X[2], b_ + 4096); TRRD(X[3], b_ + 6144); TRRD(X[4], b_ + 8192); TRRD(X[5], b_ + 10240); TRRD(X[6], b_ + 12288); TRRD(X[7], b_ + 14336); } while (0)
#define PV_MM(d0, X) do { \
        o[d0] = __builtin_amdgcn_mfma_f32_32x32x16_bf16(pa0, (bf16x8){X[0][0], X[0][1], X[0][2], X[0][3], X[1][0], X[1][1], X[1][2], X[1][3]}, o[d0], 0, 0, 0); \
        o[d0] = __builtin_amdgcn_mfma_f32_32x32x16_bf16(pa1, (bf16x8){X[2][0], X[2][1], X[2][2], X[2][3], X[3][0], X[3][1], X[3][2], X[3][3]}, o[d0], 0, 0, 0); \
        o[d0] = __builtin_amdgcn_mfma_f32_32x32x16_bf16(pa2, (bf16x8){X[4][0], X[4][1], X[4][2], X[4][3], X[5][0], X[5][1], X[5][2], X[5][3]}, o[d0], 0, 0, 0); \
        o[d0] = __builtin_amdgcn_mfma_f32_32x32x16_bf16(pa3, (bf16x8){X[6][0], X[6][1], X[6][2], X[6][3], X[7][0], X[7][1], X[7][2], X[7][3]}, o[d0], 0, 0, 0); } while (0)
#define LGK(N) asm volatile("s_waitcnt lgkmcnt(" #N ")" ::: "memory")
    s16x4 xa[8], xb[8];
    PV_RD(0, xa); PV_RD(1, xb);
    LGK(8); SBAR(); PV_MM(0, xa); SBAR(); PV_RD(2, xa);
    LGK(8); SBAR(); PV_MM(1, xb); SBAR(); PV_RD(3, xb);
    LGK(8); SBAR(); PV_MM(2, xa); SBAR();
    LGK(0); SBAR(); PV_MM(3, xb);
#undef LGK
#undef PV_MM
#undef PV_RD
#undef TRRD
}
__device__ __forceinline__ void bias_mask(f32x16& p0, f32x16& p1, int dq, unsigned W, bool needmask, int hi) {
    const float NEG = -__builtin_inff();
    const int dq4 = dq - 4 * hi;
    if (needmask) {
#pragma unroll
        for (int r = 0; r < 16; ++r) { const int c = (r & 3) + 8 * (r >> 2);
            if ((unsigned)(dq4 - c) >= W) p0[r] = NEG;
            if ((unsigned)(dq4 - c - 32) >= W) p1[r] = NEG; }
    }
}
__device__ __forceinline__ void bias_mask_cmp(f32x16& p0, f32x16& p1, int dq, int dd, const LAS float* blx, int hi, bool needbias, bool needmask) {
    const float NEG = -__builtin_inff();
    const int dq4 = dq - 4 * hi, dd4 = dd - 64 * hi;
    if (needbias) {
        float bv[16];
#pragma unroll
        for (int r = 0; r < 16; ++r) { const int c = (r & 3) + 8 * (r >> 2); bv[r] = blx[64 + ((dd4 - 16 * c) & 127)]; }
        SBAR();
#pragma unroll
        for (int r = 0; r < 16; ++r) { const int c = (r & 3) + 8 * (r >> 2); p0[r] += ((unsigned)(dd4 - 16 * c) < 128u) ? bv[r] : 0.f; }
        SBAR();
#pragma unroll
        for (int r = 0; r < 16; ++r) { const int c = (r & 3) + 8 * (r >> 2); bv[r] = blx[64 + ((dd4 - 16 * c - 512) & 127)]; }
        SBAR();
#pragma unroll
        for (int r = 0; r < 16; ++r) { const int c = (r & 3) + 8 * (r >> 2); p1[r] += ((unsigned)(dd4 - 16 * c - 512) < 128u) ? bv[r] : 0.f; }
    }
    if (needmask) {
#pragma unroll
        for (int r = 0; r < 16; ++r) { const int c = (r & 3) + 8 * (r >> 2);
            if (c > dq4) p0[r] = NEG;
            if (c + 32 > dq4) p1[r] = NEG; }
    }
}
template <int CTRL> __device__ __forceinline__ float quad_perm(float v) { return __uint_as_float((unsigned)__builtin_amdgcn_update_dpp(0, (int)__float_as_uint(v), CTRL, 0xF, 0xF, true)); }
__device__ __forceinline__ float rowmax32(const f32x16& p0, const f32x16& p1) {
    float pmax = p0[0];
#pragma unroll
    for (int r = 1; r < 16; ++r) pmax = fmaxf(pmax, p0[r]);
#pragma unroll
    for (int r = 0; r < 16; ++r) pmax = fmaxf(pmax, p1[r]);
    auto rr = __builtin_amdgcn_permlane32_swap(__float_as_uint(pmax), __float_as_uint(pmax), false, false);
    return fmaxf(__uint_as_float(rr[0]), __uint_as_float(rr[1]));
}
__device__ __forceinline__ float halfswap_add(float ps) {
    auto rr = __builtin_amdgcn_permlane32_swap(__float_as_uint(ps), __float_as_uint(ps), false, false);
    return __uint_as_float(rr[0]) + __uint_as_float(rr[1]);
}
#define EXP_PK4(P, B_, OUT) do { _Pragma("unroll") for (int e_ = 0; e_ < 8; ++e_) { P[B_ + e_] = (VAR & 1) ? fmaf(P[B_ + e_], LOG2E, mnL) : __builtin_amdgcn_exp2f(fmaf(P[B_ + e_], LOG2E, mnL)); ps += P[B_ + e_]; } \
        unsigned a0 = cvtpk(P[B_ + 0], P[B_ + 1]), a1 = cvtpk(P[B_ + 2], P[B_ + 3]); \
        unsigned b0 = cvtpk(P[B_ + 4], P[B_ + 5]), b1 = cvtpk(P[B_ + 6], P[B_ + 7]); \
        auto r0 = __builtin_amdgcn_permlane32_swap(a0, b0, false, false); auto r1 = __builtin_amdgcn_permlane32_swap(a1, b1, false, false); \
        u32x4 w = {r0[0], r1[0], r0[1], r1[1]}; OUT = *reinterpret_cast<bf16x8*>(&w); } while (0)
template <int VAR = 0>
__device__ __forceinline__ void sm_pv(f32x16& p0, f32x16& p1, float& m_reg, float& l_reg, f32x16* o, int vb, LAS float* al, int r32, int hi, bool rowsel = true) {
    const float pmax = rowsel ? rowmax32(p0, p1) : -__builtin_inff();
    float alpha = 1.f;
    if (!__all(pmax - m_reg <= SM_THR)) {
        const float mn = fmaxf(m_reg, pmax);
        alpha = __builtin_amdgcn_exp2f((m_reg - mn) * LOG2E); m_reg = mn;
        if (hi == 0) al[r32] = alpha; asm volatile("s_waitcnt lgkmcnt(0)" ::: "memory");
        float av[16];
#pragma unroll
        for (int r = 0; r < 16; ++r) av[r] = al[crow(r, hi)];
        SBAR();
#pragma unroll
        for (int d_ = 0; d_ < 4; ++d_)
#pragma unroll
            for (int r = 0; r < 16; ++r) o[d_][r] *= av[r]; }
    const float mnL = rowsel ? -m_reg * LOG2E : -__builtin_inff();
    float ps = 0.f;
    bf16x8 pa0, pa1, pa2, pa3;
    EXP_PK4(p0, 0, pa0); EXP_PK4(p0, 8, pa1); EXP_PK4(p1, 0, pa2); EXP_PK4(p1, 8, pa3);
    l_reg = l_reg * alpha + halfswap_add(ps);
    SBAR();
    if constexpr ((VAR & 2) == 0) pv_tile(o, vb, pa0, pa1, pa2, pa3);
    else { asm volatile("" :: "v"(pa0), "v"(pa1), "v"(pa2), "v"(pa3)); }
}
}

template <int VAR = 0>
__device__ __forceinline__ void nsa_fused(const Params& p, unsigned char* lds_g, bf16_t* O1, const int tidv) {
    using namespace at;
    LAS unsigned char* L = (LAS unsigned char*)lds_g;
    const int tid = tidv, lane = tid & 63, wave = __builtin_amdgcn_readfirstlane(tid >> 6), r32 = lane & 31, hi = lane >> 5;
    const bf16_t* Q1 = (const bf16_t*)(p.ws + WS_D); const bf16_t* KV = (const bf16_t*)(p.ws + WS_E); const bf16_t* Z1 = (const bf16_t*)(p.ws + WS_G);
    const float* GT = (const float*)(p.ws + WS_GATES); const bf16_t* KC = (const bf16_t*)(p.ws + WS_KCMP); const bf16_t* VC = (const bf16_t*)(p.ws + WS_VCMP);
    const float* biasp = (const float*)(p.ws + WS_MISC + MISC_BIASP);
    const size_t TS = (size_t)T * 512;
    LAS float* wsf = (LAS float*)(L + L_WS) + wave * 64;
    LAS float* blw = (LAS float*)(L + L_BIAS);
    LAS float* impS = (LAS float*)(L + L_IMP);
    LAS unsigned* totL = (LAS unsigned*)(L + L_Q) + wave * 2048 + lane;
    LAS unsigned long long* selS = (LAS unsigned long long*)(L + L_SEL);
    const int vb0 = (int)(size_t)(L + L_V) + v_rd_base(lane);
    const int hh = r32 & 3, tl = r32 >> 2;
    const LAS float* bl = blw + hh * 256;
    const DmaMap dm = dma_map(tid);
    const int G = gridDim.x;
    if (wave >= 4) __builtin_amdgcn_s_setprio(1);
    for (int it = blockIdx.x; it < 16 * 32; it += G) {
        int bg, y;
        if (G == 256) { const int xcd = it & 7, q = it >> 3; bg = (xcd * 2 + (q / 32)) & 15; y = (q / 32) ? 31 - (q % 32) : (q % 32); } else { bg = it / 32; y = it % 32; }
        const int b = bg >> 2, g = bg & 3;
        __syncthreads();
        for (int e = tid; e < 1024; e += 512) { const int d_ = (e & 255) - 64; blw[e] = (d_ >= 0 && d_ < 128) ? biasp[(g * 4 + (e >> 8)) * 128 + d_] : 0.f; }
        for (int pass = 0; pass < 2; ++pass) {
            const int x = pass ? 63 - y : y;
            const int t0 = 64 * x, t = t0 + 8 * wave + tl;
            const size_t row = (size_t)b * SEQ + t;
            const bf16_t* Kb = KV + ((size_t)b * SEQ) * 512 + g * 128;
            const bf16_t* KCb = KC + (size_t)bg * NCMPP * 128; const bf16_t* VCb = VC + (size_t)bg * NCMPP * 128;
            __syncthreads();
            dma_k<VAR>(L, dm, KCb, 128, wave);
            bf16x8 qr[8];
            int qlo_ = lane; asm volatile("" : "+v"(qlo_)); qlo_ = (qlo_ & 3) * 128 + (qlo_ >> 5) * 8;
#pragma unroll
            for (int d0 = 0; d0 < 8; ++d0) qr[d0] = *(const bf16x8*)(Q1 + row * DM + (g * 4) * 128 + qlo_ + d0 * 16);
            LAS float* gtS = (LAS float*)(L + L_GT) + (wave * 64 + lane) * 4;
            { const float* gp_ = GT + row * 48 + (g * 4 + hh) * 3; float gq_[3][4];
#pragma unroll
              for (int c_ = 0; c_ < 3; ++c_)
#pragma unroll
                  for (int k_ = 0; k_ < 4; ++k_) gq_[c_][k_] = gp_[(size_t)k_ * T * 48 + c_];
#pragma unroll
              for (int c_ = 0; c_ < 3; ++c_) gtS[c_] = sigmoidf_((gq_[c_][0] + gq_[c_][1]) + (gq_[c_][2] + gq_[c_][3])); }
            __builtin_amdgcn_s_waitcnt(0x0F70);
            f32x16 o[4]; f32x16 p0, p1; float m_reg, l_reg;
#define BRANCH_INIT() do { m_reg = -1e30f; l_reg = 0.f; _Pragma("unroll") for (int d_ = 0; d_ < 4; ++d_) _Pragma("unroll") for (int r = 0; r < 16; ++r) o[d_][r] = 0.f; } while (0)
#define BRANCH_END(cidx, FIRST) do { \
            if (hi == 0) { wsf[r32] = l_reg > 0.f ? gtS[cidx] / l_reg : 0.f; } \
            asm volatile("s_waitcnt lgkmcnt(0)" ::: "memory"); \
            _Pragma("unroll") for (int r = 0; r < 8; ++r) { const float sc0_ = wsf[crow(2 * r, hi)], sc1_ = wsf[crow(2 * r + 1, hi)]; \
                _Pragma("unroll") for (int d_ = 0; d_ < 4; ++d_) { const unsigned tp_ = (FIRST) ? 0u : totL[(d_ * 8 + r) * 64]; \
                    totL[(d_ * 8 + r) * 64] = cvtpk(__uint_as_float(tp_ << 16) + o[d_][2 * r] * sc0_, __uint_as_float(tp_ & 0xffff0000u) + o[d_][2 * r + 1] * sc1_); } } \
            asm volatile("s_waitcnt lgkmcnt(0)" ::: "memory"); } while (0)
            const int ncmp_t = (VAR & 128) ? 0 : (4 * x + 2) / 64 + 1;
            const int ic = (t - 31) >> 4;
            int buf = 0;
            BRANCH_INIT();
            TILE_SYNC();
            for (int tt = 0; tt < ncmp_t; ++tt) {
                LAS unsigned char* Lb = L + buf * BUF; LAS unsigned char* Ln = L + (buf ^ 1) * BUF;
                if (tt + 1 < ncmp_t) dma_k<VAR>(Ln, dm, KCb + (size_t)(tt + 1) * 64 * 128, 128, wave);
                else { dma_k<VAR>(Ln, dm, KCb, 128, wave); dma_v<VAR>(Ln, dm, VCb, 128, wave); }
                qkt<VAR>(p0, p1, Lb + L_K, r32, hi, qr);
                bias_mask_cmp(p0, p1, ic - 64 * tt, t - 31 - 1024 * tt, bl, hi, (t0 + 8 * wave - 31) - 16 * (64 * tt + 63) < 128, 64 * tt + 63 > ((t0 + 8 * wave - 31) >> 4));
                const float pmax = rowmax32(p0, p1); const float mn = fmaxf(m_reg, pmax); const float alpha = __builtin_amdgcn_exp2f((m_reg - mn) * LOG2E); m_reg = mn;
                const float mnL = -mn * LOG2E; float ps = 0.f;
#pragma unroll
                for (int r = 0; r < 16; ++r) { ps += __builtin_amdgcn_exp2f(fmaf(p0[r], LOG2E, mnL)); ps += __builtin_amdgcn_exp2f(fmaf(p1[r], LOG2E, mnL)); }
                l_reg = l_reg * alpha + halfswap_add(ps);
                TILE_SYNC(); buf ^= 1;
            }
            const float m_c = m_reg, l_c = l_reg, il_c = l_c > 0.f ? 1.f / l_c : 0.f; float imp_carry = 0.f;
            for (int tt = 0; tt < ncmp_t; ++tt) {
                LAS unsigned char* Lb = L + buf * BUF; LAS unsigned char* Ln = L + (buf ^ 1) * BUF;
                if (tt + 1 < ncmp_t) { dma_k<VAR>(Ln, dm, KCb + (size_t)(tt + 1) * 64 * 128, 128, wave); dma_v<VAR>(Ln, dm, VCb + (size_t)(tt + 1) * 64 * 128, 128, wave); }
                qkt<VAR>(p0, p1, Lb + L_K, r32, hi, qr);
                bias_mask_cmp(p0, p1, ic - 64 * tt, t - 31 - 1024 * tt, bl, hi, (t0 + 8 * wave - 31) - 16 * (64 * tt + 63) < 128, 64 * tt + 63 > ((t0 + 8 * wave - 31) >> 4));
                const float mnL = -m_c * LOG2E;
#pragma unroll
                for (int r = 0; r < 16; ++r) { p0[r] = __builtin_amdgcn_exp2f(fmaf(p0[r], LOG2E, mnL)); p1[r] = __builtin_amdgcn_exp2f(fmaf(p1[r], LOG2E, mnL)); }
                { float qa[8], xo[8];
#pragma unroll
                  for (int gq = 0; gq < 8; ++gq) { const int rb = (gq & 3) * 4;
                      float qs_ = gq < 4 ? (p0[rb] + p0[rb + 1]) + (p0[rb + 2] + p0[rb + 3]) : (p1[rb] + p1[rb + 1]) + (p1[rb + 2] + p1[rb + 3]);
                      float ls_ = gq < 4 ? p0[rb + 3] : p1[rb + 3];
                      qs_ *= il_c; ls_ *= il_c;
                      qs_ += quad_perm<0xB1>(qs_); qs_ += quad_perm<0x4E>(qs_); ls_ += quad_perm<0xB1>(ls_); ls_ += quad_perm<0x4E>(ls_);
                      qa[gq] = qs_; { auto rr_ = __builtin_amdgcn_permlane32_swap(__float_as_uint(ls_), __float_as_uint(ls_), false, false); xo[gq] = __uint_as_float(hi ? rr_[0] : rr_[1]); } }
#pragma unroll
                  for (int gq = 0; gq < 8; ++gq) { const float prev = hi ? xo[gq] : (gq ? xo[gq - 1] : imp_carry);
                      if (hh == 0) impS[(8 * wave + tl) * 64 + 16 * tt + 2 * gq + hi] = qa[gq] + prev; }
                  imp_carry = xo[7]; }
                bf16x8 pa0, pa1, pa2, pa3;
#define PK4(P, B_, OUT) do { unsigned a0 = cvtpk(P[B_ + 0], P[B_ + 1]), a1 = cvtpk(P[B_ + 2], P[B_ + 3]); \
        unsigned b0 = cvtpk(P[B_ + 4], P[B_ + 5]), b1 = cvtpk(P[B_ + 6], P[B_ + 7]); \
        auto r0 = __builtin_amdgcn_permlane32_swap(a0, b0, false, false); auto r1 = __builtin_amdgcn_permlane32_swap(a1, b1, false, false); \
        u32x4 w = {r0[0], r1[0], r0[1], r1[1]}; OUT = *reinterpret_cast<bf16x8*>(&w); } while (0)
                PK4(p0, 0, pa0); PK4(p0, 8, pa1); PK4(p1, 0, pa2); PK4(p1, 8, pa3); SBAR();
#undef PK4
                pv_tile(o, vb0 + buf * BUF, pa0, pa1, pa2, pa3);
                TILE_SYNC(); buf ^= 1;
            }
            l_reg = l_c;
            { LAS unsigned char* Lb = L + buf * BUF; dma_k<VAR>(Lb, dm, Kb + 2 * TS, 512, wave); dma_v<VAR>(Lb, dm, Kb + 3 * TS, 512, wave); }
            if (x < 16) { if (lane == 0) { for (int i = 0; i < 8; ++i) selS[8 * wave + i] = ~0ull; } }
            else {
                int ia = (8 * wave * 64 + lane) * 4; asm volatile("" : "+v"(ia));
                const LAS float* ip = (const LAS float*)((LAS unsigned char*)impS + ia);
                const int j = lane;
                const bool forced = (j == 0) || (j == x) || (j == x - 1), visible = j <= x;
                unsigned key[8], thr[8];
#pragma unroll
                for (int i = 0; i < 8; ++i) { const float imp = ip[i * 64];
                    key[i] = forced ? 0xffffffffu : (visible ? __float_as_uint(imp) + 1u : 0u); thr[i] = 0u; }
#pragma unroll 1
                for (int bit = 31; bit >= 0; --bit) {
#pragma unroll
                    for (int i = 0; i < 8; ++i) { const unsigned c = thr[i] | (1u << bit); if (__popcll(__ballot(key[i] >= c)) >= 16) thr[i] = c; } }
#pragma unroll
                for (int i = 0; i < 8; ++i) {
                    const unsigned long long gt = __ballot(key[i] > thr[i]), eq = __ballot(key[i] == thr[i]);
                    const int need = 16 - __popcll(gt);
                    const bool pick = (key[i] > thr[i]) || ((key[i] == thr[i]) && (__popcll(eq & ((1ull << j) - 1ull)) < need));
                    const unsigned long long mk = __ballot(pick);
                    if (lane == 0) selS[8 * wave + i] = mk; }
            }
            TILE_SYNC();
            unsigned long long um = 0ull, wm = 0ull;
            for (int i = 0; i < 64; ++i) { const unsigned long long v = selS[i]; um |= v; if ((i >> 3) == wave) wm |= v; }
            const unsigned long long mym = selS[8 * wave + tl];
            um &= (x >= 63) ? ~0ull : ((1ull << (x + 1)) - 1ull);
            um = ((unsigned long long)__builtin_amdgcn_readfirstlane((unsigned)(um >> 32)) << 32) | (unsigned)__builtin_amdgcn_readfirstlane((unsigned)um);
            wm = ((unsigned long long)__builtin_amdgcn_readfirstlane((unsigned)(wm >> 32)) << 32) | (unsigned)__builtin_amdgcn_readfirstlane((unsigned)wm);
            int j = 0;
            if constexpr ((VAR & 256) != 0) j = -1;
            BRANCH_END(0, true);
            BRANCH_INIT();
            TILE_SYNC();
            while (j >= 0) {
                LAS unsigned char* Lb = L + buf * BUF; LAS unsigned char* Ln = L + (buf ^ 1) * BUF;
                const int jn = next_bit(um, j + 1);
                if (jn >= 0) { dma_k<VAR>(Ln, dm, Kb + 2 * TS + (size_t)(64 * jn) * 512, 512, wave); dma_v<VAR>(Ln, dm, Kb + 3 * TS + (size_t)(64 * jn) * 512, 512, wave); }
                else { const int jl = (x >= 8 ? x - 8 : 0); dma_k<VAR>(Ln, dm, Kb + 4 * TS + (size_t)(64 * jl) * 512, 512, wave); dma_v<VAR>(Ln, dm, Kb + 5 * TS + (size_t)(64 * jl) * 512, 512, wave); }
                if ((wm >> j) & 1ull) {
                    qkt<VAR>(p0, p1, Lb + L_K, r32, hi, qr, j + 2 >= x, bl + (t - 64 * j - 4 * hi + 1));
                    bias_mask(p0, p1, t - 64 * j, 0x7fffffffu, j == x, hi);
                    sm_pv<VAR>(p0, p1, m_reg, l_reg, o, vb0 + buf * BUF, wsf, r32, hi, (mym >> j) & 1ull); }
                TILE_SYNC(); buf ^= 1;
                j = jn;
            }
            BRANCH_END(1, false);
            BRANCH_INIT();
            for (int jw = (x >= 8 ? x - 8 : 0); jw <= x && !(VAR & 512); ++jw) {
                LAS unsigned char* Lb = L + buf * BUF; LAS unsigned char* Ln = L + (buf ^ 1) * BUF;
                if (jw < x) { dma_k<VAR>(Ln, dm, Kb + 4 * TS + (size_t)(64 * (jw + 1)) * 512, 512, wave); dma_v<VAR>(Ln, dm, Kb + 5 * TS + (size_t)(64 * (jw + 1)) * 512, 512, wave); }
                qkt<VAR>(p0, p1, Lb + L_K, r32, hi, qr, jw + 2 >= x, bl + (t - 64 * jw - 4 * hi + 1));
                bias_mask(p0, p1, t - 64 * jw, 512u, jw == x || jw + 8 == x, hi);
                sm_pv<VAR>(p0, p1, m_reg, l_reg, o, vb0 + buf * BUF, wsf, r32, hi);
                TILE_SYNC(); buf ^= 1;
            }
            BRANCH_END(2, false);
            { LAS unsigned char* Tt = L + (wave < 4 ? 0 : BUF) + (wave & 3) * 8192;
              int te_ = t0 + 8 * wave; asm volatile("" : "+s"(te_));
              u32x4 zz[8], tt8[8]; size_t eo[8]; int ln_e = lane; asm volatile("" : "+v"(ln_e));
#pragma unroll
              for (int i = 0; i < 8; ++i) { const int idx = ln_e + 64 * i, rw = idx >> 4, ch = idx & 15;
                  eo[i] = ((size_t)b * SEQ + te_ + (rw >> 2)) * DM + (g * 4 + (rw & 3)) * 128 + 8 * ch;
                  zz[i] = *(const u32x4*)(Z1 + eo[i]); }
              __builtin_amdgcn_sched_barrier(0);
#pragma unroll
              for (int r = 0; r < 8; ++r)
#pragma unroll
                  for (int d_ = 0; d_ < 4; ++d_) { const unsigned tp_ = totL[(d_ * 8 + r) * 64];
                      *(LAS bf16_t*)(Tt + crow(2 * r, hi) * 256 + (32 * d_ + r32) * 2) = (bf16_t)(tp_ & 0xffffu); *(LAS bf16_t*)(Tt + crow(2 * r + 1, hi) * 256 + (32 * d_ + r32) * 2) = (bf16_t)(tp_ >> 16); }
              asm volatile("s_waitcnt lgkmcnt(0)" ::: "memory");
#pragma unroll
              for (int i = 0; i < 8; ++i) { const int idx = ln_e + 64 * i, rw = idx >> 4, ch = idx & 15; tt8[i] = *(const LAS u32x4*)(Tt + rw * 256 + ch * 16); }
              __builtin_amdgcn_sched_barrier(0);
#pragma unroll
              for (int i = 0; i < 8; ++i) { u32x4 w;
#define MULPK(T_, Z_) cvtpk(__uint_as_float((T_) << 16) * __uint_as_float((Z_) << 16), __uint_as_float((T_) & 0xffff0000u) * __uint_as_float((Z_) & 0xffff0000u))
                  w.x = MULPK(tt8[i].x, zz[i].x); w.y = MULPK(tt8[i].y, zz[i].y); w.z = MULPK(tt8[i].z, zz[i].z); w.w = MULPK(tt8[i].w, zz[i].w);
#undef MULPK
                  *(u32x4*)(O1 + eo[i]) = w; }
              asm volatile("s_waitcnt lgkmcnt(0)" ::: "memory"); }
#undef BRANCH_INIT
#undef BRANCH_END
        }
    }
    __builtin_amdgcn_s_setprio(0);
}

#define XB_TMO      128
#define XB_XCNT(j)  (256  + 64 * (j))
#define XB_XSUB(j)  (1280 + 64 * (j))
#define XB_XGEN(j)  (2304 + 64 * (j))
#define XB_TOP      3328
#define XB_TOPGEN   3392
#define XCD_BAR_WORDS 3456
#define XB_SPIN_CAP (1u << 22)
__device__ __forceinline__ unsigned xb_ld(unsigned* p)              { return __hip_atomic_load(p, __ATOMIC_RELAXED, __HIP_MEMORY_SCOPE_AGENT); }
__device__ __forceinline__ unsigned xb_add(unsigned* p, unsigned v) { return __hip_atomic_fetch_add(p, v, __ATOMIC_RELAXED, __HIP_MEMORY_SCOPE_AGENT); }
__device__ __forceinline__ unsigned xb_xcc_id() { return (unsigned)__builtin_amdgcn_s_getreg((3 << 11) | 20) & 0xFu; }
#define XB_SPIN(cond, bar) do { unsigned _sp = 0; while (cond) { __builtin_amdgcn_s_sleep(1); \
    if ((++_sp & 255u) == 0u) { if (xb_ld(&(bar)[XB_TMO])) break; if (_sp > XB_SPIN_CAP) { atomicAdd(&(bar)[XB_TMO], 1u); break; } } } } while (0)
struct XcdBarrier { unsigned* bar; unsigned x; volatile LAS unsigned* st; };
__device__ __forceinline__ XcdBarrier xcd_barrier_post(unsigned* bar, volatile LAS unsigned* st) {
    XcdBarrier b; b.bar = bar; b.x = xb_xcc_id(); b.st = st;
    if (threadIdx.x == 0) (void)xb_add(&bar[XB_XCNT(b.x)], 1u);
    return b;
}
__device__ __forceinline__ void xcd_barrier_complete(unsigned* bar, unsigned x, unsigned& nloc, unsigned& nx) {
    const unsigned G = gridDim.x * gridDim.y * gridDim.z;
    unsigned sum, cnt, mine, sp = 0u;
    for (;;) {
        sum = 0u; cnt = 0u; mine = 0u;
#pragma unroll
        for (unsigned j = 0; j < 16; ++j) { const unsigned c = xb_ld(&bar[XB_XCNT(j)]); sum += c; cnt += (c > 0u) ? 1u : 0u; mine = (j == x) ? c : mine; }
        if (sum == G) break;
        __builtin_amdgcn_s_sleep(1);
        if ((++sp & 255u) == 0u) { if (xb_ld(&bar[XB_TMO])) break; if (sp > XB_SPIN_CAP) { atomicAdd(&bar[XB_TMO], 1u); break; } }
    }
    nloc = mine > 0u ? mine : 1u; nx = cnt > 0u ? cnt : 1u;
}
__device__ __forceinline__ void xcd_barrier(const XcdBarrier& b, const int tidv) {
    asm volatile("s_waitcnt vmcnt(0)" ::: "memory");
    __syncthreads();
    if (tidv == 0) {
        unsigned* bar = b.bar;
        __builtin_amdgcn_s_waitcnt(0);
        unsigned nloc = b.st[0], nx = b.st[1];
        if (nloc == 0u) { xcd_barrier_complete(bar, b.x, nloc, nx); b.st[0] = nloc; b.st[1] = nx; }
        const unsigned old = xb_add(&bar[XB_XSUB(b.x)], 1u);
        const unsigned gen = old / nloc;
        if (old + 1u == (gen + 1u) * nloc) {
            __builtin_amdgcn_fence(__ATOMIC_RELEASE, "agent");
            asm volatile("s_waitcnt vmcnt(0)" ::: "memory");
            const unsigned og = xb_add(&bar[XB_TOP], 1u);
            const unsigned tg = og / nx;
            if (og + 1u == (tg + 1u) * nx) xb_add(&bar[XB_TOPGEN], 1u);
            else XB_SPIN(xb_ld(&bar[XB_TOPGEN]) == tg, bar);
            __builtin_amdgcn_fence(__ATOMIC_ACQUIRE, "agent");
            xb_add(&bar[XB_XGEN(b.x)], 1u);
            asm volatile("s_waitcnt vmcnt(0)" ::: "memory");
        } else {
            XB_SPIN(xb_ld(&bar[XB_XGEN(b.x)]) == gen, bar);
            __builtin_amdgcn_fence(__ATOMIC_ACQUIRE, "agent");
            asm volatile("s_waitcnt vmcnt(0)" ::: "memory");
        }
    }
    __syncthreads();
}

constexpr int NPHASE = 11;
__global__ void __launch_bounds__(512, 2) mk_fwd(Params p) {
    extern __shared__ __attribute__((aligned(16))) unsigned char lds[];
    cg::grid_group grid = cg::this_grid();
    const int lo = p.ph_lo, hi = p.ph_hi;
    PG8_LAS unsigned char* ldsl = (PG8_LAS unsigned char*)lds;
    unsigned char* ws = p.ws;
    bf16_t* A = (bf16_t*)(ws + WS_A);
    if (threadIdx.x < 4) ((LAS unsigned*)((LAS unsigned char*)lds + LDS_BYTES - 16))[threadIdx.x] = 0u;
    __syncthreads();
    XcdBarrier xbar = xcd_barrier_post((unsigned*)(p.ws + WS_BAR), (volatile LAS unsigned*)((LAS unsigned char*)lds + LDS_BYTES - 16));
#define IN(k) (lo <= (k) && (k) < hi)
#define SEAM(k) do { if (IN(k) && IN((k) + 1)) xcd_barrier(xbar, tidv); } while (0)
    if (p.ws == nullptr) grid.sync();
#define RUN(k, BODY) do { if (IN(k)) { BODY; } if (PROBE_REP == (k)) { xcd_barrier(xbar, tidv); BODY; } SEAM(k); } while (0)
#define GEMM_PHASE(EPI, BT, N_, ...) do { pg8::Gemm g{A, (const bf16_t*)(ws + (BT)), T, (N_), DM}; pg8::StaticOrder S; S.init(T, (N_), gridDim.x, blockIdx.x); \
        pg8::EPI E{__VA_ARGS__}; pg8::gemm_phase<pg8::EPI, pg8::StaticOrder, true, true>(ldsl, g, S, E, tidv); } while (0)
    const int wv_s = __builtin_amdgcn_readfirstlane(threadIdx.x >> 6);
    int tidv = threadIdx.x;
    RUN(0, (p0_prep(p, lds), rows_rms16(p.x, p.norm_gains, A, tidv)));
#if !MK_SKEL
    RUN(1, GEMM_PHASE(EpiHgrnIn, WS_W0IN, N0IN, ws, p.out, (const float*)(ws + WS_MISC + MISC_LB)));
#if HGRN_NAIVE
    RUN(2, hgrn_naive(p, lds));
#else
    RUN(2, hgrn_chunk4(p, lds));
#if PROBE_REP == 21
    xcd_barrier(xbar, tidv); hgrn_chunk3<1>(p, lds);
#elif PROBE_REP == 22
    xcd_barrier(xbar, tidv); hgrn_chunk3<2>(p, lds);
#endif
#endif
    RUN(3, hgrn_headnorm(p));
    RUN(4, ({ pg8::Gemm g{A, (const bf16_t*)(ws + WS_W0OUT), T, DM, DM}; pg8::StaticOrder S; S.init(T, DM, gridDim.x, blockIdx.x);
        pg8::EpiResidInit<true, true> E{p.x, (bf16_t*)(ws + WS_B), (float*)(ws + WS_SSQ)}; pg8::gemm_phase<pg8::EpiResidInit<true, true>, pg8::StaticOrder, true, true>(ldsl, g, S, E, tidv); }));
    RUN(6, ({ pg8::Gemm g{(const bf16_t*)(ws + WS_B), (const bf16_t*)(ws + WS_W1IN), T, N1PAD, DM}; pg8::SplitTailOrder S; S.init(T, N1PAD - 256, gridDim.x, blockIdx.x);
        pg8::EpiNsaIn E{ws, (float*)(ws + WS_GATES), ldsl, (const float*)(ws + WS_SSQ)}; pg8::gemm_phase<pg8::EpiNsaIn, pg8::SplitTailOrder, true, true>(ldsl, g, S, E, tidv); }));
#if NSA_NAIVE
    RUN(7, compress_naive(p, lds));
    RUN(8, nsa_naive(p, lds, A));
#else
    RUN(7, compress_mfma(p, lds));
#if NSA_DIFF
    if (IN(8)) { bf16_t* OA = (bf16_t*)(ws + WS_W0IN); nsa_naive(p, lds, OA); grid.sync(); nsa_fused(p, lds, A, tidv); grid.sync();
        for (size_t e = (size_t)blockIdx.x * 512 + threadIdx.x; e < (size_t)T * DM; e += (size_t)gridDim.x * 512) { const float a = bf2f(A[e]), r = bf2f(OA[e]); A[e] = (bf16_t)f2bf(a + NSA_AMP * (a - r)); } } SEAM(8);
#else
    tidv = wv_s * 64 + (int)__builtin_amdgcn_mbcnt_hi(~0u, __builtin_amdgcn_mbcnt_lo(~0u, 0u));
    RUN(8, nsa_fused(p, lds, A, tidv));
#ifdef PROBE_VAR
    if (IN(9)) { tidv = wv_s * 64 + (int)__builtin_amdgcn_mbcnt_hi(~0u, __builtin_amdgcn_mbcnt_lo(~0u, 0u)); nsa_fused<PROBE_VAR>(p, lds, (bf16_t*)(ws + WS_W0IN), tidv);
        tidv = wv_s * 64 + (int)__builtin_amdgcn_mbcnt_hi(~0u, __builtin_amdgcn_mbcnt_lo(~0u, 0u)); xcd_barrier(xbar, tidv); }
#endif
#endif
#endif
    RUN(9, GEMM_PHASE(EpiResidInit<false>, WS_W1OUT, DM, (const bf16_t*)(ws + WS_B), (bf16_t*)(ws + WS_B)));
    RUN(10, rows_rms_b<false>((const bf16_t*)(ws + WS_B), p.final_gain, p.out, tidv));
#else
    for (int k = 1; k < 10; ++k) { SEAM(k); }
    if (IN(10)) { rows_rms_f32(p.x, p.final_gain, p.out, tidv); }
#endif
#undef IN
#undef SEAM
#undef RUN
#undef GEMM_PHASE
}

extern "C" void kernel_launch(void* const* d_in, const int* in_sizes, int n_in, void* d_out, int out_size, void* d_ws, size_t ws_size, hipStream_t stream) {
    static int grid = 0;
    if (grid == 0) {
        if (n_in != 18 || in_sizes[0] != T * DM || out_size != T * DM || ws_size < WS_END) {
            fprintf(stderr, "kernel_launch: unexpected shapes (n_in %d, in0 %d, out %d, ws %zu)\n", n_in, n_in > 0 ? in_sizes[0] : -1, out_size, ws_size); grid = -1; return; }
        int dev = 0, cus = 0, per_cu = 0;
        if (hipGetDevice(&dev) != hipSuccess || hipDeviceGetAttribute(&cus, hipDeviceAttributeMultiprocessorCount, dev) != hipSuccess) { grid = -1; return; }
        if (hipFuncSetAttribute((const void*)mk_fwd, hipFuncAttributeMaxDynamicSharedMemorySize, LDS_BYTES) != hipSuccess) { fprintf(stderr, "kernel_launch: hipFuncSetAttribute failed\n"); grid = -1; return; }
        if (hipOccupancyMaxActiveBlocksPerMultiprocessor(&per_cu, (const void*)mk_fwd, 512, LDS_BYTES) != hipSuccess || per_cu < 1) { fprintf(stderr, "kernel_launch: occupancy query says %d\n", per_cu); per_cu = 1; }
        (void)hipGetLastError();
        grid = cus;
    }
    if (grid < 0) return;
    Params p{};
    p.x = (const float*)d_in[0]; p.norm_gains = (const float*)d_in[1]; p.final_gain = (const float*)d_in[2]; p.rel_bias = (const float*)d_in[3]; p.hgrn_lb = (const float*)d_in[4];
    p.hgrn_w_in = (const float*)d_in[5]; p.hgrn_head_gain = (const float*)d_in[6]; p.hgrn_w_out = (const float*)d_in[7]; p.nsa_w_in = (const float*)d_in[8];
    p.pe_k = (const float*)d_in[9]; p.pe_v = (const float*)d_in[10]; p.pk_w1 = (const float*)d_in[11]; p.pk_b1 = (const float*)d_in[12]; p.pk_w2 = (const float*)d_in[13];
    p.pv_w1 = (const float*)d_in[14]; p.pv_b1 = (const float*)d_in[15]; p.pv_w2 = (const float*)d_in[16]; p.nsa_w_out = (const float*)d_in[17];
    p.out = (float*)d_out; p.ws = (unsigned char*)d_ws;
#if MK_MULTI
    for (int k = 0; k < NPHASE; ++k) { p.ph_lo = k; p.ph_hi = k + 1; hipLaunchKernelGGL(mk_fwd, dim3(grid), dim3(512), LDS_BYTES, stream, p); }
#else
    p.ph_lo = 0; p.ph_hi = NPHASE;
    if (hipMemsetAsync((unsigned char*)d_ws + WS_BAR, 0, BAR_BYTES, stream) != hipSuccess) { fprintf(stderr, "kernel_launch: memset of the barrier words failed\n"); return; }
    void* args[] = {&p};
    hipError_t e = hipLaunchCooperativeKernel((const void*)mk_fwd, dim3(grid), dim3(512), args, LDS_BYTES, stream);
    if (e != hipSuccess) fprintf(stderr, "kernel_launch: cooperative launch failed: %s (grid %d)\n", hipGetErrorString(e), grid);
#endif
}
```
